# Optimizing an MI355X kernel written in HIP

```python
import jax, jax.numpy as jnp
from jax import lax
import numpy as np

D_MODEL = 2048
BATCH = 4
SEQ = 4096
DEPTH = 2

GRID_W = 64
CTX_LEN = 256
N_HEADS = 16
HEAD_DIM = 64
ATTN_WIDTH = N_HEADS * HEAD_DIM
WIN_ROWS = 8
WIN_COLS = 16
COL_BLOCK = 16
KEY_SPAN = 32
ROPE_BASE = 10000.0
CONV_WIDTH = 512
CONV_K = 31
SC_WIDTH = 512
SC_K = 3
N_BRANCH = 3
N_EXPERTS = 16
EXPERT_FF = 1024
CAP_FACTOR = 2
EPS = 1e-6
NEG_INF = -1e30
PROJ_SPLITS = (ATTN_WIDTH, ATTN_WIDTH, ATTN_WIDTH, CONV_WIDTH, CONV_WIDTH, SC_WIDTH, SC_WIDTH, SC_WIDTH, N_BRANCH * D_MODEL)
PROJ_WIDTH = 3 * ATTN_WIDTH + 2 * CONV_WIDTH + 3 * SC_WIDTH + N_BRANCH * D_MODEL

kernel_name = "hybrid_natten_conformer_shortconv_ec_moe_dit"


def rmsnorm(x, g):
    x32 = x.astype(jnp.float32)
    y = x32 * lax.rsqrt(jnp.mean(x32 * x32, axis=-1, keepdims=True) + EPS)
    return (y * g.astype(jnp.float32)).astype(x.dtype)


def layernorm(x, g, b):
    x32 = x.astype(jnp.float32)
    mu = jnp.mean(x32, axis=-1, keepdims=True)
    xc = x32 - mu
    y = xc * lax.rsqrt(jnp.mean(xc * xc, axis=-1, keepdims=True) + EPS)
    return (y * g.astype(jnp.float32) + b.astype(jnp.float32)).astype(x.dtype)


def modulate(h, shift, scale):
    return h * (1 + scale) + shift


def heads(t):
    return t.reshape(*t.shape[:-1], N_HEADS, HEAD_DIM)


def split_proj(p):
    idx = np.cumsum(PROJ_SPLITS)[:-1].tolist()
    return jnp.split(p, idx, axis=-1)


def depthwise_conv(u, w):
    k = w.shape[0]
    kern = w.astype(u.dtype)[:, None, :]
    return lax.conv_general_dilated(u, kern, window_strides=(1,), padding=[(k // 2, k // 2)],
                                    dimension_numbers=('NWC', 'WIO', 'NWC'),
                                    feature_group_count=u.shape[-1])


def axial_rope(x, row_pos, col_pos):
    half = HEAD_DIM // 2
    quarter = half // 2
    freqs = 1.0 / (ROPE_BASE ** (jnp.arange(quarter, dtype=jnp.float32) / quarter))

    def rot(xp, pos):
        ang = pos.astype(jnp.float32)[:, None] * freqs[None, :]
        cos = jnp.cos(ang)[None, :, None, :]
        sin = jnp.sin(ang)[None, :, None, :]
        x1 = xp[..., :quarter].astype(jnp.float32)
        x2 = xp[..., quarter:].astype(jnp.float32)
        return jnp.concatenate([x1 * cos - x2 * sin, x2 * cos + x1 * sin], axis=-1)

    out = jnp.concatenate([rot(x[..., :half], row_pos), rot(x[..., half:], col_pos)], axis=-1)
    return out.astype(x.dtype)


def context_attention(qc, kc, vc):
    s = jnp.einsum('bqhd,bkhd->bhqk', qc, kc).astype(jnp.float32) * (HEAD_DIM ** -0.5)
    p = jax.nn.softmax(s, axis=-1).astype(vc.dtype)
    o = jnp.einsum('bhqk,bkhd->bqhd', p, vc)
    return o.reshape(*o.shape[:2], ATTN_WIDTH)


def neighbourhood_attention(q, k, v, q_plain, kc, vc, rpb):
    B, S, H, Dh = q.shape
    rows = S // GRID_W
    kr = min(WIN_ROWS, rows)
    n_cb = GRID_W // COL_BLOCK
    scale = Dh ** -0.5
    qg = q.reshape(B, rows, n_cb, COL_BLOCK, H, Dh)
    qpg = q_plain.reshape(B, rows, n_cb, COL_BLOCK, H, Dh)
    kg = k.reshape(B, rows, GRID_W, H, Dh)
    vg = v.reshape(B, rows, GRID_W, H, Dh)
    q_col = np.arange(GRID_W).reshape(n_cb, COL_BLOCK)
    q_cstart = np.clip(q_col - WIN_COLS // 2, 0, GRID_W - WIN_COLS)
    blk_start = np.clip(np.arange(n_cb) * COL_BLOCK - WIN_COLS // 2, 0, GRID_W - KEY_SPAN)
    key_col = blk_start[:, None] + np.arange(KEY_SPAN)
    col_valid = ((key_col[:, None, :] >= q_cstart[..., None]) &
                 (key_col[:, None, :] < q_cstart[..., None] + WIN_COLS))
    col_off = np.clip(key_col[:, None, :] - q_col[..., None] + WIN_COLS - 1, 0, 2 * WIN_COLS - 2)
    rpb_cols = rpb[:, :, col_off]
    n_loc = kr * KEY_SPAN

    def row_step(r):
        rs = jnp.clip(r - kr // 2, 0, rows - kr)
        kb = lax.dynamic_slice_in_dim(kg, rs, kr, axis=1)[:, :, key_col]
        vb = lax.dynamic_slice_in_dim(vg, rs, kr, axis=1)[:, :, key_col]
        qr = lax.dynamic_index_in_dim(qg, r, axis=1, keepdims=False)
        qpr = lax.dynamic_index_in_dim(qpg, r, axis=1, keepdims=False)
        row_off = rs + jnp.arange(kr) - r + WIN_ROWS - 1
        bias = jnp.take(rpb_cols, row_off, axis=1).transpose(0, 2, 3, 1, 4)
        s_loc = (jnp.einsum('bjqhd,brjkhd->bhjqrk', qr, kb).astype(jnp.float32) * scale
                 + bias[None].astype(jnp.float32))
        s_loc = jnp.where(col_valid[None, None, :, :, None, :], s_loc, NEG_INF)
        s_ctx = jnp.einsum('bjqhd,bkhd->bhjqk', qpr, kc).astype(jnp.float32) * scale
        s = jnp.concatenate([s_loc.reshape(B, H, n_cb, COL_BLOCK, n_loc), s_ctx], axis=-1)
        p = jax.nn.softmax(s, axis=-1).astype(v.dtype)
        p_loc = p[..., :n_loc].reshape(B, H, n_cb, COL_BLOCK, kr, KEY_SPAN)
        p_ctx = p[..., n_loc:]
        o = (jnp.einsum('bhjqrk,brjkhd->bjqhd', p_loc, vb)
             + jnp.einsum('bhjqk,bkhd->bjqhd', p_ctx, vc))
        return o.reshape(B, GRID_W, H * Dh)

    out = lax.map(row_step, jnp.arange(rows))
    return out.transpose(1, 0, 2, 3).reshape(B, S, H * Dh)


def conformer_conv(a, g, dw_w, dw_b, ln_g, ln_b, w_out):
    u = depthwise_conv(a * jax.nn.sigmoid(g), dw_w) + dw_b
    u = jax.nn.silu(layernorm(u, ln_g, ln_b))
    return u @ w_out


def short_conv(b_gate, c_gate, u, w, w_out):
    return (b_gate * depthwise_conv(c_gate * u, w)) @ w_out


def merge_branches(attn_out, pieces, w_attn_o, conv_dw_w, conv_dw_b, conv_ln_g, conv_ln_b,
                   w_conv_o, sc_w, w_sc_o, w_o):
    _, _, _, glu_a, glu_g, sc_b, sc_c, sc_x, gates = pieces
    y_a = attn_out @ w_attn_o
    y_b = conformer_conv(glu_a, glu_g, conv_dw_w, conv_dw_b, conv_ln_g, conv_ln_b, w_conv_o)
    y_c = short_conv(sc_b, sc_c, sc_x, sc_w, w_sc_o)
    g_a, g_b, g_c = jnp.split(jax.nn.sigmoid(gates), N_BRANCH, axis=-1)
    return (g_a * y_a + g_b * y_b + g_c * y_c) @ w_o


def expert_choice_ffn(h, w_router, w1, w3, w2):
    B, n, D = h.shape
    cap = max(1, CAP_FACTOR * n // N_EXPERTS)
    aff = jax.nn.softmax(jnp.einsum('bnd,de->bne', h, w_router).astype(jnp.float32), axis=-1)
    g, idx = lax.top_k(aff.transpose(0, 2, 1), cap)
    xs = jax.vmap(lambda hb, ib: hb[ib])(h, idx)
    a = jnp.einsum('becd,edf->becf', xs, w1)
    b3 = jnp.einsum('becd,edf->becf', xs, w3)
    y = jnp.einsum('becf,efd->becd', jax.nn.silu(a) * b3, w2) * g[..., None].astype(h.dtype)
    return jax.vmap(lambda yb, ib: jnp.zeros((n, D), yb.dtype).at[ib.reshape(-1)].add(yb.reshape(-1, D)))(y, idx)


def setup_inputs(seed: int = 0) -> dict:
    key = jax.random.key(seed)
    ks = jax.random.split(key, 32)
    L, D = DEPTH, D_MODEL

    def nrm(k, shape, scale):
        return jax.random.normal(k, shape, jnp.float32) * scale

    return {
        "x": nrm(ks[0], (BATCH, SEQ, D), 1.0),
        "c": nrm(ks[1], (BATCH, D), 1.0),
        "ctx": nrm(ks[2], (BATCH, CTX_LEN, D), 1.0),
        "c_ctx": nrm(ks[3], (D,), 1.0),
        "w_ada": nrm(ks[4], (L, D, 6 * D), 0.25 * D ** -0.5),
        "b_ada": nrm(ks[5], (L, 6 * D), 0.02),
        "g_norm1": 1.0 + nrm(ks[6], (L, D), 0.1),
        "g_norm2": 1.0 + nrm(ks[7], (L, D), 0.1),
        "w_in": nrm(ks[8], (L, D, PROJ_WIDTH), D ** -0.5),
        "b_in": nrm(ks[9], (L, PROJ_WIDTH), 0.02),
        "g_q": 1.0 + nrm(ks[10], (L, HEAD_DIM), 0.1),
        "g_k": 1.0 + nrm(ks[11], (L, HEAD_DIM), 0.1),
        "rpb": nrm(ks[12], (L, N_HEADS, 2 * WIN_ROWS - 1, 2 * WIN_COLS - 1), 0.5),
        "w_attn_o": nrm(ks[13], (L, ATTN_WIDTH, D), ATTN_WIDTH ** -0.5),
        "conv_dw_w": nrm(ks[14], (L, CONV_K, CONV_WIDTH), CONV_K ** -0.5),
        "conv_dw_b": nrm(ks[15], (L, CONV_WIDTH), 0.02),
        "conv_ln_g": 1.0 + nrm(ks[16], (L, CONV_WIDTH), 0.1),
        "conv_ln_b": nrm(ks[17], (L, CONV_WIDTH), 0.02),
        "w_conv_o": nrm(ks[18], (L, CONV_WIDTH, D), CONV_WIDTH ** -0.5),
        "sc_w": nrm(ks[19], (L, SC_K, SC_WIDTH), SC_K ** -0.5),
        "w_sc_o": nrm(ks[20], (L, SC_WIDTH, D), SC_WIDTH ** -0.5),
        "w_o": nrm(ks[21], (L, D, D), D ** -0.5),
        "w_router": nrm(ks[22], (L, D, N_EXPERTS), D ** -0.5),
        "w_e1": nrm(ks[23], (L, N_EXPERTS, D, EXPERT_FF), D ** -0.5),
        "w_e3": nrm(ks[24], (L, N_EXPERTS, D, EXPERT_FF), D ** -0.5),
        "w_e2": nrm(ks[25], (L, N_EXPERTS, EXPERT_FF, D), EXPERT_FF ** -0.5),
    }


def reference(x, c, ctx, c_ctx, w_ada, b_ada, g_norm1, g_norm2, w_in, b_in, g_q, g_k, rpb, w_attn_o,
              conv_dw_w, conv_dw_b, conv_ln_g, conv_ln_b, w_conv_o, sc_w, w_sc_o, w_o, w_router,
              w_e1, w_e3, w_e2):
    B, S, D = x.shape
    t = jnp.arange(S)
    row_pos, col_pos = t // GRID_W, t % GRID_W
    xc = ctx
    for l in range(DEPTH):
        last = l == DEPTH - 1
        mod = jnp.split(jax.nn.silu(c) @ w_ada[l] + b_ada[l], 6, axis=-1)
        n_mod = 2 if last else 6
        mod_c = jnp.split(jax.nn.silu(c_ctx) @ w_ada[l][:, :n_mod * D] + b_ada[l][:n_mod * D], n_mod, axis=-1)
        branch_params = (w_attn_o[l], conv_dw_w[l], conv_dw_b[l], conv_ln_g[l], conv_ln_b[l],
                         w_conv_o[l], sc_w[l], w_sc_o[l], w_o[l])

        hc = modulate(rmsnorm(xc, g_norm1[l]), mod_c[0], mod_c[1])
        if last:
            kv = hc @ w_in[l][:, ATTN_WIDTH:3 * ATTN_WIDTH] + b_in[l][ATTN_WIDTH:3 * ATTN_WIDTH]
            kc_raw, vc_raw = jnp.split(kv, 2, axis=-1)
            kc = rmsnorm(heads(kc_raw), g_k[l])
            vc = heads(vc_raw)
        else:
            pc = split_proj(hc @ w_in[l] + b_in[l])
            qc = rmsnorm(heads(pc[0]), g_q[l])
            kc = rmsnorm(heads(pc[1]), g_k[l])
            vc = heads(pc[2])
            mix_c = merge_branches(context_attention(qc, kc, vc), pc, *branch_params)
            xc_mid = xc + mod_c[2] * mix_c
            hc2 = modulate(rmsnorm(xc_mid, g_norm2[l]), mod_c[3], mod_c[4])
            xc_next = xc_mid + mod_c[5] * expert_choice_ffn(hc2, w_router[l], w_e1[l], w_e3[l], w_e2[l])

        h = modulate(rmsnorm(x, g_norm1[l]), mod[0][:, None], mod[1][:, None])
        p = split_proj(h @ w_in[l] + b_in[l])
        q = rmsnorm(heads(p[0]), g_q[l])
        k = rmsnorm(heads(p[1]), g_k[l])
        v = heads(p[2])
        q_rot = axial_rope(q, row_pos, col_pos)
        k_rot = axial_rope(k, row_pos, col_pos)
        attn = neighbourhood_attention(q_rot, k_rot, v, q, kc, vc, rpb[l])
        x = x + mod[2][:, None] * merge_branches(attn, p, *branch_params)
        h2 = modulate(rmsnorm(x, g_norm2[l]), mod[3][:, None], mod[4][:, None])
        x = x + mod[5][:, None] * expert_choice_ffn(h2, w_router[l], w_e1[l], w_e3[l], w_e2[l])

        if not last:
            xc = xc_next
    return x
```

```cpp
#include <hip/hip_runtime.h>
#include <cstdio>
#include <cstdint>

#ifndef MK_PER_PHASE
#define MK_PER_PHASE 0
#endif

__device__ __forceinline__ int mk_lane_id() { unsigned z = 0u; asm volatile("" : "+v"(z)); return (int)__builtin_amdgcn_mbcnt_hi(~0u, __builtin_amdgcn_mbcnt_lo(~0u, z)); }
namespace pg8 {
#define PG8_LAS __attribute__((address_space(3)))
typedef unsigned short bf16_t;
typedef short bf16x8 __attribute__((ext_vector_type(8)));
typedef float f32x4 __attribute__((ext_vector_type(4)));
typedef float f32x2 __attribute__((ext_vector_type(2)));
typedef unsigned u32x4 __attribute__((ext_vector_type(4)));
typedef unsigned u32x2 __attribute__((ext_vector_type(2)));
typedef int i32x4 __attribute__((ext_vector_type(4)));
typedef int i32x8 __attribute__((ext_vector_type(8)));
constexpr int BM = 256, BK = 64, HALF = 128, HTB = HALF * BK * 2, STAGE_BYTES = 8 * HTB, NXCD = 8, WGM = 8;

__host__ __device__ __forceinline__ int lds_byte(int r, int c) { const int st = (r >> 4) * 2 + (c >> 5), rr = r & 15, cc = c & 31, ob = rr * 64 + cc * 2; return st * 1024 + (ob ^ (((ob >> 9) & 1) << 5)); }
__host__ __device__ __forceinline__ void stage_rc(int b, int& R, int& C) { const int st = b / 1024, sb = b % 1024, swz = sb ^ (((sb >> 9) & 1) << 5); R = (st >> 1) * 16 + swz / 64; C = (st & 1) * 32 + (swz % 64) / 2; }
__host__ __device__ __forceinline__ int perm32(int rho) { const int n = rho >> 4, i = rho & 15; return 8 * (i >> 2) + 4 * n + (i & 3); }

struct Unit { int pm, pn, pb; };
struct Gemm { const bf16_t* A; const bf16_t* Bt; int K; };

struct StaticOrder {
    int nM, nN, nwg, G, c, moe, ex_n, ex_pm0, ex_pn0;
    __host__ __device__ void init(int M, int N, int G_, int c_, int moe_) { nM = M / BM; nN = N / BM; nwg = nM * nN; G = G_; c = c_; moe = moe_; ex_n = 0; ex_pm0 = 0; ex_pn0 = 0; }
    __host__ __device__ bool next(int i, Unit& u) const {
        const long L = (long)i * G + c; if (L >= nwg + ex_n) return false;
        if (L >= nwg) { const int q = (int)L - nwg; u.pm = ex_pm0 + (q & 3); u.pn = ex_pn0 + (q >> 2); u.pb = u.pn; return true; }
        int wgid = (int)L; { const int q = nwg / NXCD, r = nwg % NXCD, xcd = wgid % NXCD, off = wgid / NXCD; wgid = (xcd < r ? xcd * (q + 1) : r * (q + 1) + (xcd - r) * q) + off; }
        const int nig = WGM * nN, gid = wgid / nig, fm = gid * WGM, gsz = (nM - fm) < WGM ? (nM - fm) : WGM;
        u.pm = fm + ((wgid % nig) % gsz); u.pn = (wgid % nig) / gsz;
        u.pb = moe ? ((u.pm < 128 ? (u.pm >> 3) : (u.pm - 128)) * nN + u.pn) : u.pn;
        return true;
    }
    __device__ __forceinline__ void a_ready(const Unit&) const {}
    __device__ __forceinline__ void done(const Unit&) const {}
};

__device__ __forceinline__ unsigned cvt_pk_bf16(float lo, float hi) { unsigned r; asm volatile("v_cvt_pk_bf16_f32 %0, %1, %2" : "=v"(r) : "v"(lo), "v"(hi)); return r; }

template <class Epi, class Sched, bool ALIGN_EPI = false, bool SP2 = false, bool GATHER = false, bool FP8 = false>
__device__ __forceinline__ void gemm_phase(PG8_LAS unsigned char* lds, const Gemm g, const Sched& S, const Epi& E, const int wave_id, const PG8_LAS int* gidx = nullptr) {
    static_assert(!GATHER || SP2, "GATHER is written for the SP2 loop");
    int tid_ = wave_id * 64 + mk_lane_id(); asm volatile("" : "+v"(tid_));
    const int tid = tid_, wid = __builtin_amdgcn_readfirstlane(tid >> 6), lane = tid & 63, wr = wid >> 2, wc = wid & 3, fr = lane & 15, fq = lane >> 4;
    const int K = g.K, nt = K / BK;
    unsigned voffA[2], voffB[2];
#pragma unroll
    for (int i = 0; i < 2; ++i) { int R, C; stage_rc(tid * 16 + i * 8192, R, C); const int Rb = Epi::PERM ? ((R & ~31) + perm32(R & 31)) : R;
        voffA[i] = (unsigned)(R * K + C) * 2u; voffB[i] = (unsigned)(Rb * K + C) * 2u; }
    int gR[2]; unsigned gC[2]; unsigned oc[2][2], on[2][2];
#pragma unroll
    for (int i = 0; i < 2; ++i) { int R, C; stage_rc(tid * 16 + i * 8192, R, C); gR[i] = R; gC[i] = (unsigned)C * 2u; }
#define PG8_GOFF(dst, slot) do { _Pragma("unroll") for (int _h = 0; _h < 2; ++_h) _Pragma("unroll") for (int _i = 0; _i < 2; ++_i) dst[_h][_i] = (unsigned)gidx[(slot) * 256 + _h * 128 + gR[_i]] * (unsigned)(K * 2) + gC[_i]; } while (0)
    const size_t kstep = (size_t)(BK * 2);
    const size_t hstep = (size_t)HALF * K * 2;
    const size_t tstep = 2 * hstep;
    const unsigned ldsw = (unsigned)wid * 1024u;
    const int aoff = lds_byte(wr * 64 + fr, fq * 8), boff = lds_byte(wc * 32 + fr, fq * 8);
#define PG8_SA(b, h) (((b) * 2 + (h)) * HTB)
#define PG8_SB(b, h) ((4 + (b) * 2 + (h)) * HTB)
#define PG8_STAGE(bufoff, gbase, voff) do { _Pragma("unroll") for (int _i = 0; _i < 2; ++_i) \
        __builtin_amdgcn_global_load_lds((const unsigned*)((const char*)(gbase) + (voff)[_i]), (PG8_LAS unsigned*)(lds + (bufoff) + ldsw + _i * 8192), 16, 0, 0); } while (0)
#define PG8_STAGE_G(bufoff, kt_, o0, o1) do { const char* _gb = (const char*)g.A + (size_t)(kt_) * kstep; \
        __builtin_amdgcn_global_load_lds((const unsigned*)(_gb + (o0)), (PG8_LAS unsigned*)(lds + (bufoff) + ldsw), 16, 0, 0); \
        __builtin_amdgcn_global_load_lds((const unsigned*)(_gb + (o1)), (PG8_LAS unsigned*)(lds + (bufoff) + ldsw + 8192), 16, 0, 0); } while (0)
#define PG8_LDA(dst, b, h) do { _Pragma("unroll") for (int m = 0; m < 4; ++m) { if constexpr (FP8) dst##8[m] = __builtin_shufflevector(*(const PG8_LAS i32x4*)(lds + PG8_SA(b, h) + aoff + m * 2048), *(const PG8_LAS i32x4*)(lds + PG8_SA(b, h) + aoff + m * 2048 + 1024), 0, 1, 2, 3, 4, 5, 6, 7); \
        else { _Pragma("unroll") for (int k = 0; k < 2; ++k) dst[m][k] = *(const PG8_LAS bf16x8*)(lds + PG8_SA(b, h) + aoff + m * 2048 + k * 1024); } } } while (0)
#define PG8_LDB(dst, b, h) do { _Pragma("unroll") for (int n = 0; n < 2; ++n) { if constexpr (FP8) dst##8[n] = __builtin_shufflevector(*(const PG8_LAS i32x4*)(lds + PG8_SB(b, h) + boff + n * 2048), *(const PG8_LAS i32x4*)(lds + PG8_SB(b, h) + boff + n * 2048 + 1024), 0, 1, 2, 3, 4, 5, 6, 7); \
        else { _Pragma("unroll") for (int k = 0; k < 2; ++k) dst[n][k] = *(const PG8_LAS bf16x8*)(lds + PG8_SB(b, h) + boff + n * 2048 + k * 1024); } } } while (0)
#define PG8_CAT(x, y) __builtin_shufflevector(__builtin_bit_cast(i32x4, x), __builtin_bit_cast(i32x4, y), 0, 1, 2, 3, 4, 5, 6, 7)
#define PG8_MMA(ai, bj, At, Bt) do { __builtin_amdgcn_s_setprio(1); _Pragma("unroll") for (int m = 0; m < 4; ++m) _Pragma("unroll") for (int n = 0; n < 2; ++n) { \
        if constexpr (FP8) acc[ai][bj][m][n] = __builtin_amdgcn_mfma_scale_f32_16x16x128_f8f6f4(Bt##8[n], At##8[m], acc[ai][bj][m][n], 0, 0, 0, 0x7F7F7F7F, 0, 0x7F7F7F7F); \
        else { _Pragma("unroll") for (int k = 0; k < 2; ++k) acc[ai][bj][m][n] = __builtin_amdgcn_mfma_f32_16x16x32_bf16(Bt[n][k], At[m][k], acc[ai][bj][m][n], 0, 0, 0); } } __builtin_amdgcn_s_setprio(0); \
        if constexpr (FP8) { _Pragma("unroll") for (int m = 0; m < 4; ++m) _Pragma("unroll") for (int n = 0; n < 2; ++n) asm volatile("" : "+a"(acc[ai][bj][m][n])); } } while (0)
#define PG8_WAIT_V(n) asm volatile("s_waitcnt vmcnt(" #n ")" ::: "memory")
#define PG8_WAIT_L(n) asm volatile("s_waitcnt lgkmcnt(" #n ")" ::: "memory")
#define PG8_BAR __builtin_amdgcn_s_barrier()
#define PG8_SCHED __builtin_amdgcn_sched_barrier(0)
    Unit cur, nxt; int ui = 0;
    if (!S.next(0, cur)) return;
    f32x4 acc[2][2][4][2];
#pragma unroll
    for (int a = 0; a < 2; ++a)
#pragma unroll
        for (int b = 0; b < 2; ++b)
#pragma unroll
            for (int m = 0; m < 4; ++m)
#pragma unroll
                for (int n = 0; n < 2; ++n) acc[a][b][m][n] = (f32x4){0.f, 0.f, 0.f, 0.f};
    bf16x8 At[4][2], B0[2][2], B1[2][2];
    i32x8 At8[4], B08[2], B18[2];
    const char* cA = (const char*)g.A + (size_t)cur.pm * tstep; const char* cB = (const char*)g.Bt + (size_t)cur.pb * tstep;
    S.a_ready(cur);
    if constexpr (SP2) {
        if constexpr (GATHER) { PG8_GOFF(oc, 0); }
        PG8_STAGE(PG8_SB(0, 0), cB, voffB); PG8_STAGE(PG8_SB(0, 1), cB + hstep, voffB);
        if constexpr (GATHER) { PG8_STAGE_G(PG8_SA(0, 0), 0, oc[0][0], oc[0][1]); PG8_STAGE_G(PG8_SA(0, 1), 0, oc[1][0], oc[1][1]); }
        else { PG8_STAGE(PG8_SA(0, 0), cA, voffA); PG8_STAGE(PG8_SA(0, 1), cA + hstep, voffA); }
        if (wr == 1) PG8_BAR;
        PG8_WAIT_V(2); PG8_BAR;
        PG8_STAGE(PG8_SB(1, 0), cB + kstep, voffB);
        if constexpr (GATHER) { PG8_STAGE_G(PG8_SA(1, 0), 1, oc[0][0], oc[0][1]); } else { PG8_STAGE(PG8_SA(1, 0), cA + kstep, voffA); }
        PG8_STAGE(PG8_SB(1, 1), cB + hstep + kstep, voffB);
        PG8_WAIT_V(6); PG8_BAR;
    } else {
        PG8_STAGE(PG8_SB(0, 0), cB, voffB); PG8_STAGE(PG8_SA(0, 0), cA, voffA); PG8_STAGE(PG8_SB(0, 1), cB + hstep, voffB); PG8_STAGE(PG8_SA(0, 1), cA + hstep, voffA);
        if (wr == 1) PG8_BAR;
        PG8_WAIT_V(4); PG8_BAR;
        PG8_STAGE(PG8_SB(1, 0), cB + kstep, voffB); PG8_STAGE(PG8_SA(1, 0), cA + kstep, voffA); PG8_STAGE(PG8_SB(1, 1), cB + hstep + kstep, voffB);
        PG8_WAIT_V(6); PG8_BAR;
    }
    for (;;) {
        const bool has_next = S.next(ui + 1, nxt);
        if constexpr (GATHER) { if (has_next) { PG8_GOFF(on, ui + 1); } else { _Pragma("unroll") for (int _h = 0; _h < 2; ++_h) _Pragma("unroll") for (int _i = 0; _i < 2; ++_i) on[_h][_i] = oc[_h][_i]; } }
        const char* nA = has_next ? (const char*)g.A + (size_t)nxt.pm * tstep : cA; const char* nB = has_next ? (const char*)g.Bt + (size_t)nxt.pb * tstep : cB;
#pragma nounroll
        for (int t = 0; t < nt; t += 2) {
            const bool last = (t == nt - 2);
            const char* a1 = cA + (size_t)(t + 1) * kstep;
            const char* a2 = last ? nA : cA + (size_t)(t + 2) * kstep; const char* b2 = last ? nB : cB + (size_t)(t + 2) * kstep;
            const char* a3 = a2 + kstep; const char* b3 = b2 + kstep;
            if (last && has_next) S.a_ready(nxt);
            if constexpr (SP2) {
            const int kt2 = last ? 0 : t + 2, kt3 = kt2 + 1;
            unsigned s00, s01, s10, s11; if constexpr (GATHER) { s00 = last ? on[0][0] : oc[0][0]; s01 = last ? on[0][1] : oc[0][1]; s10 = last ? on[1][0] : oc[1][0]; s11 = last ? on[1][1] : oc[1][1]; }
            PG8_LDB(B0, 0, 0); PG8_LDB(B1, 0, 1); PG8_SCHED; PG8_LDA(At, 0, 0);
            if constexpr (GATHER) { PG8_STAGE_G(PG8_SA(1, 1), t + 1, oc[1][0], oc[1][1]); } else { PG8_STAGE(PG8_SA(1, 1), a1 + hstep, voffA); }
            PG8_WAIT_V(8); PG8_WAIT_L(0); PG8_BAR; PG8_MMA(0, 0, At, B0); PG8_MMA(0, 1, At, B1); PG8_BAR; PG8_SCHED;
            PG8_LDA(At, 0, 1); PG8_STAGE(PG8_SB(0, 0), b2, voffB); PG8_STAGE(PG8_SB(0, 1), b2 + hstep, voffB);
            if constexpr (GATHER) { PG8_STAGE_G(PG8_SA(0, 0), kt2, s00, s01); } else { PG8_STAGE(PG8_SA(0, 0), a2, voffA); }
            PG8_WAIT_V(8); PG8_WAIT_L(0); PG8_BAR; PG8_MMA(1, 0, At, B0); PG8_MMA(1, 1, At, B1); PG8_BAR; PG8_SCHED;
            PG8_LDB(B0, 1, 0); PG8_LDB(B1, 1, 1); PG8_SCHED; PG8_LDA(At, 1, 0);
            if constexpr (GATHER) { PG8_STAGE_G(PG8_SA(0, 1), kt2, s10, s11); } else { PG8_STAGE(PG8_SA(0, 1), a2 + hstep, voffA); }
            PG8_WAIT_V(8); PG8_WAIT_L(0); PG8_BAR; PG8_MMA(0, 0, At, B0); PG8_MMA(0, 1, At, B1); PG8_BAR; PG8_SCHED;
            PG8_LDA(At, 1, 1); PG8_STAGE(PG8_SB(1, 0), b3, voffB); PG8_STAGE(PG8_SB(1, 1), b3 + hstep, voffB);
            if constexpr (GATHER) { PG8_STAGE_G(PG8_SA(1, 0), kt3, s00, s01); } else { PG8_STAGE(PG8_SA(1, 0), a3, voffA); }
            PG8_WAIT_V(8); PG8_WAIT_L(0); PG8_BAR; PG8_MMA(1, 0, At, B0); PG8_MMA(1, 1, At, B1); PG8_BAR; PG8_SCHED;
            } else {
            PG8_LDB(B0, 0, 0); PG8_SCHED; PG8_LDA(At, 0, 0); PG8_STAGE(PG8_SA(1, 1), a1 + hstep, voffA);
            PG8_WAIT_L(8); PG8_BAR; PG8_WAIT_L(0); PG8_MMA(0, 0, At, B0); PG8_BAR; PG8_SCHED;
            PG8_LDB(B1, 0, 1); PG8_STAGE(PG8_SB(0, 0), b2, voffB);
            PG8_BAR; PG8_WAIT_L(0); PG8_MMA(0, 1, At, B1); PG8_BAR;
            PG8_LDA(At, 0, 1); PG8_STAGE(PG8_SA(0, 0), a2, voffA);
            PG8_BAR; PG8_WAIT_L(0); PG8_MMA(1, 0, At, B0); PG8_BAR; PG8_SCHED;
            PG8_STAGE(PG8_SB(0, 1), b2 + hstep, voffB);
            PG8_WAIT_V(6); PG8_BAR; PG8_MMA(1, 1, At, B1); PG8_BAR;
            PG8_LDB(B0, 1, 0); PG8_SCHED; PG8_LDA(At, 1, 0); PG8_STAGE(PG8_SA(0, 1), a2 + hstep, voffA);
            PG8_WAIT_L(8); PG8_BAR; PG8_WAIT_L(0); PG8_MMA(0, 0, At, B0); PG8_BAR; PG8_SCHED;
            PG8_LDB(B1, 1, 1); PG8_STAGE(PG8_SB(1, 0), b3, voffB);
            PG8_BAR; PG8_WAIT_L(0); PG8_MMA(0, 1, At, B1); PG8_BAR;
            PG8_LDA(At, 1, 1); PG8_STAGE(PG8_SA(1, 0), a3, voffA);
            PG8_BAR; PG8_WAIT_L(0); PG8_MMA(1, 0, At, B0); PG8_BAR; PG8_SCHED;
            PG8_STAGE(PG8_SB(1, 1), b3 + hstep, voffB);
            PG8_WAIT_V(6); PG8_BAR; PG8_MMA(1, 1, At, B1); PG8_BAR;
            }
        }
        if constexpr (ALIGN_EPI) { if (wr == 0) PG8_BAR; }
        { int t2_ = mk_lane_id(); asm volatile("" : "+v"(t2_)); const int l2_ = t2_ & 63;
          E(acc, cur, wr, wc, l2_ & 15, l2_ >> 4); } S.done(cur);
        if (!has_next) break;
#pragma unroll
        for (int a = 0; a < 2; ++a)
#pragma unroll
            for (int b = 0; b < 2; ++b)
#pragma unroll
                for (int m = 0; m < 4; ++m)
#pragma unroll
                    for (int n = 0; n < 2; ++n) acc[a][b][m][n] = (f32x4){0.f, 0.f, 0.f, 0.f};
        cur = nxt; cA = nA; cB = nB; ++ui;
        if constexpr (GATHER) { _Pragma("unroll") for (int _h = 0; _h < 2; ++_h) _Pragma("unroll") for (int _i = 0; _i < 2; ++_i) oc[_h][_i] = on[_h][_i]; }
        if constexpr (ALIGN_EPI) { if (wr == 1) PG8_BAR; }
    }
    PG8_WAIT_V(0);
    if constexpr (!ALIGN_EPI) { if (wr == 0) PG8_BAR; }
    PG8_BAR;
#undef PG8_SA
#undef PG8_SB
#undef PG8_STAGE
#undef PG8_STAGE_G
#undef PG8_GOFF
#undef PG8_LDA
#undef PG8_LDB
#undef PG8_MMA
#undef PG8_CAT
#undef PG8_WAIT_V
#undef PG8_WAIT_L
#undef PG8_BAR
#undef PG8_SCHED
}
}

using pg8::bf16_t; using pg8::f32x4; using pg8::f32x2; using pg8::u32x4; using pg8::u32x2; using pg8::cvt_pk_bf16;
constexpr int NWAVES = 8;
constexpr int NB = 4, SEQ = 4096, DM = 2048, NL = 2, CTXL = 256, NH = 16, HD = 64, AW = 1024, CWD = 512, SWD = 512, PW = 11776, NE = 16, FF = 1024;
constexpr int ML = NB * SEQ, MC = NB * CTXL, MT = ML + MC;
constexpr int CAP_L = 512, CAP_C = 32;
constexpr int GATE_COL = 5632;
constexpr int XS_ROWS = 32768 + 16 * 256;
constexpr float EPS = 1e-6f;
constexpr float LOG2E = 1.4426950408889634f;
constexpr int NPHASE = 25;

constexpr size_t MiB = 1u << 20;
constexpr size_t WS_CTL = 0, CTL_ZERO_BYTES = 1 * MiB;
constexpr size_t WS_MOD = 1 * MiB;
constexpr size_t WS_ADAP = 2 * MiB;
constexpr size_t WS_ROPE = 10 * MiB;
constexpr size_t WS_AFFT = 11 * MiB;
constexpr size_t WS_SLOT = 13 * MiB;
constexpr size_t WS_IDX = 15 * MiB;
constexpr size_t WS_GATE = 15 * MiB + 512 * 1024;
constexpr size_t WS_WIN = 16 * MiB;
constexpr size_t WS_WAO = 108 * MiB;
constexpr size_t WS_WCO = 116 * MiB;
constexpr size_t WS_WSO = 120 * MiB;
constexpr size_t WS_WO = 124 * MiB;
constexpr size_t WS_W13 = 140 * MiB;
constexpr size_t WS_W2 = 396 * MiB;
constexpr size_t WS_H = 524 * MiB;
constexpr size_t WS_MX = 592 * MiB;
constexpr size_t WS_P = 660 * MiB;
constexpr size_t WS_XS = 660 * MiB;
constexpr size_t WS_HID = 804 * MiB;
constexpr size_t WS_H8 = 660 * MiB;
constexpr size_t WS_Y = 876 * MiB;
constexpr size_t WS_QR = 1052 * MiB, WS_QP = 1084 * MiB, WS_KR = 1116 * MiB, WS_VT = 1148 * MiB;
constexpr size_t WS_QC = 1180 * MiB, WS_KC = 1182 * MiB, WS_VCT = 1184 * MiB;
constexpr size_t WS_ATT = 1186 * MiB;
constexpr size_t WS_CONV = 1220 * MiB;
constexpr size_t WS_SC = 1237 * MiB;
constexpr size_t WS_XM = 1052 * MiB;
constexpr size_t WS_MSH = WS_ROPE + 16384;
constexpr size_t WS_TAB = 1254 * MiB;
constexpr size_t WS_U = 1258 * MiB;
constexpr size_t WS_MA2 = 1 * MiB + 768 * 1024;
constexpr size_t WS_X1 = 1276 * MiB;
constexpr size_t WS_END = 1340 * MiB;
static_assert(WS_P + (size_t)MT * PW * 2 <= WS_QR && WS_Y + (size_t)XS_ROWS * DM * 2 <= WS_QR && WS_XM + (size_t)MT * DM * 4 <= WS_CONV, "ws map");
constexpr int CW_BAR = 4096;

constexpr int RING_OFF = 0, RING_BYTES = 131072;
constexpr int MISC_OFF = RING_BYTES + 320;
constexpr int LDS_BYTES = 147456;

#define GAS __attribute__((address_space(1)))
#define CAS __attribute__((address_space(4)))
#define LAS __attribute__((address_space(3)))
#define LDS_WAIT() asm volatile("s_waitcnt lgkmcnt(0)" ::: "memory")
#define VM_WAIT() asm volatile("s_waitcnt vmcnt(0)" ::: "memory")
__device__ __forceinline__ unsigned f2bf(float f) { unsigned u = __builtin_bit_cast(unsigned, f); return (u + 0x7fffu + ((u >> 16) & 1u)) >> 16; }
__device__ __forceinline__ unsigned pk2(float lo, float hi) { return f2bf(lo) | (f2bf(hi) << 16); }
__device__ __forceinline__ float bflo(unsigned w) { return __builtin_bit_cast(float, w << 16); }
__device__ __forceinline__ float bfhi(unsigned w) { return __builtin_bit_cast(float, w & 0xffff0000u); }
__device__ __forceinline__ float bf1(bf16_t h) { return __builtin_bit_cast(float, ((unsigned)h) << 16); }
__device__ __forceinline__ float wave_sum(float v) {
#pragma unroll
    for (int o = 1; o < 64; o <<= 1) v += __shfl_xor(v, o);
    return v;
}
__device__ __forceinline__ float wave_max(float v) {
#pragma unroll
    for (int o = 1; o < 64; o <<= 1) v = fmaxf(v, __shfl_xor(v, o));
    return v;
}
__device__ __forceinline__ float sigmoidf_(float x) { return __builtin_amdgcn_rcpf(1.0f + __expf(-x)); }
__device__ __forceinline__ unsigned pk4_gate(float a, float b, float c, float d) {
    const unsigned fa = __float_as_uint(a * 255.0f + 8388608.0f), fb = __float_as_uint(b * 255.0f + 8388608.0f), fc = __float_as_uint(c * 255.0f + 8388608.0f), fd = __float_as_uint(d * 255.0f + 8388608.0f);
    return __builtin_amdgcn_perm(__builtin_amdgcn_perm(fd, fc, 0x0c0c0400u), __builtin_amdgcn_perm(fb, fa, 0x0c0c0400u), 0x05040100u);
}
__device__ __forceinline__ unsigned pk4_bytes(f32x4 f) {
    const unsigned fa = __float_as_uint(f.x), fb = __float_as_uint(f.y), fc = __float_as_uint(f.z), fd = __float_as_uint(f.w);
    return __builtin_amdgcn_perm(__builtin_amdgcn_perm(fd, fc, 0x0c0c0400u), __builtin_amdgcn_perm(fb, fa, 0x0c0c0400u), 0x05040100u);
}
__device__ __forceinline__ f32x4 gate4(unsigned w) { return (f32x4){(float)(w & 0xffu), (float)((w >> 8) & 0xffu), (float)((w >> 16) & 0xffu), (float)(w >> 24)}; }

#define XB_TMO      128
#define XB_XCNT(j)  (256  + 64 * (j))
#define XB_XSUB(j)  (1280 + 64 * (j))
#define XB_XGEN(j)  (2304 + 64 * (j))
#define XB_TOP      3328
#define XB_TOPGEN   3392
#define XCD_BAR_WORDS 3456
#define XB_SPIN_CAP (1u << 18)
__device__ __forceinline__ unsigned xb_ld(unsigned* p)              { return __hip_atomic_load(p, __ATOMIC_RELAXED, __HIP_MEMORY_SCOPE_AGENT); }
__device__ __forceinline__ unsigned xb_add(unsigned* p, unsigned v) { return __hip_atomic_fetch_add(p, v, __ATOMIC_RELAXED, __HIP_MEMORY_SCOPE_AGENT); }
__device__ __forceinline__ unsigned xb_xcc_id() { return (unsigned)__builtin_amdgcn_s_getreg((3 << 11) | 20) & 0xFu; }
#define XB_SPIN(cond, bar) do { unsigned _sp = 0; while (cond) { __builtin_amdgcn_s_sleep(1); \
    if ((++_sp & 255u) == 0u) { if (xb_ld(&(bar)[XB_TMO])) break; if (_sp > XB_SPIN_CAP) { atomicAdd(&(bar)[XB_TMO], 1u); break; } } } } while (0)
struct XcdBarrier { unsigned* bar; unsigned x; volatile LAS unsigned* st; bool w0; };
__device__ __forceinline__ XcdBarrier xcd_barrier_post(unsigned* bar, volatile LAS unsigned* st, bool w0) {
    XcdBarrier b; b.bar = bar; b.x = xb_xcc_id(); b.st = st; b.w0 = w0;
    if (b.w0 && mk_lane_id() == 0) (void)xb_add(&bar[XB_XCNT(b.x)], 1u);
    return b;
}
__device__ __forceinline__ void xcd_barrier_complete(unsigned* bar, unsigned x, unsigned& nloc, unsigned& nx) {
    const unsigned G = gridDim.x * gridDim.y * gridDim.z;
    unsigned sum, cnt, mine, sp = 0u;
    for (;;) {
        sum = 0u; cnt = 0u; mine = 0u;
#pragma unroll
        for (unsigned j = 0; j < 16; ++j) { const unsigned c = xb_ld(&bar[XB_XCNT(j)]); sum += c; cnt += (c > 0u) ? 1u : 0u; mine = (j == x) ? c : mine; }
        if (sum == G) break;
        __builtin_amdgcn_s_sleep(1);
        if ((++sp & 255u) == 0u) { if (xb_ld(&bar[XB_TMO])) break; if (sp > XB_SPIN_CAP) { atomicAdd(&bar[XB_TMO], 1u); break; } }
    }
    nloc = mine > 0u ? mine : 1u; nx = cnt > 0u ? cnt : 1u;
}
__device__ __forceinline__ void xcd_arrive(const XcdBarrier& b) {
    asm volatile("s_waitcnt vmcnt(0)" ::: "memory");
    __syncthreads();
    if (b.w0 && mk_lane_id() == 0) {
        unsigned* bar = b.bar;
        __builtin_amdgcn_s_waitcnt(0);
        unsigned nloc = b.st[0], nx = b.st[1];
        if (nloc == 0u) { xcd_barrier_complete(bar, b.x, nloc, nx); b.st[0] = nloc; b.st[1] = nx; }
        const unsigned old = xb_add(&bar[XB_XSUB(b.x)], 1u);
        const unsigned gen = old / nloc;
        if (old + 1u == (gen + 1u) * nloc) {
            __builtin_amdgcn_fence(__ATOMIC_RELEASE, "agent");
            asm volatile("s_waitcnt vmcnt(0)" ::: "memory");
            (void)xb_add(&bar[XB_TOP], 1u);
        }
        b.st[2] = (gen + 1u) * nx;
    }
}
__device__ __forceinline__ void xcd_wait(const XcdBarrier& b) {
    if (b.w0 && mk_lane_id() == 0) {
        unsigned* bar = b.bar;
        const unsigned target = b.st[2];
        XB_SPIN(xb_ld(&bar[XB_TOP]) < target, bar);
        __builtin_amdgcn_fence(__ATOMIC_ACQUIRE, "agent");
        asm volatile("s_waitcnt vmcnt(0)" ::: "memory");
    }
    __syncthreads();
}
__device__ __forceinline__ void xcd_barrier(const XcdBarrier& b) { xcd_arrive(b); xcd_wait(b); }

struct Frame {
    LAS unsigned char* lds;
    int tid, lane, wave, G, bx, gw, ngw;
    const CAS unsigned char* karg;
    unsigned char* ws; float* out;
    __device__ __forceinline__ const float* in(int i) const { return ((const float* const CAS*)karg)[i]; }
};
__device__ __forceinline__ Frame fresh(const Frame& F0) {
    Frame R; unsigned long long k = (unsigned long long)F0.karg; int t = F0.wave * 64 + mk_lane_id(), g = gridDim.x, bx = blockIdx.x; asm volatile("" : "+s"(k), "+v"(t), "+s"(g), "+s"(bx));
    R.karg = (const CAS unsigned char*)k; R.lds = F0.lds; R.tid = t; R.lane = t & 63; R.wave = F0.wave; R.G = g; R.bx = bx; R.gw = bx * NWAVES + R.wave; R.ngw = g * NWAVES;
    R.out = ((float* const CAS*)R.karg)[26]; R.ws = ((unsigned char* const CAS*)R.karg)[27]; return R;
}
enum { I_X = 0, I_C, I_CTX, I_CCTX, I_WADA, I_BADA, I_GN1, I_GN2, I_WIN, I_BIN, I_GQ, I_GK, I_RPB, I_WAO, I_CDW, I_CDB, I_CLG, I_CLB, I_WCO, I_SCW, I_WSO, I_WO, I_WR, I_WE1, I_WE3, I_WE2 };

__device__ __forceinline__ void conv_item(const float* W, int K, int N, bf16_t* WT, int k0, int n0, int drow0, LAS float* scr, int lane) {
    { const int rr = lane >> 3, cq = lane & 7; f32x4 t[8];
#pragma unroll
      for (int i = 0; i < 8; ++i) t[i] = *(const f32x4*)(W + (size_t)(k0 + 8 * i + rr) * N + n0 + 4 * cq);
#pragma unroll
      for (int i = 0; i < 8; ++i) { LAS float* d = scr + (8 * i + rr) * 33 + 4 * cq; d[0] = t[i].x; d[1] = t[i].y; d[2] = t[i].z; d[3] = t[i].w; } }
    LDS_WAIT(); asm volatile("" ::: "memory");
    const int c = lane & 7;
#pragma unroll
    for (int j = 0; j < 4; ++j) { const int n = (lane >> 3) + 8 * j; const LAS float* s = scr + (8 * c) * 33 + n;
        u32x4 o; o.x = pk2(s[0 * 33], s[1 * 33]); o.y = pk2(s[2 * 33], s[3 * 33]); o.z = pk2(s[4 * 33], s[5 * 33]); o.w = pk2(s[6 * 33], s[7 * 33]);
        *(u32x4*)(WT + (size_t)(drow0 + n) * K + k0 + 8 * c) = o; }
    LDS_WAIT(); asm volatile("" ::: "memory");
}
__device__ __forceinline__ unsigned pk4_fp8(float a, float b, float c, float d) { int r = __builtin_amdgcn_cvt_pk_fp8_f32(a, b, 0, false); r = __builtin_amdgcn_cvt_pk_fp8_f32(c, d, r, true); return (unsigned)r; }
__device__ __forceinline__ void conv_item8(const float* W, int K, int N, unsigned char* WT, int k0, int n0, int drow0, float scale, LAS float* scr, int lane) {
    { const int rr = lane >> 3, cq = lane & 7; f32x4 t[8];
#pragma unroll
      for (int i = 0; i < 8; ++i) t[i] = *(const f32x4*)(W + (size_t)(k0 + 8 * i + rr) * N + n0 + 4 * cq);
#pragma unroll
      for (int i = 0; i < 8; ++i) { LAS float* d = scr + (8 * i + rr) * 33 + 4 * cq; d[0] = t[i].x; d[1] = t[i].y; d[2] = t[i].z; d[3] = t[i].w; } }
    LDS_WAIT(); asm volatile("" ::: "memory");
    const int c = lane & 7;
#pragma unroll
    for (int j = 0; j < 4; ++j) { const int n = (lane >> 3) + 8 * j; const LAS float* s = scr + (8 * c) * 33 + n;
        u32x2 o; o.x = pk4_fp8(s[0 * 33] * scale, s[1 * 33] * scale, s[2 * 33] * scale, s[3 * 33] * scale); o.y = pk4_fp8(s[4 * 33] * scale, s[5 * 33] * scale, s[6 * 33] * scale, s[7 * 33] * scale);
        *(u32x2*)(WT + (size_t)(drow0 + n) * K + k0 + 8 * c) = o; }
    LDS_WAIT(); asm volatile("" ::: "memory");
}
constexpr float W13_SCALE = 64.0f, W2_SCALE = 32.0f;
constexpr int CI_IN = 32 * 368, CI_AO = 16 * 64, CI_CO = 8 * 64, CI_SO = 8 * 64, CI_O = 32 * 64, CI_E1 = 16 * 32 * 32, CI_E3 = CI_E1, CI_E2 = 16 * 16 * 64;
constexpr int CI_LAYER = CI_IN + CI_AO + CI_CO + CI_SO + CI_O + CI_E1 + CI_E3 + CI_E2;
constexpr int ADA_ITEMS = 2 * 16 * 48;

__device__ __forceinline__ void ada_item(const Frame& F, int it, LAS float* scr) {
    const int lane = F.lane;
    const int l = it / 768, r = it % 768, kc = r / 48, cg = r % 48;
    const float* c = F.in(I_C); const float* cc = F.in(I_CCTX);
    for (int q = lane; q < 640; q += 64) { const int v = q >> 7, rr = q & 127, k = kc * 128 + rr; const float cv = (v < 4) ? c[v * DM + k] : cc[k]; scr[q] = cv / (1.0f + expf(-cv)); }
    LDS_WAIT(); asm volatile("" ::: "memory");
    f32x4 acc[5];
#pragma unroll
    for (int v = 0; v < 5; ++v) acc[v] = (f32x4){0.f, 0.f, 0.f, 0.f};
    const float* wp = F.in(I_WADA) + (size_t)l * DM * 12288 + (size_t)(kc * 128) * 12288 + cg * 256 + lane * 4;
#pragma unroll 8
    for (int rr = 0; rr < 128; ++rr) { const f32x4 w = *(const f32x4*)(wp + (size_t)rr * 12288);
#pragma unroll
        for (int v = 0; v < 5; ++v) acc[v] += w * scr[v * 128 + rr]; }
#pragma unroll
    for (int v = 0; v < 5; ++v) *(f32x4*)(((float*)(F.ws + WS_ADAP)) + (size_t)((l * 16 + kc) * 5 + v) * 12288 + cg * 256 + lane * 4) = acc[v];
    LDS_WAIT(); asm volatile("" ::: "memory");
}

struct PaDesc { const float* src; unsigned char* dst; int N, K, fp8; float scale; };
__device__ __forceinline__ void pa_desc(const Frame& F, int it, PaDesc& D) {
    int r = it - ADA_ITEMS; const int l = r / CI_LAYER; r -= l * CI_LAYER;
    int inp, kb, nb, drow0, N, K, fp8 = 0; size_t soff, doff; float sc = 1.0f;
    if (r < CI_IN) { kb = r / 368; nb = r % 368; inp = I_WIN; soff = (size_t)l * DM * PW; N = PW; K = DM; doff = WS_WIN + (size_t)l * PW * DM * 2; drow0 = 32 * nb; }
    else if ((r -= CI_IN) < CI_AO) { kb = r / 64; nb = r % 64; inp = I_WAO; soff = (size_t)l * AW * DM; N = DM; K = AW; doff = WS_WAO + (size_t)l * DM * AW * 2; drow0 = 32 * nb; }
    else if ((r -= CI_AO) < CI_CO) { kb = r / 64; nb = r % 64; inp = I_WCO; soff = (size_t)l * CWD * DM; N = DM; K = CWD; doff = WS_WCO + (size_t)l * DM * CWD * 2; drow0 = 32 * nb; }
    else if ((r -= CI_CO) < CI_SO) { kb = r / 64; nb = r % 64; inp = I_WSO; soff = (size_t)l * SWD * DM; N = DM; K = SWD; doff = WS_WSO + (size_t)l * DM * SWD * 2; drow0 = 32 * nb; }
    else if ((r -= CI_SO) < CI_O) { kb = r / 64; nb = r % 64; inp = I_WO; soff = (size_t)l * DM * DM; N = DM; K = DM; doff = WS_WO + (size_t)l * DM * DM * 2; drow0 = 32 * nb; }
    else if ((r -= CI_O) < CI_E1 + CI_E3) { const int w3 = r >= CI_E1; if (w3) r -= CI_E1; const int e = r / 1024, q = r % 1024; kb = q / 32; nb = q % 32; const int n0 = 32 * nb;
        inp = w3 ? I_WE3 : I_WE1; soff = (size_t)(l * NE + e) * DM * FF; N = FF; K = DM; doff = WS_W13 + (size_t)(l * NE + e) * 2048 * DM; drow0 = (n0 >> 7) * 256 + (n0 & 127) + (w3 ? 128 : 0); fp8 = 1; sc = W13_SCALE; }
    else { r -= CI_E1 + CI_E3; const int e = r / 1024, q = r % 1024; kb = q / 64; nb = q % 64; inp = I_WE2; soff = (size_t)(l * NE + e) * FF * DM; N = DM; K = FF; doff = WS_W2 + (size_t)(l * NE + e) * DM * FF; drow0 = 32 * nb; fp8 = 1; sc = W2_SCALE; }
    D.src = F.in(inp) + soff + (size_t)(64 * kb) * N + 32 * nb; D.N = N; D.K = K; D.fp8 = fp8; D.scale = sc;
    D.dst = F.ws + doff + ((size_t)drow0 * K + 64 * kb) * (fp8 ? 1 : 2);
}
__device__ __forceinline__ void phase_pa(const Frame& F0) {
    const Frame F = fresh(F0);
    LAS float* scr = (LAS float*)(F.lds + RING_OFF + F.wave * 16384);
    const int lane = F.lane;
    const int total = ADA_ITEMS + 2 * CI_LAYER;
    if (F.gw == 0) {
        for (int l = 0; l < NL; ++l) { float mq = fabsf(F.in(I_GQ)[l * 64 + lane]), mk = fabsf(F.in(I_GK)[l * 64 + lane]), mr = 0.f;
            for (int i = lane; i < NH * 15 * 31; i += 64) mr = fmaxf(mr, fabsf(F.in(I_RPB)[l * NH * 15 * 31 + i]));
            mq = wave_max(mq); mk = wave_max(mk); mr = wave_max(mr);
            if (lane == 0) ((float*)(F.ws + WS_MSH))[l] = 8.1f * mq * mk + mr; }
    }
    int it = F.gw;
    while (it < ADA_ITEMS) { ada_item(F, it, scr); it += F.ngw; }
    const int rr = lane >> 3, cq = lane & 7, c = lane & 7;
    PaDesc D; f32x4 t[8];
    if (it < total) { pa_desc(F, it, D);
#pragma unroll
        for (int i = 0; i < 8; ++i) t[i] = *(const GAS f32x4*)(D.src + (size_t)(8 * i + rr) * D.N + 4 * cq); }
#pragma nounroll
    for (; it < total; it += F.ngw) {
#pragma unroll
        for (int i = 0; i < 8; ++i) { LAS float* d = scr + (8 * i + rr) * 33 + 4 * cq; d[0] = t[i].x; d[1] = t[i].y; d[2] = t[i].z; d[3] = t[i].w; }
        const PaDesc C = D;
        asm volatile("" ::: "memory");
        if (it + F.ngw < total) { pa_desc(F, it + F.ngw, D);
#pragma unroll
            for (int i = 0; i < 8; ++i) t[i] = *(const GAS f32x4*)(D.src + (size_t)(8 * i + rr) * D.N + 4 * cq); }
        asm volatile("" ::: "memory");
        LDS_WAIT(); asm volatile("" ::: "memory");
        if (C.fp8) {
#pragma unroll
            for (int j = 0; j < 4; ++j) { const int n = (lane >> 3) + 8 * j; const LAS float* sp = scr + (8 * c) * 33 + n; const float scale = C.scale;
                u32x2 o; o.x = pk4_fp8(sp[0 * 33] * scale, sp[1 * 33] * scale, sp[2 * 33] * scale, sp[3 * 33] * scale); o.y = pk4_fp8(sp[4 * 33] * scale, sp[5 * 33] * scale, sp[6 * 33] * scale, sp[7 * 33] * scale);
                *(GAS u32x2*)(C.dst + (size_t)n * C.K + 8 * c) = o; }
        } else {
#pragma unroll
            for (int j = 0; j < 4; ++j) { const int n = (lane >> 3) + 8 * j; const LAS float* sp = scr + (8 * c) * 33 + n;
                u32x4 o; o.x = pk2(sp[0 * 33], sp[1 * 33]); o.y = pk2(sp[2 * 33], sp[3 * 33]); o.z = pk2(sp[4 * 33], sp[5 * 33]); o.w = pk2(sp[6 * 33], sp[7 * 33]);
                *(GAS u32x4*)(C.dst + ((size_t)n * C.K + 8 * c) * 2) = o; }
        }
        LDS_WAIT(); asm volatile("" ::: "memory");
    }
}
__device__ __forceinline__ void phase_pa2(const Frame& F0) {
    const Frame F = fresh(F0);
    const int gt = F.bx * 512 + F.tid, nt = F.G * 512;
    for (int i = gt; i < 2 * 5 * 12288; i += nt) { const int l = i / 61440, r = i % 61440, v = r / 12288, n = r % 12288;
        float s = F.in(I_BADA)[l * 12288 + n];
#pragma unroll
        for (int kc = 0; kc < 16; ++kc) s += ((float*)(F.ws + WS_ADAP))[(size_t)((l * 16 + kc) * 5 + v) * 12288 + n];
        ((float*)(F.ws + WS_MOD))[i] = s; }
    for (int i = gt; i < 2 * 5 * DM; i += nt) { const int l = i / (5 * DM), r = i % (5 * DM), v = r / DM, c = r % DM, n = 4 * DM + c;
        float s = F.in(I_BADA)[l * 12288 + n];
#pragma unroll
        for (int kc = 0; kc < 16; ++kc) s += ((float*)(F.ws + WS_ADAP))[(size_t)((l * 16 + kc) * 5 + v) * 12288 + n];
        ((float*)(F.ws + WS_MA2))[i] = F.in(I_GN2)[l * DM + c] * (s + 1.0f); }
    for (int idx = gt; idx < NL * NH * 15 * 64; idx += nt) {
        const int dd = (idx & 63) - 16, ro = (idx >> 6) % 15, lh = (idx >> 6) / 15;
        ((float*)(F.ws + WS_TAB))[idx] = (dd >= 0 && dd < 31) ? (F.in(I_RPB)[(lh * 15 + ro) * 31 + dd] - ((const float*)(F.ws + WS_MSH))[lh >> 4]) * LOG2E : 0.f; }
    for (int i = gt; i < 1024; i += nt) { const int pos = i >> 4, f = i & 15; const float freq = 1.0f / powf(10000.0f, (float)f * (1.0f / 16.0f)); const float ang = (float)pos * freq;
        ((float*)(F.ws + WS_ROPE))[2 * i] = cosf(ang); ((float*)(F.ws + WS_ROPE))[2 * i + 1] = sinf(ang); }
}

__device__ __forceinline__ const float* xrow_ptr(const Frame& F, int lx, int row) {
    if (lx == 0) return (row < ML) ? F.in(I_X) + (size_t)row * DM : F.in(I_CTX) + (size_t)(row - ML) * DM;
    return F.out + (size_t)row * DM;
}
__device__ __forceinline__ void load_row_f32(const float* p, int lane, f32x4 (&v)[8]) {
#pragma unroll
    for (int j = 0; j < 4; ++j) { v[2 * j] = *(const f32x4*)(p + 8 * lane + 512 * j); v[2 * j + 1] = *(const f32x4*)(p + 8 * lane + 512 * j + 4); }
}
__device__ __forceinline__ void combine_rows2(const Frame& F, int lprev, const int (&row)[2], const bool (&ok)[2], f32x4 (&v)[2][8]) {
    const int lane = F.lane;
    f32x4 a[2][8]; int sl[2]; bool lat[2]; int bb[2];
#pragma unroll
    for (int u = 0; u < 2; ++u) { lat[u] = row[u] < ML; bb[u] = lat[u] ? (row[u] >> 12) : ((row[u] - ML) >> 8);
        if (ok[u]) { if (lprev == 0) load_row_f32(xrow_ptr(F, 0, row[u]), lane, v[u]);
            else { const bf16_t* xb = ((const bf16_t*)(F.ws + WS_X1)) + (size_t)row[u] * DM + 8 * lane;
#pragma unroll
                for (int j = 0; j < 4; ++j) { const u32x4 w = *(const u32x4*)(xb + 512 * j); v[u][2 * j] = (f32x4){bflo(w.x), bfhi(w.x), bflo(w.y), bfhi(w.y)}; v[u][2 * j + 1] = (f32x4){bflo(w.z), bfhi(w.z), bflo(w.w), bfhi(w.w)}; } }
            const bf16_t* dl = ((const bf16_t*)(F.ws + WS_XM)) + (size_t)row[u] * DM + 8 * lane;
#pragma unroll
            for (int j = 0; j < 4; ++j) { const u32x4 w = *(const u32x4*)(dl + 512 * j);
                v[u][2 * j] += (f32x4){bflo(w.x), bfhi(w.x), bflo(w.y), bfhi(w.y)}; v[u][2 * j + 1] += (f32x4){bflo(w.z), bfhi(w.z), bflo(w.w), bfhi(w.w)}; } }
        sl[u] = (ok[u] && lane < 16) ? ((const int*)(F.ws + WS_SLOT))[(size_t)row[u] * 16 + lane] : 0x7fffffff;
#pragma unroll
        for (int j = 0; j < 8; ++j) a[u][j] = (f32x4){0.f, 0.f, 0.f, 0.f}; }
    for (int e = 0; e < 16; ++e) {
#pragma unroll
        for (int u = 0; u < 2; ++u) {
            const int sv = __builtin_amdgcn_readlane(sl[u], e);
            if (sv < (lat[u] ? CAP_L : CAP_C)) {
                const int yr = lat[u] ? ((e * 4 + bb[u]) * 512 + sv) : (32768 + e * 256 + bb[u] * 32 + sv);
                const bf16_t* yp = ((bf16_t*)(F.ws + WS_Y)) + (size_t)yr * DM + 8 * lane;
#pragma unroll
                for (int j = 0; j < 4; ++j) { const u32x4 w = *(const u32x4*)(yp + 512 * j);
                    a[u][2 * j] += (f32x4){bflo(w.x), bfhi(w.x), bflo(w.y), bfhi(w.y)}; a[u][2 * j + 1] += (f32x4){bflo(w.z), bfhi(w.z), bflo(w.w), bfhi(w.w)}; }
            }
        }
    }
#pragma unroll
    for (int u = 0; u < 2; ++u) {
        const float* g2 = ((float*)(F.ws + WS_MOD)) + (size_t)(lprev * 5 + (lat[u] ? bb[u] : 4)) * 12288 + 5 * DM + 8 * lane;
#pragma unroll
        for (int j = 0; j < 4; ++j) { const f32x4 m0 = *(const f32x4*)(g2 + 512 * j), m1 = *(const f32x4*)(g2 + 512 * j + 4); v[u][2 * j] += m0 * a[u][2 * j]; v[u][2 * j + 1] += m1 * a[u][2 * j + 1]; } }
}
__device__ __forceinline__ void phase_norm1(const Frame& F0, int l) {
    const Frame F = fresh(F0);
    const int lane = F.lane;
    for (int r0 = F.gw; r0 < MT; r0 += 2 * F.ngw) {
        const int row[2] = {r0, r0 + F.ngw}; const bool ok[2] = {true, r0 + F.ngw < MT};
        f32x4 v[2][8];
        if (l == 0) {
#pragma unroll
            for (int u = 0; u < 2; ++u) if (ok[u]) { if (row[u] < ML) load_row_f32(F.in(I_X) + (size_t)row[u] * DM, lane, v[u]); else load_row_f32(F.in(I_CTX) + (size_t)(row[u] - ML) * DM, lane, v[u]); }
        } else {
            combine_rows2(F, l - 1, row, ok, v);
#pragma unroll
            for (int u = 0; u < 2; ++u) if (ok[u] && row[u] < ML) {
#pragma unroll
                for (int j = 0; j < 4; ++j) { u32x4 o; o.x = pk2(v[u][2 * j].x, v[u][2 * j].y); o.y = pk2(v[u][2 * j].z, v[u][2 * j].w); o.z = pk2(v[u][2 * j + 1].x, v[u][2 * j + 1].y); o.w = pk2(v[u][2 * j + 1].z, v[u][2 * j + 1].w);
                    *(u32x4*)(((bf16_t*)(F.ws + WS_X1)) + (size_t)row[u] * DM + 8 * lane + 512 * j) = o; } }
        }
#pragma unroll
        for (int u = 0; u < 2; ++u) if (ok[u]) {
            const int bs = row[u] < ML ? (row[u] >> 12) : 4;
            float ss = 0.f;
#pragma unroll
            for (int j = 0; j < 8; ++j) ss += (v[u][j].x * v[u][j].x + v[u][j].y * v[u][j].y) + (v[u][j].z * v[u][j].z + v[u][j].w * v[u][j].w);
            const float rinv = 1.0f / sqrtf(wave_sum(ss) * (1.0f / DM) + EPS);
            const float* g1 = F.in(I_GN1) + l * DM + 8 * lane; const float* md = ((float*)(F.ws + WS_MOD)) + (size_t)(l * 5 + bs) * 12288 + 8 * lane;
#pragma unroll
            for (int j = 0; j < 4; ++j) {
                const f32x4 ga = *(const f32x4*)(g1 + 512 * j), gb = *(const f32x4*)(g1 + 512 * j + 4);
                const f32x4 sha = *(const f32x4*)(md + 512 * j), shb = *(const f32x4*)(md + 512 * j + 4);
                const f32x4 sca = *(const f32x4*)(md + DM + 512 * j), scb = *(const f32x4*)(md + DM + 512 * j + 4);
                const f32x4 ha = (v[u][2 * j] * rinv * ga) * (sca + 1.0f) + sha, hb = (v[u][2 * j + 1] * rinv * gb) * (scb + 1.0f) + shb;
                u32x4 o; o.x = pk2(ha.x, ha.y); o.y = pk2(ha.z, ha.w); o.z = pk2(hb.x, hb.y); o.w = pk2(hb.z, hb.w);
                *(u32x4*)(((bf16_t*)(F.ws + WS_H)) + (size_t)row[u] * DM + 8 * lane + 512 * j) = o; }
        }
    }
}
__device__ __forceinline__ void phase_final(const Frame& F0) {
    const Frame F = fresh(F0);
    const int lane = F.lane;
    for (int r0 = F.gw; r0 < ML; r0 += 2 * F.ngw) {
        const int row[2] = {r0, r0 + F.ngw}; const bool ok[2] = {true, r0 + F.ngw < ML};
        f32x4 v[2][8]; combine_rows2(F, NL - 1, row, ok, v);
#pragma unroll
        for (int u = 0; u < 2; ++u) if (ok[u]) {
#pragma unroll
            for (int j = 0; j < 4; ++j) { *(f32x4*)(F.out + (size_t)row[u] * DM + 8 * lane + 512 * j) = v[u][2 * j]; *(f32x4*)(F.out + (size_t)row[u] * DM + 8 * lane + 512 * j + 4) = v[u][2 * j + 1]; } }
    }
}

struct EpiProj {
    static constexpr bool PERM = true;
    bf16_t* O; const float* bias;
    __device__ __forceinline__ void operator()(const f32x4 (&acc)[2][2][4][2], const pg8::Unit& u, int wr, int wc, int fr, int fq) const {
        const int row0 = u.pm * 256 + wr * 64 + fr, col0 = u.pn * 256 + wc * 32 + 8 * fq; const bool sg = u.pn >= (GATE_COL / 256);
        f32x4 bv[2][2];
#pragma unroll
        for (int bj = 0; bj < 2; ++bj)
#pragma unroll
            for (int n = 0; n < 2; ++n) bv[bj][n] = *(const f32x4*)(bias + col0 + bj * 128 + 4 * n);
#pragma unroll
        for (int ai = 0; ai < 2; ++ai)
#pragma unroll
            for (int m = 0; m < 4; ++m) { bf16_t* rowp = O + (size_t)(row0 + ai * 128 + m * 16) * PW + col0;
#pragma unroll
                for (int bj = 0; bj < 2; ++bj) { f32x4 v0 = acc[ai][bj][m][0] + bv[bj][0], v1 = acc[ai][bj][m][1] + bv[bj][1];
                    if (sg) {
                        u32x2 q; q.x = pk4_gate(sigmoidf_(v0.x), sigmoidf_(v0.y), sigmoidf_(v0.z), sigmoidf_(v0.w)); q.y = pk4_gate(sigmoidf_(v1.x), sigmoidf_(v1.y), sigmoidf_(v1.z), sigmoidf_(v1.w));
                        *(u32x2*)((unsigned char*)rowp + (GATE_COL - col0) + bj * 128) = q; continue; }
                    u32x4 w; w.x = cvt_pk_bf16(v0[0], v0[1]); w.y = cvt_pk_bf16(v0[2], v0[3]); w.z = cvt_pk_bf16(v1[0], v1[1]); w.w = cvt_pk_bf16(v1[2], v1[3]);
                    *(u32x4*)(rowp + bj * 128) = w; } }
    }
};
template <bool ACCUM> struct EpiGate {
    static constexpr bool PERM = true;
    bf16_t* O; const unsigned char* Pg;
    __device__ __forceinline__ void operator()(const f32x4 (&acc)[2][2][4][2], const pg8::Unit& u, int wr, int wc, int fr, int fq) const {
        const int row0 = u.pm * 256 + wr * 64 + fr, col0 = u.pn * 256 + wc * 32 + 8 * fq;
        u32x2 gw[2][4][2];
#pragma unroll
        for (int ai = 0; ai < 2; ++ai)
#pragma unroll
            for (int m = 0; m < 4; ++m)
#pragma unroll
                for (int bj = 0; bj < 2; ++bj) gw[ai][m][bj] = *(const u32x2*)(Pg + (size_t)(row0 + ai * 128 + m * 16) * (PW * 2) + col0 + bj * 128);
#pragma unroll
        for (int ai = 0; ai < 2; ++ai) {
            u32x4 pw[4][2];
            if (ACCUM) {
#pragma unroll
                for (int m = 0; m < 4; ++m)
#pragma unroll
                    for (int bj = 0; bj < 2; ++bj) pw[m][bj] = *(const u32x4*)(O + (size_t)(row0 + ai * 128 + m * 16) * DM + col0 + bj * 128);
            }
#pragma unroll
            for (int m = 0; m < 4; ++m) { const size_t row = (size_t)(row0 + ai * 128 + m * 16);
#pragma unroll
                for (int bj = 0; bj < 2; ++bj) {
                    f32x4 v0 = acc[ai][bj][m][0] * gate4(gw[ai][m][bj].x), v1 = acc[ai][bj][m][1] * gate4(gw[ai][m][bj].y);
                    if (ACCUM) { const u32x4 p = pw[m][bj]; v0 = v0 * (1.0f / 255.0f) + (f32x4){bflo(p.x), bfhi(p.x), bflo(p.y), bfhi(p.y)}; v1 = v1 * (1.0f / 255.0f) + (f32x4){bflo(p.z), bfhi(p.z), bflo(p.w), bfhi(p.w)}; }
                    else { v0 *= (1.0f / 255.0f); v1 *= (1.0f / 255.0f); }
                    u32x4 w; w.x = cvt_pk_bf16(v0[0], v0[1]); w.y = cvt_pk_bf16(v0[2], v0[3]); w.z = cvt_pk_bf16(v1[0], v1[1]); w.w = cvt_pk_bf16(v1[2], v1[3]);
                    *(u32x4*)(O + row * DM + col0 + bj * 128) = w; } }
        }
    }
};
struct EpiDelta {
    static constexpr bool PERM = true;
    bf16_t* O; const float* mod;
    __device__ __forceinline__ void operator()(const f32x4 (&acc)[2][2][4][2], const pg8::Unit& u, int wr, int wc, int fr, int fq) const {
        const int row0 = u.pm * 256 + wr * 64 + fr, col0 = u.pn * 256 + wc * 32 + 8 * fq;
        const int bs = (u.pm < 64) ? (u.pm >> 4) : 4;
        f32x4 mv[2][2];
#pragma unroll
        for (int bj = 0; bj < 2; ++bj)
#pragma unroll
            for (int n = 0; n < 2; ++n) mv[bj][n] = *(const f32x4*)(mod + (size_t)bs * 12288 + col0 + bj * 128 + 4 * n);
#pragma unroll
        for (int ai = 0; ai < 2; ++ai)
#pragma unroll
            for (int m = 0; m < 4; ++m) { bf16_t* rowp = O + (size_t)(row0 + ai * 128 + m * 16) * DM + col0;
#pragma unroll
                for (int bj = 0; bj < 2; ++bj) { const f32x4 v0 = acc[ai][bj][m][0] * mv[bj][0], v1 = acc[ai][bj][m][1] * mv[bj][1];
                    u32x4 w; w.x = cvt_pk_bf16(v0[0], v0[1]); w.y = cvt_pk_bf16(v0[2], v0[3]); w.z = cvt_pk_bf16(v1[0], v1[1]); w.w = cvt_pk_bf16(v1[2], v1[3]);
                    *(u32x4*)(rowp + bj * 128) = w; } }
    }
};
struct EpiSwiglu {
    static constexpr bool PERM = true;
    unsigned char* O;
    __device__ __forceinline__ void operator()(const f32x4 (&acc)[2][2][4][2], const pg8::Unit& u, int wr, int wc, int fr, int fq) const {
        const int row0 = u.pm * 256 + wr * 64 + fr, col0 = u.pn * 128 + wc * 32 + 8 * fq; constexpr float SC = 1.0f / W13_SCALE;
#pragma unroll
        for (int ai = 0; ai < 2; ++ai)
#pragma unroll
            for (int m = 0; m < 4; ++m) { float h[8];
#pragma unroll
                for (int n = 0; n < 2; ++n)
#pragma unroll
                    for (int q = 0; q < 4; ++q) { const float a = acc[ai][0][m][n][q] * SC, b3 = acc[ai][1][m][n][q] * SC; h[4 * n + q] = a * sigmoidf_(a) * b3; }
                u32x2 w; w.x = pk4_fp8(h[0], h[1], h[2], h[3]); w.y = pk4_fp8(h[4], h[5], h[6], h[7]);
                *(u32x2*)(O + (size_t)(row0 + ai * 128 + m * 16) * FF + col0) = w; }
    }
};
struct EpiY {
    static constexpr bool PERM = true;
    bf16_t* O; const float* gate;
    __device__ __forceinline__ void operator()(const f32x4 (&acc)[2][2][4][2], const pg8::Unit& u, int wr, int wc, int fr, int fq) const {
        const int row0 = u.pm * 256 + wr * 64 + fr, col0 = u.pn * 256 + wc * 32 + 8 * fq;
        float gts[2][4];
#pragma unroll
        for (int ai = 0; ai < 2; ++ai)
#pragma unroll
            for (int m = 0; m < 4; ++m) gts[ai][m] = gate[row0 + ai * 128 + m * 16];
#pragma unroll
        for (int ai = 0; ai < 2; ++ai)
#pragma unroll
            for (int m = 0; m < 4; ++m) { const int row = row0 + ai * 128 + m * 16; const float gt = gts[ai][m] * (1.0f / W2_SCALE);
#pragma unroll
                for (int bj = 0; bj < 2; ++bj) { const f32x4 v0 = acc[ai][bj][m][0] * gt, v1 = acc[ai][bj][m][1] * gt;
                    u32x4 w; w.x = cvt_pk_bf16(v0[0], v0[1]); w.y = cvt_pk_bf16(v0[2], v0[3]); w.z = cvt_pk_bf16(v1[0], v1[1]); w.w = cvt_pk_bf16(v1[2], v1[3]);
                    *(u32x4*)(O + (size_t)row * DM + col0 + bj * 128) = w; } }
    }
};

__device__ __forceinline__ void load64bf(const bf16_t* p, float (&x)[64]) {
#pragma unroll
    for (int i = 0; i < 8; ++i) { const u32x4 w = *(const u32x4*)(p + 8 * i);
        x[8 * i + 0] = bflo(w.x); x[8 * i + 1] = bfhi(w.x); x[8 * i + 2] = bflo(w.y); x[8 * i + 3] = bfhi(w.y); x[8 * i + 4] = bflo(w.z); x[8 * i + 5] = bfhi(w.z); x[8 * i + 6] = bflo(w.w); x[8 * i + 7] = bfhi(w.w); }
}
__device__ __forceinline__ void store64bf(bf16_t* p, const float (&x)[64]) {
#pragma unroll
    for (int i = 0; i < 8; ++i) { u32x4 w; w.x = pk2(x[8 * i], x[8 * i + 1]); w.y = pk2(x[8 * i + 2], x[8 * i + 3]); w.z = pk2(x[8 * i + 4], x[8 * i + 5]); w.w = pk2(x[8 * i + 6], x[8 * i + 7]); *(u32x4*)(p + 8 * i) = w; }
}
__device__ __forceinline__ void headnorm(float (&x)[64], const float* g) {
    float ss = 0.f;
#pragma unroll
    for (int i = 0; i < 64; ++i) ss += x[i] * x[i];
    const float rinv = 1.0f / sqrtf(ss * (1.0f / 64.0f) + EPS);
#pragma unroll
    for (int i = 0; i < 64; ++i) x[i] = x[i] * rinv * g[i];
}
__device__ __forceinline__ void rope64(float (&x)[64], const float* rrow, const float* rcol) {
#pragma unroll
    for (int i = 0; i < 16; ++i) { const float c = rrow[2 * i], s = rrow[2 * i + 1]; const float a = x[i], b = x[i + 16]; x[i] = a * c - b * s; x[i + 16] = b * c + a * s; }
#pragma unroll
    for (int i = 0; i < 16; ++i) { const float c = rcol[2 * i], s = rcol[2 * i + 1]; const float a = x[32 + i], b = x[48 + i]; x[32 + i] = a * c - b * s; x[48 + i] = b * c + a * s; }
}
template <bool PLAIN, bool ROT>
__device__ __forceinline__ void prep_head(const u32x4 (&w)[8], const f32x4 g0, const f32x4 g1, bf16_t* plain_dst, bf16_t* rot_dst, const float* rope, int rowpos, int rsub, int c) {
#pragma unroll
    for (int j = 0; j < 8; ++j) {
        float x[8] = {bflo(w[j].x), bfhi(w[j].x), bflo(w[j].y), bfhi(w[j].y), bflo(w[j].z), bfhi(w[j].z), bflo(w[j].w), bfhi(w[j].w)};
        float ss = 0.f;
#pragma unroll
        for (int e = 0; e < 8; ++e) ss += x[e] * x[e];
        ss += __shfl_xor(ss, 1); ss += __shfl_xor(ss, 2); ss += __shfl_xor(ss, 4);
        const float rinv = 1.0f / sqrtf(ss * (1.0f / 64.0f) + EPS);
        x[0] *= rinv * g0.x; x[1] *= rinv * g0.y; x[2] *= rinv * g0.z; x[3] *= rinv * g0.w; x[4] *= rinv * g1.x; x[5] *= rinv * g1.y; x[6] *= rinv * g1.z; x[7] *= rinv * g1.w;
        const size_t o = (size_t)(8 * j) * 64;
        if constexpr (PLAIN) { u32x4 p; p.x = pk2(x[0], x[1]); p.y = pk2(x[2], x[3]); p.z = pk2(x[4], x[5]); p.w = pk2(x[6], x[7]); *(GAS u32x4*)(plain_dst + o) = p; }
        if constexpr (ROT) {
            const int pos = (c < 4) ? rowpos : (8 * j + rsub);
            const float* rp = rope + pos * 32 + 16 * (c & 1);
            const f32x4 t0 = *(const GAS f32x4*)rp, t1 = *(const GAS f32x4*)(rp + 4), t2 = *(const GAS f32x4*)(rp + 8), t3 = *(const GAS f32x4*)(rp + 12);
            const float cs[8] = {t0.x, t0.z, t1.x, t1.z, t2.x, t2.z, t3.x, t3.z}, sn[8] = {t0.y, t0.w, t1.y, t1.w, t2.y, t2.w, t3.y, t3.w};
            const float sg = (c & 2) ? 1.0f : -1.0f;
            float y[8];
#pragma unroll
            for (int e = 0; e < 8; ++e) { const float xp = __shfl_xor(x[e], 2); y[e] = x[e] * cs[e] + sg * xp * sn[e]; }
            u32x4 p; p.x = pk2(y[0], y[1]); p.y = pk2(y[2], y[3]); p.z = pk2(y[4], y[5]); p.w = pk2(y[6], y[7]); *(GAS u32x4*)(rot_dst + o) = p; }
    }
}
__device__ __forceinline__ void phase_prep(const Frame& F0, int l) {
    const Frame Fp = fresh(F0); const Frame& F = Fp;
    const int lane = F.lane, rsub = lane >> 3, c = lane & 7;
    LAS unsigned* scr = (LAS unsigned*)(F.lds + RING_OFF + F.wave * 16384);
    const float* gqp = F.in(I_GQ) + l * 64 + 8 * c; const float* gkp = F.in(I_GK) + l * 64 + 8 * c;
    const f32x4 gq0 = *(const f32x4*)gqp, gq1 = *(const f32x4*)(gqp + 4), gk0 = *(const f32x4*)gkp, gk1 = *(const f32x4*)(gkp + 4);
    const float* rope = (const float*)(F.ws + WS_ROPE);
    for (int it = F.gw; it < (MT / 64) * NH; it += F.ngw) {
        Frame F = Fp; { unsigned long long w_ = (unsigned long long)Fp.ws; asm volatile("" : "+s"(w_)); F.ws = (unsigned char*)w_; }
        const int ch = it >> 4, h = it & 15, r0 = ch * 64; const bool lat = r0 < ML;
        const int b = lat ? (r0 >> 12) : ((r0 - ML) >> 8), t0 = lat ? (r0 & 4095) : ((r0 - ML) & 255);
        const size_t hb = (size_t)(b * NH + h);
        const bool doq = !lat && l == 0;
        const bf16_t* pbase = ((const bf16_t*)(F.ws + WS_P)) + (size_t)(r0 + rsub) * PW + h * 64 + 8 * c;
        u32x4 qw[8], kw[8], vw[8];
#pragma unroll
        for (int j = 0; j < 8; ++j) { const bf16_t* p = pbase + (size_t)(8 * j) * PW; qw[j] = doq ? *(const GAS u32x4*)p : (u32x4){0u, 0u, 0u, 0u}; kw[j] = *(const GAS u32x4*)(p + AW); vw[j] = *(const GAS u32x4*)(p + 2 * AW); }
#pragma unroll
        for (int j = 0; j < 8; ++j) { LAS unsigned* d = scr + (8 * j + rsub) * 33 + 4 * c; d[0] = vw[j].x; d[1] = vw[j].y; d[2] = vw[j].z; d[3] = vw[j].w; }
        if (lat) {
            const size_t tb = (hb * SEQ + t0 + rsub) * 64 + 8 * c;
            prep_head<false, true>(kw, gk0, gk1, nullptr, ((bf16_t*)(F.ws + WS_KR)) + tb, rope, t0 >> 6, rsub, c);
        } else {
            const size_t tb = (hb * CTXL + t0 + rsub) * 64 + 8 * c;
            if (doq) prep_head<true, false>(qw, gq0, gq1, ((bf16_t*)(F.ws + WS_QC)) + tb, nullptr, rope, 0, rsub, c);
            prep_head<true, false>(kw, gk0, gk1, ((bf16_t*)(F.ws + WS_KC)) + tb, nullptr, rope, 0, rsub, c);
        }
        LDS_WAIT(); asm volatile("" ::: "memory");
        const int wsel = lane >> 1, sh = (lane & 1) * 16;
        u32x4 ov[8];
#pragma unroll
        for (int i = 0; i < 8; ++i) { unsigned o[4];
#pragma unroll
            for (int q = 0; q < 4; ++q) { const unsigned w0 = scr[(8 * i + 2 * q) * 33 + wsel], w1 = scr[(8 * i + 2 * q + 1) * 33 + wsel];
                o[q] = ((w0 >> sh) & 0xffffu) | ((w1 >> sh) << 16); }
            ov[i] = (u32x4){o[0], o[1], o[2], o[3]}; }
        if (lat) { bf16_t* vt = ((bf16_t*)(F.ws + WS_VT)) + (hb * 64 + lane) * SEQ + t0;
#pragma unroll
            for (int i = 0; i < 8; ++i) *(GAS u32x4*)(vt + 8 * i) = ov[i]; }
        else { bf16_t* vt = ((bf16_t*)(F.ws + WS_VCT)) + (hb * 64 + lane) * CTXL + t0;
#pragma unroll
            for (int i = 0; i < 8; ++i) *(GAS u32x4*)(vt + 8 * i) = ov[i]; }
        LDS_WAIT(); asm volatile("" ::: "memory");
    }
}

__device__ __forceinline__ void phase_glu(const Frame& F0, int l, int nrows) {
    const Frame F = fresh(F0);
    const int gt = F.bx * 512 + F.tid, nt = F.G * 512;
    for (int it = gt; it < nrows * 64; it += 2 * nt) {
        u32x4 aw[2], gw[2]; bool ok[2]; int row[2], c0[2];
#pragma unroll
        for (int u = 0; u < 2; ++u) { const int i2 = it + u * nt; ok[u] = i2 < nrows * 64; row[u] = i2 >> 6; c0[u] = (i2 & 63) * 8;
            if (ok[u]) { aw[u] = *(const GAS u32x4*)(((const bf16_t*)(F.ws + WS_P)) + (size_t)row[u] * PW + 3072 + c0[u]); gw[u] = *(const GAS u32x4*)(((const bf16_t*)(F.ws + WS_P)) + (size_t)row[u] * PW + 3584 + c0[u]); } }
#pragma unroll
        for (int u = 0; u < 2; ++u) if (ok[u]) {
            u32x4 o; o.x = pk2(bflo(aw[u].x) * sigmoidf_(bflo(gw[u].x)), bfhi(aw[u].x) * sigmoidf_(bfhi(gw[u].x))); o.y = pk2(bflo(aw[u].y) * sigmoidf_(bflo(gw[u].y)), bfhi(aw[u].y) * sigmoidf_(bfhi(gw[u].y)));
            o.z = pk2(bflo(aw[u].z) * sigmoidf_(bflo(gw[u].z)), bfhi(aw[u].z) * sigmoidf_(bfhi(gw[u].z))); o.w = pk2(bflo(aw[u].w) * sigmoidf_(bflo(gw[u].w)), bfhi(aw[u].w) * sigmoidf_(bfhi(gw[u].w)));
            *(GAS u32x4*)(((bf16_t*)(F.ws + WS_U)) + (size_t)row[u] * CWD + c0[u]) = o; }
    }
}
__device__ __forceinline__ void phase_conv(const Frame& F0, int l, int nrows) {
    const Frame F = fresh(F0);
    const int lane = F.lane, c0 = 8 * lane;
    LAS float* wl = (LAS float*)(F.lds + RING_OFF);
    { const float* dw = F.in(I_CDW) + (size_t)l * 31 * CWD; float tv[31];
#pragma unroll
      for (int i = 0; i < 31; ++i) tv[i] = ((const GAS float*)dw)[F.tid + 512 * i];
#pragma unroll
      for (int i = 0; i < 31; ++i) wl[512 * i + ((F.tid >> 2) & 1) * 256 + (F.tid >> 3) * 4 + (F.tid & 3)] = tv[i]; }
    __syncthreads();
    const float* dbp = F.in(I_CDB) + l * CWD + c0; const float* lgp = F.in(I_CLG) + l * CWD + c0; const float* lbp = F.in(I_CLB) + l * CWD + c0;
    const f32x4 db0 = *(const f32x4*)dbp, db1 = *(const f32x4*)(dbp + 4), lg0 = *(const f32x4*)lgp, lg1 = *(const f32x4*)(lgp + 4), lb0 = *(const f32x4*)lbp, lb1 = *(const f32x4*)(lbp + 4);
    for (int un = F.gw; un < nrows / 4; un += F.ngw) {
        const int r0 = 4 * un; const bool lat = r0 < ML; const int sbeg = lat ? (r0 & ~4095) : (ML + ((r0 - ML) & ~255)), send = sbeg + (lat ? SEQ : CTXL);
        const bf16_t* ub = ((const bf16_t*)(F.ws + WS_U)) + c0;
        f32x4 acc[4][2];
#pragma unroll
        for (int t = 0; t < 4; ++t) { acc[t][0] = db0; acc[t][1] = db1; }
        f32x4 w[4][2];
#pragma unroll
        for (int i = 0; i < 34; ++i) {
#pragma unroll
            for (int j = 3; j > 0; --j) { w[j][0] = w[j - 1][0]; w[j][1] = w[j - 1][1]; }
            if (i < 31) { w[0][0] = *(const LAS f32x4*)(wl + i * CWD + 4 * lane); w[0][1] = *(const LAS f32x4*)(wl + i * CWD + 256 + 4 * lane); }
            const int r = r0 - 15 + i;
            if (r >= sbeg && r < send) {
                const u32x4 xw = *(const GAS u32x4*)(ub + (size_t)r * CWD);
                const f32x4 x0 = (f32x4){bflo(xw.x), bfhi(xw.x), bflo(xw.y), bfhi(xw.y)}, x1 = (f32x4){bflo(xw.z), bfhi(xw.z), bflo(xw.w), bfhi(xw.w)};
#pragma unroll
                for (int t = 0; t < 4; ++t) { const int k = i - t; if (k >= 0 && k < 31) { acc[t][0] += w[t][0] * x0; acc[t][1] += w[t][1] * x1; } }
            }
            if ((i & 7) == 7) asm volatile("" ::: "memory");
        }
#pragma unroll
        for (int t = 0; t < 4; ++t) {
            float s = (acc[t][0].x + acc[t][0].y) + (acc[t][0].z + acc[t][0].w) + (acc[t][1].x + acc[t][1].y) + (acc[t][1].z + acc[t][1].w);
            const float mean = wave_sum(s) * (1.0f / 512.0f);
            const f32x4 d0 = acc[t][0] - mean, d1 = acc[t][1] - mean;
            float s2 = (d0.x * d0.x + d0.y * d0.y) + (d0.z * d0.z + d0.w * d0.w) + (d1.x * d1.x + d1.y * d1.y) + (d1.z * d1.z + d1.w * d1.w);
            const float rstd = 1.0f / sqrtf(wave_sum(s2) * (1.0f / 512.0f) + EPS);
            const f32x4 y0 = d0 * rstd * lg0 + lb0, y1 = d1 * rstd * lg1 + lb1;
            u32x4 o; o.x = pk2(y0.x * sigmoidf_(y0.x), y0.y * sigmoidf_(y0.y)); o.y = pk2(y0.z * sigmoidf_(y0.z), y0.w * sigmoidf_(y0.w)); o.z = pk2(y1.x * sigmoidf_(y1.x), y1.y * sigmoidf_(y1.y)); o.w = pk2(y1.z * sigmoidf_(y1.z), y1.w * sigmoidf_(y1.w));
            *(GAS u32x4*)(((bf16_t*)(F.ws + WS_CONV)) + (size_t)(r0 + t) * CWD + c0) = o;
        }
    }
    __syncthreads();
}
__device__ __forceinline__ void phase_shortconv(const Frame& F0, int l, int nrows) {
    const Frame F = fresh(F0);
    const int gt = F.bx * 512 + F.tid, nt = F.G * 512;
    const float* sw = F.in(I_SCW) + (size_t)l * 3 * SWD;
    for (int it = gt; it < nrows * 64; it += nt) {
        const int row = it >> 6, c0 = (it & 63) * 8; const bool lat = row < ML; const int sbeg = lat ? (row & ~4095) : (ML + ((row - ML) & ~255)), send = sbeg + (lat ? SEQ : CTXL);
        float acc[8];
#pragma unroll
        for (int q = 0; q < 8; ++q) acc[q] = 0.f;
#pragma unroll
        for (int k = 0; k < 3; ++k) { const int r = row + k - 1;
            if (r >= sbeg && r < send) { const u32x4 cw = *(const u32x4*)(((bf16_t*)(F.ws + WS_P)) + (size_t)r * PW + 4608 + c0), xw = *(const u32x4*)(((bf16_t*)(F.ws + WS_P)) + (size_t)r * PW + 5120 + c0);
                const f32x4 w0 = *(const f32x4*)(sw + k * SWD + c0), w1 = *(const f32x4*)(sw + k * SWD + c0 + 4);
                acc[0] += w0.x * bflo(cw.x) * bflo(xw.x); acc[1] += w0.y * bfhi(cw.x) * bfhi(xw.x); acc[2] += w0.z * bflo(cw.y) * bflo(xw.y); acc[3] += w0.w * bfhi(cw.y) * bfhi(xw.y);
                acc[4] += w1.x * bflo(cw.z) * bflo(xw.z); acc[5] += w1.y * bfhi(cw.z) * bfhi(xw.z); acc[6] += w1.z * bflo(cw.w) * bflo(xw.w); acc[7] += w1.w * bfhi(cw.w) * bfhi(xw.w); } }
        const u32x4 bw = *(const u32x4*)(((bf16_t*)(F.ws + WS_P)) + (size_t)row * PW + 4096 + c0);
        u32x4 o; o.x = pk2(acc[0] * bflo(bw.x), acc[1] * bfhi(bw.x)); o.y = pk2(acc[2] * bflo(bw.y), acc[3] * bfhi(bw.y)); o.z = pk2(acc[4] * bflo(bw.z), acc[5] * bfhi(bw.z)); o.w = pk2(acc[6] * bflo(bw.w), acc[7] * bfhi(bw.w));
        *(u32x4*)(((bf16_t*)(F.ws + WS_SC)) + (size_t)row * SWD + c0) = o;
    }
}

__device__ __forceinline__ void phase_glu_sc(const Frame& F0, int l, int nrows) {
    const Frame F = fresh(F0);
    const int gt = F.bx * 512 + F.tid, nt = F.G * 512;
    const int c0 = (gt & 63) * 8;
    const float* sw = F.in(I_SCW) + (size_t)l * 3 * SWD + c0;
    f32x4 w0[3], w1[3];
#pragma unroll
    for (int k = 0; k < 3; ++k) { w0[k] = *(const f32x4*)(sw + k * SWD); w1[k] = *(const f32x4*)(sw + k * SWD + 4); }
    for (int it = gt; it < nrows * 64; it += nt) {
        const int row = it >> 6; const bool lat = row < ML; const int sbeg = lat ? (row & ~4095) : (ML + ((row - ML) & ~255)), send = sbeg + (lat ? SEQ : CTXL);
        const bf16_t* pr = ((const bf16_t*)(F.ws + WS_P)) + (size_t)row * PW + c0;
        const u32x4 aw = *(const GAS u32x4*)(pr + 3072), gw = *(const GAS u32x4*)(pr + 3584), bw = *(const GAS u32x4*)(pr + 4096);
        u32x4 cw[3], xw[3];
#pragma unroll
        for (int k = 0; k < 3; ++k) { const int r = row + k - 1; const bool ok = r >= sbeg && r < send; const bf16_t* p = pr + (ptrdiff_t)(k - 1) * PW;
            cw[k] = ok ? *(const GAS u32x4*)(p + 4608) : (u32x4){0u, 0u, 0u, 0u}; xw[k] = ok ? *(const GAS u32x4*)(p + 5120) : (u32x4){0u, 0u, 0u, 0u}; }
        { u32x4 o; o.x = pk2(bflo(aw.x) * sigmoidf_(bflo(gw.x)), bfhi(aw.x) * sigmoidf_(bfhi(gw.x))); o.y = pk2(bflo(aw.y) * sigmoidf_(bflo(gw.y)), bfhi(aw.y) * sigmoidf_(bfhi(gw.y)));
          o.z = pk2(bflo(aw.z) * sigmoidf_(bflo(gw.z)), bfhi(aw.z) * sigmoidf_(bfhi(gw.z))); o.w = pk2(bflo(aw.w) * sigmoidf_(bflo(gw.w)), bfhi(aw.w) * sigmoidf_(bfhi(gw.w)));
          *(GAS u32x4*)(((bf16_t*)(F.ws + WS_U)) + (size_t)row * CWD + c0) = o; }
        float acc[8];
#pragma unroll
        for (int q = 0; q < 8; ++q) acc[q] = 0.f;
#pragma unroll
        for (int k = 0; k < 3; ++k) {
            acc[0] += w0[k].x * bflo(cw[k].x) * bflo(xw[k].x); acc[1] += w0[k].y * bfhi(cw[k].x) * bfhi(xw[k].x); acc[2] += w0[k].z * bflo(cw[k].y) * bflo(xw[k].y); acc[3] += w0[k].w * bfhi(cw[k].y) * bfhi(xw[k].y);
            acc[4] += w1[k].x * bflo(cw[k].z) * bflo(xw[k].z); acc[5] += w1[k].y * bfhi(cw[k].z) * bfhi(xw[k].z); acc[6] += w1[k].z * bflo(cw[k].w) * bflo(xw[k].w); acc[7] += w1[k].w * bfhi(cw[k].w) * bfhi(xw[k].w); }
        u32x4 o; o.x = pk2(acc[0] * bflo(bw.x), acc[1] * bfhi(bw.x)); o.y = pk2(acc[2] * bflo(bw.y), acc[3] * bfhi(bw.y)); o.z = pk2(acc[4] * bflo(bw.z), acc[5] * bfhi(bw.z)); o.w = pk2(acc[6] * bflo(bw.w), acc[7] * bfhi(bw.w));
        *(GAS u32x4*)(((bf16_t*)(F.ws + WS_SC)) + (size_t)row * SWD + c0) = o;
    }
}

using pg8::bf16x8;
typedef __bf16 bf16x2_t __attribute__((ext_vector_type(2)));
__device__ __forceinline__ unsigned cvtpk_s(float lo, float hi) { f32x2 v = {lo, hi}; bf16x2_t b = __builtin_convertvector(v, bf16x2_t); return __builtin_bit_cast(unsigned, b); }
struct KF { bf16x8 k[2][2]; };
struct VF { bf16x8 v[4]; };
__device__ __forceinline__ void attn_step(const KF& fk, const VF& fv, const bf16x8 (&q)[2], f32x4 (&o)[4], float& ls, const f32x4 t0, const f32x4 t1) {
    constexpr float C = 0.125f * LOG2E;
    f32x4 s0 = (f32x4){0.f, 0.f, 0.f, 0.f}, s1 = (f32x4){0.f, 0.f, 0.f, 0.f};
    s0 = __builtin_amdgcn_mfma_f32_16x16x32_bf16(fk.k[0][0], q[0], s0, 0, 0, 0); s0 = __builtin_amdgcn_mfma_f32_16x16x32_bf16(fk.k[0][1], q[1], s0, 0, 0, 0);
    s1 = __builtin_amdgcn_mfma_f32_16x16x32_bf16(fk.k[1][0], q[0], s1, 0, 0, 0); s1 = __builtin_amdgcn_mfma_f32_16x16x32_bf16(fk.k[1][1], q[1], s1, 0, 0, 0);
    float p[8];
#pragma unroll
    for (int e = 0; e < 4; ++e) { p[e] = __builtin_amdgcn_exp2f(s0[e] * C + t0[e]); p[4 + e] = __builtin_amdgcn_exp2f(s1[e] * C + t1[e]); }
    ls += ((p[0] + p[1]) + (p[2] + p[3])) + ((p[4] + p[5]) + (p[6] + p[7]));
    const bf16x8 pb = __builtin_bit_cast(bf16x8, (u32x4){cvtpk_s(p[0], p[1]), cvtpk_s(p[2], p[3]), cvtpk_s(p[4], p[5]), cvtpk_s(p[6], p[7])});
#pragma unroll
    for (int dt = 0; dt < 4; ++dt) o[dt] = __builtin_amdgcn_mfma_f32_16x16x32_bf16(fv.v[dt], pb, o[dt], 0, 0, 0);
}
__device__ __forceinline__ float lane_xor(float v, int lane, int m) { return __builtin_bit_cast(float, __builtin_amdgcn_ds_bpermute((lane ^ m) << 2, __builtin_bit_cast(int, v))); }
template <bool ROT>
__device__ __forceinline__ void q_tile_from_w(const u32x4 w0, const u32x4 w1, const f32x4 (&gv)[4], const LAS float* rr, const LAS float* rc, int lane, bf16x8 (&qo)[2]);
template <bool ROT>
__device__ __forceinline__ void q_tile_from_p(const bf16_t* prow, const f32x4 (&gv)[4], const LAS float* rr, const LAS float* rc, int lane, bf16x8 (&qo)[2]) {
    const u32x4 w0 = *(const GAS u32x4*)prow, w1 = *(const GAS u32x4*)(prow + 32);
    q_tile_from_w<ROT>(w0, w1, gv, rr, rc, lane, qo);
}
template <bool ROT>
__device__ __forceinline__ void q_tile_from_w(const u32x4 w0, const u32x4 w1, const f32x4 (&gv)[4], const LAS float* rr, const LAS float* rc, int lane, bf16x8 (&qo)[2]) {
    const int g = lane >> 4;
    float x[16] = {bflo(w0.x), bfhi(w0.x), bflo(w0.y), bfhi(w0.y), bflo(w0.z), bfhi(w0.z), bflo(w0.w), bfhi(w0.w), bflo(w1.x), bfhi(w1.x), bflo(w1.y), bfhi(w1.y), bflo(w1.z), bfhi(w1.z), bflo(w1.w), bfhi(w1.w)};
    float ss = 0.f;
#pragma unroll
    for (int e = 0; e < 16; ++e) ss += x[e] * x[e];
    ss += lane_xor(ss, lane, 16); ss += lane_xor(ss, lane, 32);
    const float rinv = 1.0f / sqrtf(ss * (1.0f / 64.0f) + EPS);
#pragma unroll
    for (int e = 0; e < 16; ++e) x[e] = x[e] * rinv * gv[e >> 2][e & 3];
    if constexpr (ROT) {
        const float sg = (g & 2) ? 1.0f : -1.0f;
#pragma unroll
        for (int hf = 0; hf < 2; ++hf) { const LAS float* tp = hf ? rc : rr;
            const f32x4 t0 = *(const LAS f32x4*)tp, t1 = *(const LAS f32x4*)(tp + 4), t2 = *(const LAS f32x4*)(tp + 8), t3 = *(const LAS f32x4*)(tp + 12);
            const float cs[8] = {t0.x, t0.z, t1.x, t1.z, t2.x, t2.z, t3.x, t3.z}, sn[8] = {t0.y, t0.w, t1.y, t1.w, t2.y, t2.w, t3.y, t3.w};
#pragma unroll
            for (int e = 0; e < 8; ++e) { const float xv = x[8 * hf + e], xp = lane_xor(xv, lane, 32); x[8 * hf + e] = xv * cs[e] + sg * xp * sn[e]; } }
    }
    qo[0] = __builtin_bit_cast(bf16x8, (u32x4){pk2(x[0], x[1]), pk2(x[2], x[3]), pk2(x[4], x[5]), pk2(x[6], x[7])});
    qo[1] = __builtin_bit_cast(bf16x8, (u32x4){pk2(x[8], x[9]), pk2(x[10], x[11]), pk2(x[12], x[13]), pk2(x[14], x[15])});
}
constexpr int ATT_NS = 6, ATT_SLOT = 16384, ATT_TABC = ATT_NS * ATT_SLOT, ATT_ROPE = ATT_TABC + 4096;
__device__ __forceinline__ void glds16(const void* sbase, unsigned voff, unsigned lds_dst) { unsigned keep;
    asm volatile("s_mov_b32 %0, m0\n\ts_mov_b32 m0, %3\n\ts_nop 0\n\tglobal_load_lds_dwordx4 %1, %2\n\ts_mov_b32 m0, %0" : "=&s"(keep) : "v"(voff), "s"(sbase), "s"(lds_dst) : "memory"); }
constexpr int CV_ROWS = 65536;
__device__ __forceinline__ void conv_taps_fill(const Frame& F0, int l) {
    const Frame F = fresh(F0);
    LAS float* wl = (LAS float*)(F.lds + RING_OFF);
    const float* dw = F.in(I_CDW) + (size_t)l * 31 * CWD; float tv[31];
#pragma unroll
    for (int i = 0; i < 31; ++i) tv[i] = ((const GAS float*)dw)[F.tid + 512 * i];
#pragma unroll
    for (int i = 0; i < 31; ++i) wl[512 * i + ((F.tid >> 2) & 1) * 256 + (F.tid >> 3) * 4 + (F.tid & 3)] = tv[i];
}
__device__ __forceinline__ void phase_conv2(const Frame& F0, int l, int nrows, bool prefilled) {
    if (!prefilled) conv_taps_fill(F0, l);
    const Frame F = fresh(F0);
    const int lane = F.lane, wave = F.wave, c0 = 8 * lane;
    LAS float* wl = (LAS float*)(F.lds + RING_OFF);
    const float* dbp = F.in(I_CDB) + l * CWD + c0; const float* lgp = F.in(I_CLG) + l * CWD + c0; const float* lbp = F.in(I_CLB) + l * CWD + c0;
    const f32x4 db0 = *(const f32x4*)dbp, db1 = *(const f32x4*)(dbp + 4), lg0 = *(const f32x4*)lgp, lg1 = *(const f32x4*)(lgp + 4), lb0 = *(const f32x4*)lbp, lb1 = *(const f32x4*)(lbp + 4);
    const unsigned ldsb = (unsigned)(unsigned long long)(F.lds + RING_OFF) + (unsigned)CV_ROWS;
    const LAS unsigned char* rowsL = F.lds + RING_OFF + CV_ROWS;
    __syncthreads();
#define CV_STAGE(ti_) do { const int r0_ = 32 * (ti_); const bool lat_ = r0_ < ML; const int sbeg_ = lat_ ? (r0_ & ~4095) : (ML + ((r0_ - ML) & ~255)), send_ = sbeg_ + (lat_ ? SEQ : CTXL); \
        const bf16_t* ub_ = (const bf16_t*)(F.ws + WS_U); \
        _Pragma("nounroll") for (int j = wave; j < 62; j += 8) { const int r = r0_ - 15 + j; \
            if (r >= sbeg_ && r < send_) glds16(ub_ + (size_t)r * CWD, (unsigned)lane * 16u, ldsb + (unsigned)j * 1024u); \
            else *(LAS u32x4*)(rowsL + j * 1024 + lane * 16) = (u32x4){0u, 0u, 0u, 0u}; } } while (0)
    f32x4 acc[4][2];
    int tcur = -1, tnext = F.bx; const int ntile = nrows / 32;
#pragma nounroll
    for (;;) {
        if (tnext < ntile) CV_STAGE(tnext);
        if (tcur >= 0) {
            const int r0 = 32 * tcur;
#pragma unroll
            for (int t = 0; t < 4; ++t) {
                float s = (acc[t][0].x + acc[t][0].y) + (acc[t][0].z + acc[t][0].w) + (acc[t][1].x + acc[t][1].y) + (acc[t][1].z + acc[t][1].w);
                const float mean = wave_sum(s) * (1.0f / 512.0f);
                const f32x4 d0 = acc[t][0] - mean, d1 = acc[t][1] - mean;
                float s2 = (d0.x * d0.x + d0.y * d0.y) + (d0.z * d0.z + d0.w * d0.w) + (d1.x * d1.x + d1.y * d1.y) + (d1.z * d1.z + d1.w * d1.w);
                const float rstd = 1.0f / sqrtf(wave_sum(s2) * (1.0f / 512.0f) + EPS);
                const f32x4 y0 = d0 * rstd * lg0 + lb0, y1 = d1 * rstd * lg1 + lb1;
                u32x4 o; o.x = pk2(y0.x * sigmoidf_(y0.x), y0.y * sigmoidf_(y0.y)); o.y = pk2(y0.z * sigmoidf_(y0.z), y0.w * sigmoidf_(y0.w)); o.z = pk2(y1.x * sigmoidf_(y1.x), y1.y * sigmoidf_(y1.y)); o.w = pk2(y1.z * sigmoidf_(y1.z), y1.w * sigmoidf_(y1.w));
                *(GAS u32x4*)(((bf16_t*)(F.ws + WS_CONV)) + (size_t)(r0 + 4 * wave + t) * CWD + c0) = o;
            }
        }
        if (tnext >= ntile) break;
        asm volatile("s_waitcnt vmcnt(0)" ::: "memory");
        __syncthreads();
#pragma unroll
        for (int t = 0; t < 4; ++t) { acc[t][0] = db0; acc[t][1] = db1; }
        f32x4 w[4][2];
        const LAS unsigned char* myrows = rowsL + (4 * wave) * 1024 + lane * 16;
#pragma unroll
        for (int i = 0; i < 34; ++i) {
#pragma unroll
            for (int j = 3; j > 0; --j) { w[j][0] = w[j - 1][0]; w[j][1] = w[j - 1][1]; }
            if (i < 31) { w[0][0] = *(const LAS f32x4*)(wl + i * CWD + 4 * lane); w[0][1] = *(const LAS f32x4*)(wl + i * CWD + 256 + 4 * lane); }
            const u32x4 xw = *(const LAS u32x4*)(myrows + i * 1024);
            const f32x4 x0 = (f32x4){bflo(xw.x), bfhi(xw.x), bflo(xw.y), bfhi(xw.y)}, x1 = (f32x4){bflo(xw.z), bfhi(xw.z), bflo(xw.w), bfhi(xw.w)};
#pragma unroll
            for (int t = 0; t < 4; ++t) { const int k = i - t; if (k >= 0 && k < 31) { acc[t][0] += w[t][0] * x0; acc[t][1] += w[t][1] * x1; } }
        }
        __syncthreads();
        tcur = tnext; tnext += F.G;
    }
#undef CV_STAGE
    asm volatile("s_waitcnt vmcnt(0)" ::: "memory");
    __syncthreads();
}
template <bool CTXQ>
__device__ __forceinline__ void attn_block(const Frame& Fu, int l, int b, int h, int rgp, float msh) {
    Frame F = Fu; { unsigned long long w = (unsigned long long)Fu.ws; asm volatile("" : "+s"(w)); F.ws = (unsigned char*)w; }
    int lane_ = F.lane; asm volatile("" : "+v"(lane_));
    const int lane = lane_, fr = lane & 15, g = lane >> 4, wave = F.wave, bh = b * NH + h;
    const int rg = rgp * 2 + (wave >> 2), j = wave & 3, r0 = 4 * rg, c0 = 16 * j, bs = min(max(16 * j - 8, 0), 32);
    const unsigned ldsb = (unsigned)(unsigned long long)(F.lds + RING_OFF);
    const LAS unsigned char* ring = F.lds + RING_OFF;
    const int kmin = CTXQ ? 0 : min(max(8 * rgp - 4, 0), 56), kmax = CTXQ ? -1 : min(max(8 * rgp + 7 - 4, 0), 56) + 7, nloc = kmax - kmin + 1, nrow = nloc + 4;
    constexpr bool active = true; constexpr int NT = CTXQ ? 1 : 4;
    const int tid = wave * 64 + lane, dk = tid >> 3, dc = (tid & 7) ^ ((dk >> 1) & 7), du = (2 * (tid & 7)) ^ (dk & 14);
    const unsigned kdo = (unsigned)(dk * 64 + 8 * dc) * 2u, vdl = (unsigned)(dk * SEQ + 4 * du) * 2u, vdc = (unsigned)(dk * CTXL + 4 * du) * 2u;
    const bf16_t* kloc = ((const bf16_t*)(F.ws + WS_KR)) + (size_t)bh * SEQ * 64; const bf16_t* vloc = ((const bf16_t*)(F.ws + WS_VT)) + (size_t)bh * 64 * SEQ;
    const bf16_t* kctx = ((const bf16_t*)(F.ws + WS_KC)) + (size_t)bh * CTXL * 64; const bf16_t* vctx = ((const bf16_t*)(F.ws + WS_VCT)) + (size_t)bh * 64 * CTXL;
#define ATT_ISSUE(s_) do { const int s2_ = min((s_), nrow - 1); const unsigned dst_ = ldsb + (unsigned)(((s_) % ATT_NS) * ATT_SLOT + wave * 1024); \
        if (s2_ < nloc) { glds16(kloc + (size_t)(kmin + s2_) * 4096, kdo, dst_); glds16(vloc + (kmin + s2_) * 64, vdl, dst_ + 8192u); } \
        else { glds16(kctx + (size_t)(s2_ - nloc) * 4096, kdo, dst_); glds16(vctx + (s2_ - nloc) * 64, vdc, dst_ + 8192u); } } while (0)
#define ATT_FRAGS(slot_, koffA, koffB, voffA, voffB, xr) do { const LAS unsigned char* sl_ = ring + (slot_) * ATT_SLOT; \
        kf.k[0][0] = *(const LAS bf16x8*)(sl_ + (koffA)); kf.k[0][1] = *(const LAS bf16x8*)(sl_ + (koffB)); kf.k[1][0] = *(const LAS bf16x8*)(sl_ + (koffA) + 2048); kf.k[1][1] = *(const LAS bf16x8*)(sl_ + (koffB) + 2048); \
        _Pragma("unroll") for (int dt = 0; dt < 4; ++dt) { const u32x2 lo_ = *(const LAS u32x2*)(sl_ + (((voffA)) ^ (xr)) + dt * 2048), hi_ = *(const LAS u32x2*)(sl_ + (((voffB)) ^ (xr)) + dt * 2048); \
            vf.v[dt] = __builtin_bit_cast(bf16x8, (u32x4){lo_.x, lo_.y, hi_.x, hi_.y}); } } while (0)
#define ATT_ROWSYNC(s_) do { asm volatile("s_waitcnt vmcnt(%0)" :: "n"(2 * (ATT_NS - 2)) : "memory");     \
        asm volatile("s_barrier" ::: "memory");                                                                  \
        ATT_ISSUE((s_) + ATT_NS - 1); } while (0)
    bf16x8 q[4][2];
    const bf16_t* qraw = ((const bf16_t*)(F.ws + WS_P)) + (size_t)(b * SEQ + r0 * 64 + c0) * PW + h * 64;
    const unsigned qlo = (unsigned)(fr * PW + 8 * g);
    if constexpr (CTXQ) {
        const bf16_t* qc = ((const bf16_t*)(F.ws + WS_QC)) + ((size_t)bh * CTXL + 128 * rgp + 16 * wave + fr) * 64 + 8 * g;
#pragma unroll
        for (int ks = 0; ks < 2; ++ks) q[0][ks] = *(const GAS bf16x8*)(qc + 32 * ks);
    } else {
        f32x4 gv[4]; { const float* gq = F.in(I_GQ) + l * 64 + 8 * g; gv[0] = *(const f32x4*)gq; gv[1] = *(const f32x4*)(gq + 4); gv[2] = *(const f32x4*)(gq + 32); gv[3] = *(const f32x4*)(gq + 36); }
        const LAS float* ropet = (const LAS float*)(F.lds + RING_OFF + ATT_ROPE) + 16 * (g & 1);
        u32x4 qw[4][2];
#pragma unroll
        for (int i = 0; i < 4; ++i) { qw[i][0] = *(const GAS u32x4*)(qraw + (size_t)i * 64 * PW + qlo); qw[i][1] = *(const GAS u32x4*)(qraw + (size_t)i * 64 * PW + qlo + 32); }
#pragma unroll
        for (int i = 0; i < 4; ++i) { q_tile_from_w<true>(qw[i][0], qw[i][1], gv, ropet + (r0 + i) * 32, ropet + (c0 + fr) * 32, lane, q[i]); asm volatile("" : "+v"(q[i][0]), "+v"(q[i][1]) :: "memory"); }
    }
    f32x4 o[4][4]; float ls[4];
#pragma unroll
    for (int i = 0; i < 4; ++i) { ls[i] = 0.f;
#pragma unroll
        for (int dt = 0; dt < 4; ++dt) o[i][dt] = (f32x4){0.f, 0.f, 0.f, 0.f}; }
    int rsv[4];
#pragma unroll
    for (int i = 0; i < 4; ++i) rsv[i] = min(max(r0 + i - 4, 0), 56);
    asm volatile("s_waitcnt vmcnt(0)" ::: "memory");
#pragma unroll
    for (int s = 0; s < ATT_NS - 1; ++s) ATT_ISSUE(s);
    KF kf; VF vf;
    if constexpr (!CTXQ) {
        const int swz = ((fr >> 1) + ((bs >> 1) & 7)) & 7;
        const int kA = bs * 128 + fr * 128 + ((g ^ (swz & 3)) + 4 * (swz >> 2)) * 16, kB = bs * 128 + fr * 128 + ((g ^ (swz & 3)) + 4 * (1 ^ (swz >> 2))) * 16;
        const int vm = fr & 14, u0 = (bs >> 2) + g;
        const int vA = 8192 + fr * 128 + (u0 ^ vm) * 8, vB = 8192 + fr * 128 + ((u0 + 4) ^ vm) * 8;
        const int cq = c0 + fr, csq = min(max(cq - 8, 0), 48);
        f32x4 mb0, mb1;
#pragma unroll
        for (int e = 0; e < 4; ++e) { const int ka_ = bs + 4 * g + e, kb_ = ka_ + 16; mb0[e] = (ka_ >= csq && ka_ < csq + 16) ? 0.f : -__builtin_inff(); mb1[e] = (kb_ >= csq && kb_ < csq + 16) ? 0.f : -__builtin_inff(); }
        const LAS float* tl = (const LAS float*)(F.lds + RING_OFF + ATT_TABC) + 16 + (bs + 4 * g - cq + 15);
#pragma nounroll
        for (int s = 0; s < nloc; ++s) {
            ATT_ROWSYNC(s);
            const int kr = kmin + s;
            if (kr >= rsv[0] && kr <= rsv[3] + 7) {
                ATT_FRAGS(s % ATT_NS, kA, kB, vA, vB, 0);
#pragma unroll
                for (int i = 0; i < 4; ++i) if (kr >= rsv[i] && kr <= rsv[i] + 7) {
                    const LAS float* tr = tl + (kr - (r0 + i) + 7) * 64;
                    const f32x4 t0 = (f32x4){tr[0], tr[1], tr[2], tr[3]} + mb0, t1 = (f32x4){tr[16], tr[17], tr[18], tr[19]} + mb1;
                    attn_step(kf, vf, q[i], o[i], ls[i], t0, t1); __builtin_amdgcn_sched_barrier(0); }
            }
        }
    }
    {
        if constexpr (!CTXQ) { f32x4 gv[4]; const float* gq = F.in(I_GQ) + l * 64 + 8 * g; gv[0] = *(const f32x4*)gq; gv[1] = *(const f32x4*)(gq + 4); gv[2] = *(const f32x4*)(gq + 32); gv[3] = *(const f32x4*)(gq + 36);
          const LAS float* ropet = (const LAS float*)(F.lds + RING_OFF + ATT_ROPE);
          u32x4 qw[4][2];
#pragma unroll
          for (int i = 0; i < 4; ++i) { qw[i][0] = *(const GAS u32x4*)(qraw + (size_t)i * 64 * PW + qlo); qw[i][1] = *(const GAS u32x4*)(qraw + (size_t)i * 64 * PW + qlo + 32); }
#pragma unroll
          for (int i = 0; i < 4; ++i) { q_tile_from_w<false>(qw[i][0], qw[i][1], gv, ropet, ropet, lane, q[i]); asm volatile("" : "+v"(q[i][0]), "+v"(q[i][1]) :: "memory"); } }
        asm volatile("s_waitcnt vmcnt(0)" ::: "memory");
        const int swz = (fr >> 1) & 7;
        const int kA = fr * 128 + ((g ^ (swz & 3)) + 4 * (swz >> 2)) * 16, kB = fr * 128 + ((g ^ (swz & 3)) + 4 * (1 ^ (swz >> 2))) * 16;
        const int vm = fr & 14;
        const int vA = 8192 + fr * 128 + (g ^ vm) * 8, vB = 8192 + fr * 128 + ((g + 4) ^ vm) * 8;
        const f32x4 tm = (f32x4){msh, msh, msh, msh};
#pragma nounroll
        for (int s = nloc; s < nrow; ++s) {
            ATT_ROWSYNC(s);
            if (active)
#pragma unroll
            for (int hf = 0; hf < 2; ++hf) {
                ATT_FRAGS(s % ATT_NS, kA + hf * 4096, kB + hf * 4096, vA, vB, hf * 64);
#pragma unroll
                for (int i = 0; i < NT; ++i) { attn_step(kf, vf, q[i], o[i], ls[i], tm, tm); __builtin_amdgcn_sched_barrier(0); }
            }
        }
    }
    asm volatile("s_waitcnt vmcnt(0)" ::: "memory");
    asm volatile("s_barrier" ::: "memory");
#undef ATT_ISSUE
#undef ATT_FRAGS
#undef ATT_ROWSYNC
#pragma unroll
    for (int i = 0; i < NT; ++i) {
        float lt = ls[i]; lt += lane_xor(lt, lane, 16); lt += lane_xor(lt, lane, 32);
        const float inv = 1.0f / lt;
        const int orow = CTXQ ? (ML + b * CTXL + 128 * rgp + 16 * wave + fr) : (b * SEQ + (r0 + i) * 64 + c0 + fr);
        bf16_t* op = ((bf16_t*)(F.ws + WS_ATT)) + (size_t)orow * AW + h * 64 + 4 * g;
        if (active) {
#pragma unroll
            for (int dt = 0; dt < 4; ++dt) { const f32x4 v = o[i][dt] * inv; u32x2 w; w.x = cvtpk_s(v.x, v.y); w.y = cvtpk_s(v.z, v.w); *(GAS u32x2*)(op + 16 * dt) = w; } }
    }
}
__device__ __forceinline__ void phase_attn(const Frame& F0, int l) {
    const Frame F = fresh(F0);
    LAS float* tabc = (LAS float*)(F.lds + RING_OFF + ATT_TABC);
    const float msh = -((const float*)(F.ws + WS_MSH))[l] * LOG2E;
    int curh = -1;
    { int t_ = F.tid; for (int i = t_; i < 2048; i += 512) ((LAS float*)(F.lds + RING_OFF + ATT_ROPE))[i] = ((const GAS float*)(F.ws + WS_ROPE))[i]; }
    for (int u = F.bx; u < 512; u += F.G) {
        const int h = u & 15, rest = u >> 4, b = rest >> 3, rgp = rest & 7;
        if (h != curh) { __syncthreads(); int t_ = F.tid; unsigned long long w_ = (unsigned long long)F.ws; asm volatile("" : "+v"(t_), "+s"(w_));
            for (int i = t_; i < 960; i += 512) ((LAS float*)(F.lds + RING_OFF + ATT_TABC))[i] = ((const GAS float*)((unsigned char*)w_ + WS_TAB))[(size_t)(l * NH + h) * 960 + i]; __syncthreads(); curh = h; }
        attn_block<false>(F, l, b, h, rgp, msh);
    }
    __syncthreads();
    if (l == 0) for (int u = F.bx; u < NB * NH * 2; u += F.G) attn_block<true>(F, l, u >> 5, (u >> 1) & 15, u & 1, msh);
    __syncthreads();
}

__device__ __forceinline__ void router_fill(const Frame& F0, int l) {
    const Frame F = fresh(F0);
    const int tid = F.tid;
    LAS float* wt = (LAS float*)(F.lds + RING_OFF);
    const float* wr = F.in(I_WR) + (size_t)l * DM * NE;
#pragma unroll 1
    for (int i0 = 0; i0 < DM * NE; i0 += 512 * 16) { float tv[16];
#pragma unroll
        for (int j = 0; j < 16; ++j) tv[j] = ((const GAS float*)wr)[i0 + 512 * j + tid];
#pragma unroll
        for (int j = 0; j < 16; ++j) { const int i = i0 + 512 * j + tid; wt[(i & 15) * DM + ((i >> 4) ^ ((i & 15) << 2))] = tv[j]; } }
}
__device__ __forceinline__ void phase_norm2(const Frame& F0, int l, int nrows, bool prefilled) {
    if (!prefilled) router_fill(F0, l);
    const Frame F = fresh(F0);
    const int tid = F.tid, lane = F.lane;
    LAS float* wt = (LAS float*)(F.lds + RING_OFF);
    __syncthreads();
    const int myexp = ((lane >> 5) & 1) * 8 + ((lane >> 4) & 1) * 4 + ((lane >> 3) & 1) * 2 + ((lane >> 2) & 1);
    for (int r0 = F.gw; r0 < nrows; r0 += 2 * F.ngw) {
        const int row[2] = {r0, min(r0 + F.ngw, nrows - 1)}; const bool ok1 = r0 + F.ngw < nrows;
        f32x4 v[2][8]; float rinv[2];
#pragma unroll
        for (int u = 0; u < 2; ++u) { const float* xp = xrow_ptr(F, 0, row[u]) + 4 * lane; const bf16_t* xb = ((const bf16_t*)(F.ws + WS_X1)) + (size_t)row[u] * DM + 4 * lane; const bf16_t* dl = ((const bf16_t*)(F.ws + WS_XM)) + (size_t)row[u] * DM + 4 * lane; float ss = 0.f;
#pragma unroll
            for (int k = 0; k < 8; ++k) { const u32x2 dw = *(const u32x2*)(dl + 256 * k); f32x4 xv; if (l == 0) xv = *(const f32x4*)(xp + 256 * k); else { const u32x2 xw = *(const u32x2*)(xb + 256 * k); xv = (f32x4){bflo(xw.x), bfhi(xw.x), bflo(xw.y), bfhi(xw.y)}; }
                v[u][k] = xv + (f32x4){bflo(dw.x), bfhi(dw.x), bflo(dw.y), bfhi(dw.y)}; ss += (v[u][k].x * v[u][k].x + v[u][k].y * v[u][k].y) + (v[u][k].z * v[u][k].z + v[u][k].w * v[u][k].w); }
            rinv[u] = ss; }
        rinv[0] = 1.0f / sqrtf(wave_sum(rinv[0]) * (1.0f / DM) + EPS); rinv[1] = 1.0f / sqrtf(wave_sum(rinv[1]) * (1.0f / DM) + EPS);
        const float* g2 = F.in(I_GN2) + l * DM + 4 * lane;
#pragma unroll
        for (int u = 0; u < 2; ++u) { const int bs = row[u] < ML ? (row[u] >> 12) : 4; const float* md = ((float*)(F.ws + WS_MOD)) + (size_t)(l * 5 + bs) * 12288 + 4 * lane;
#pragma unroll
            for (int k = 0; k < 8; ++k) { const f32x4 g = *(const f32x4*)(g2 + 256 * k), sh = *(const f32x4*)(md + 3 * DM + 256 * k), scl = *(const f32x4*)(md + 4 * DM + 256 * k);
                v[u][k] = (v[u][k] * rinv[u] * g) * (scl + 1.0f) + sh;
                if (u == 0 || ok1) *(unsigned*)(((unsigned char*)(F.ws + WS_H8)) + (size_t)row[u] * DM + 4 * lane + 256 * k) = pk4_fp8(v[u][k].x, v[u][k].y, v[u][k].z, v[u][k].w); } }
        float s[2][16];
#pragma unroll
        for (int e = 0; e < 16; ++e) { f32x4 a0 = {0.f, 0.f, 0.f, 0.f}, a1 = {0.f, 0.f, 0.f, 0.f};
#pragma unroll
            for (int k = 0; k < 8; ++k) { const f32x4 w = *(const LAS f32x4*)(wt + e * DM + 4 * (lane ^ e) + 256 * k); a0 += v[0][k] * w; a1 += v[1][k] * w; }
            float s0 = (a0.x + a0.y) + (a0.z + a0.w), s1 = (a1.x + a1.y) + (a1.z + a1.w);
            asm volatile("" : "+v"(s0), "+v"(s1) :: "memory");
            s[0][e] = s0; s[1][e] = s1; }
#pragma unroll
        for (int u = 0; u < 2; ++u) {
#pragma unroll
            for (int st = 0; st < 4; ++st) { const int d = 32 >> st, n = 8 >> st; const bool hi = (lane & d) != 0;
#pragma unroll
                for (int i = 0; i < 8; ++i) if (i < n) { const float a = s[u][i], b = s[u][i + n]; const float send = hi ? a : b, keep = hi ? b : a; s[u][i] = keep + __shfl_xor(send, d); } }
            float lg = s[u][0]; lg += __shfl_xor(lg, 2); lg += __shfl_xor(lg, 1);
            float mx = lg;
#pragma unroll
            for (int d = 4; d < 64; d <<= 1) mx = fmaxf(mx, __shfl_xor(mx, d));
            const float p = expf(lg - mx); float sum = p;
#pragma unroll
            for (int d = 4; d < 64; d <<= 1) sum += __shfl_xor(sum, d);
            const float aff = p / sum;
            if ((lane & 3) == 0 && (u == 0 || ok1)) { const int r = row[u];
                if (r < ML) ((float*)(F.ws + WS_AFFT))[((size_t)(r >> 12) * NE + myexp) * SEQ + (r & 4095)] = aff;
                else ((float*)(F.ws + WS_AFFT))[(size_t)NB * NE * SEQ + ((size_t)((r - ML) >> 8) * NE + myexp) * CTXL + ((r - ML) & 255)] = aff; }
        }
    }
    __syncthreads();
}

__device__ __forceinline__ void phase_norm2p(const Frame& F0, int l, int nrows, bool prefilled) {
    if (!prefilled) router_fill(F0, l);
    const Frame F = fresh(F0);
    const int lane = F.lane;
    LAS float* wt = (LAS float*)(F.lds + RING_OFF);
    __syncthreads();
    const int myexp = ((lane >> 5) & 1) * 8 + ((lane >> 4) & 1) * 4 + ((lane >> 3) & 1) * 2 + ((lane >> 2) & 1);
    f32x4 xr[8]; u32x2 xbw[8], dr[8];
#define N2_LOAD(row_) do { const int rr_ = (row_); const bf16_t* dl_ = ((const bf16_t*)(F.ws + WS_XM)) + (size_t)rr_ * DM + 4 * lane; \
        if (l == 0) { const float* xp_ = xrow_ptr(F, 0, rr_) + 4 * lane; _Pragma("unroll") for (int k = 0; k < 8; ++k) xr[k] = *(const f32x4*)(xp_ + 256 * k); } \
        else { const bf16_t* xb_ = ((const bf16_t*)(F.ws + WS_X1)) + (size_t)rr_ * DM + 4 * lane; _Pragma("unroll") for (int k = 0; k < 8; ++k) xbw[k] = *(const u32x2*)(xb_ + 256 * k); } \
        _Pragma("unroll") for (int k = 0; k < 8; ++k) dr[k] = *(const u32x2*)(dl_ + 256 * k); } while (0)
    if (F.gw < nrows) N2_LOAD(F.gw);
#pragma nounroll
    for (int r = F.gw; r < nrows; r += F.ngw) {
        f32x4 v[8]; float ss = 0.f;
#pragma unroll
        for (int k = 0; k < 8; ++k) { const f32x4 xv = (l == 0) ? xr[k] : (f32x4){bflo(xbw[k].x), bfhi(xbw[k].x), bflo(xbw[k].y), bfhi(xbw[k].y)};
            v[k] = xv + (f32x4){bflo(dr[k].x), bfhi(dr[k].x), bflo(dr[k].y), bfhi(dr[k].y)}; ss += (v[k].x * v[k].x + v[k].y * v[k].y) + (v[k].z * v[k].z + v[k].w * v[k].w); }
        const int bs = r < ML ? (r >> 12) : 4;
        const float* ma = ((const float*)(F.ws + WS_MA2)) + (size_t)(l * 5 + bs) * DM + 4 * lane; const float* mb = ((const float*)(F.ws + WS_MOD)) + (size_t)(l * 5 + bs) * 12288 + 3 * DM + 4 * lane;
        f32x4 A[8], B[8];
#pragma unroll
        for (int k = 0; k < 8; ++k) { A[k] = *(const f32x4*)(ma + 256 * k); B[k] = *(const f32x4*)(mb + 256 * k); }
        asm volatile("" ::: "memory");
        if (r + F.ngw < nrows) N2_LOAD(r + F.ngw);
        asm volatile("" ::: "memory");
        const float rinv = 1.0f / sqrtf(wave_sum(ss) * (1.0f / DM) + EPS);
#pragma unroll
        for (int k = 0; k < 8; ++k) { v[k] = (v[k] * rinv) * A[k] + B[k];
            *(unsigned*)(((unsigned char*)(F.ws + WS_H8)) + (size_t)r * DM + 4 * lane + 256 * k) = pk4_fp8(v[k].x, v[k].y, v[k].z, v[k].w); }
        float s[16];
#pragma unroll
        for (int e = 0; e < 16; ++e) { f32x4 a0 = {0.f, 0.f, 0.f, 0.f};
#pragma unroll
            for (int k = 0; k < 8; ++k) { const f32x4 w = *(const LAS f32x4*)(wt + e * DM + 4 * (lane ^ e) + 256 * k); a0 += v[k] * w; }
            float s0 = (a0.x + a0.y) + (a0.z + a0.w);
            asm volatile("" : "+v"(s0));
            s[e] = s0; }
#pragma unroll
        for (int st = 0; st < 4; ++st) { const int d = 32 >> st, n = 8 >> st; const bool hi = (lane & d) != 0;
#pragma unroll
            for (int i = 0; i < 8; ++i) if (i < n) { const float a = s[i], b = s[i + n]; const float send = hi ? a : b, keep = hi ? b : a; s[i] = keep + __shfl_xor(send, d); } }
        float lg = s[0]; lg += __shfl_xor(lg, 2); lg += __shfl_xor(lg, 1);
        float mx = lg;
#pragma unroll
        for (int d = 4; d < 64; d <<= 1) mx = fmaxf(mx, __shfl_xor(mx, d));
        const float p = expf(lg - mx); float sum = p;
#pragma unroll
        for (int d = 4; d < 64; d <<= 1) sum += __shfl_xor(sum, d);
        const float aff = p / sum;
        if ((lane & 3) == 0) {
            if (r < ML) ((float*)(F.ws + WS_AFFT))[((size_t)(r >> 12) * NE + myexp) * SEQ + (r & 4095)] = aff;
            else ((float*)(F.ws + WS_AFFT))[(size_t)NB * NE * SEQ + ((size_t)((r - ML) >> 8) * NE + myexp) * CTXL + ((r - ML) & 255)] = aff; }
    }
#undef N2_LOAD
    __syncthreads();
}
__device__ __forceinline__ int block_count8(LAS int* slots, int par, int wave, int lane, int wc) {
    if (lane == 0) slots[par * 8 + wave] = wc;
    __syncthreads();
    typedef int i32x4 __attribute__((ext_vector_type(4)));
    const i32x4 a = *(const LAS i32x4*)(slots + par * 8), b = *(const LAS i32x4*)(slots + par * 8 + 4);
    return (a.x + a.y) + (a.z + a.w) + (b.x + b.y) + (b.z + b.w);
}
__device__ __forceinline__ void block_count8x3(LAS int* slots, int par, int wave, int lane, int w1, int w2, int w3, int& t1, int& t2, int& t3) {
    if (lane == 0) { slots[par * 24 + wave] = w1; slots[par * 24 + 8 + wave] = w2; slots[par * 24 + 16 + wave] = w3; }
    __syncthreads();
    typedef int i32x4 __attribute__((ext_vector_type(4)));
    const LAS i32x4* p = (const LAS i32x4*)(slots + par * 24);
    const i32x4 a = p[0], b = p[1], c = p[2], d = p[3], e = p[4], f = p[5];
    t1 = (a.x + a.y) + (a.z + a.w) + (b.x + b.y) + (b.z + b.w); t2 = (c.x + c.y) + (c.z + c.w) + (d.x + d.y) + (d.z + d.w); t3 = (e.x + e.y) + (e.z + e.w) + (f.x + f.y) + (f.z + f.w);
}
__device__ __forceinline__ int block_excl_scan(LAS int* slots, int wave, int lane, int c, int& total) {
    int incl = c;
#pragma unroll
    for (int o = 1; o < 64; o <<= 1) { const int t = __shfl_up(incl, o); if (lane >= o) incl += t; }
    __syncthreads();
    if (lane == 63) slots[wave] = incl;
    __syncthreads();
    int base = 0, tot = 0;
#pragma unroll
    for (int w = 0; w < 8; ++w) { const int x = slots[w]; tot += x; if (w < wave) base += x; }
    total = tot; return base + incl - c;
}
template <int NV>
__device__ __forceinline__ void rank_group(const Frame& F, const float* src, int ntok, int cap, int* slot_out  , int rho0) {
    const int tid = F.tid, lane = F.lane, wave = F.wave;
    LAS int* cs = (LAS int*)(F.lds + RING_OFF);
    LAS int* cs3 = cs + 32;
    const bool act = NV * tid < ntok;
    float val[NV]; unsigned key[NV];
    if constexpr (NV == 8) { const f32x4 a = *(const f32x4*)(src + 8 * tid), b = *(const f32x4*)(src + 8 * tid + 4); val[0] = a.x; val[1] = a.y; val[2] = a.z; val[3] = a.w; val[4] = b.x; val[5] = b.y; val[6] = b.z; val[7] = b.w; }
    else { val[0] = act ? src[tid] : 0.f; }
#pragma unroll
    for (int i = 0; i < NV; ++i) key[i] = act ? __builtin_bit_cast(unsigned, val[i]) : 0u;
    unsigned prefix = 0u; int par = 0;
    { const unsigned cand = 1u << 30; int wc = 0;
#pragma unroll
      for (int i = 0; i < NV; ++i) wc += (int)__builtin_popcountll(__ballot(key[i] >= cand));
      if (block_count8(cs, par, wave, lane, wc) >= cap) prefix = cand;
      par ^= 1; }
    for (int bit = 28; bit >= 0; bit -= 2) {
        const unsigned c1 = prefix | (1u << bit), c2 = prefix | (2u << bit), c3 = prefix | (3u << bit); int w1 = 0, w2 = 0, w3 = 0;
#pragma unroll
        for (int i = 0; i < NV; ++i) { w1 += (int)__builtin_popcountll(__ballot(key[i] >= c1)); w2 += (int)__builtin_popcountll(__ballot(key[i] >= c2)); w3 += (int)__builtin_popcountll(__ballot(key[i] >= c3)); }
        int t1, t2, t3; block_count8x3(cs3, par, wave, lane, w1, w2, w3, t1, t2, t3);
        prefix = (t3 >= cap) ? c3 : (t2 >= cap) ? c2 : (t1 >= cap) ? c1 : prefix;
        par ^= 1;
    }
    const unsigned T = prefix;
    int wc = 0;
#pragma unroll
    for (int i = 0; i < NV; ++i) wc += (int)__builtin_popcountll(__ballot(key[i] > T));
    const int ngt = block_count8(cs, par, wave, lane, wc); par ^= 1;
    const int R = cap - ngt;
    int ceq = 0;
#pragma unroll
    for (int i = 0; i < NV; ++i) ceq += (key[i] == T) ? 1 : 0;
    int tot; int eqr = block_excl_scan(cs + 16, wave, lane, ceq, tot);
    bool sel[NV]; int csel = 0;
#pragma unroll
    for (int i = 0; i < NV; ++i) { const bool eq = key[i] == T; sel[i] = (key[i] > T) || (eq && eqr < R); eqr += eq ? 1 : 0; csel += sel[i] ? 1 : 0; }
    int sl = block_excl_scan(cs + 16, wave, lane, csel, tot);
    if (act) {
#pragma unroll
        for (int i = 0; i < NV; ++i) { const int t = NV * tid + i; slot_out[(size_t)t * 16] = sel[i] ? sl : 0x7fffffff;
            if (sel[i]) { ((int*)(F.ws + WS_IDX))[rho0 + sl] = t; ((float*)(F.ws + WS_GATE))[rho0 + sl] = val[i]; ++sl; } }
    }
    __syncthreads();
}
__device__ __forceinline__ void phase_rank(const Frame& F0, int l) {
    const Frame F = fresh(F0);
    const int nunits = 64 + ((l == 0) ? 64 : 0);
    for (int un = F.bx; un < nunits; un += F.G) {
        if (un < 64) { const int b = un >> 4, e = un & 15;
            rank_group<8>(F, ((float*)(F.ws + WS_AFFT)) + (size_t)un * SEQ, SEQ, CAP_L, ((int*)(F.ws + WS_SLOT)) + (size_t)(b * SEQ) * 16 + e, (e * 4 + b) * 512); }
        else { const int g = un - 64, b = g >> 4, e = g & 15;
            rank_group<1>(F, ((float*)(F.ws + WS_AFFT)) + (size_t)NB * NE * SEQ + (size_t)g * CTXL, CTXL, CAP_C, ((int*)(F.ws + WS_SLOT)) + (size_t)(ML + b * CTXL) * 16 + e, 32768 + e * 256 + b * 32); }
    }
}
__device__ __forceinline__ void phase_gather(const Frame& F0, int l) {
    const Frame F = fresh(F0);
    const int lane = F.lane; const int nrows = (l == 0) ? XS_ROWS : 32768;
    for (int rho = F.gw; rho < nrows; rho += F.ngw) {
        const bf16_t* src = nullptr;
        if (rho < 32768) { const int ge = rho >> 9, b = ge & 3; src = ((bf16_t*)(F.ws + WS_H)) + (size_t)(b * SEQ + ((int*)(F.ws + WS_IDX))[rho]) * DM; }
        else { const int i = (rho - 32768) & 255; if (i < 128) { const int b = i >> 5; src = ((bf16_t*)(F.ws + WS_H)) + (size_t)(ML + b * CTXL + ((int*)(F.ws + WS_IDX))[rho]) * DM; } else if (lane == 0) ((float*)(F.ws + WS_GATE))[rho] = 0.f; }
        bf16_t* dst = ((bf16_t*)(F.ws + WS_XS)) + (size_t)rho * DM + 8 * lane;
#pragma unroll
        for (int j = 0; j < 4; ++j) { const u32x4 w = src ? *(const u32x4*)(src + 8 * lane + 512 * j) : (u32x4){0u, 0u, 0u, 0u}; *(u32x4*)(dst + 512 * j) = w; }
    }
}

#ifndef PH_MASK
#define PH_MASK 0xFFFFFFFFu
#endif
#ifndef DUP_MASK
#define DUP_MASK 0x0u
#endif
#define SLOT_OF(k) (((k) < 2) ? (k) : (((k) - 2) % 11 + 2))
#define REPS(k) for (int rep_ = 0; rep_ < 1 + (int)((DUP_MASK >> SLOT_OF(k)) & 1u); ++rep_)
#define IN(k) (lo <= (k) && (k) < hi && ((PH_MASK >> (((k) < 2) ? (k) : (((k) - 2) % 11 + 2))) & 1u))
#define SEAM(k) do { if (IN(k) && IN((k) + 1)) xcd_barrier(bar); } while (0)
#define SEAMP(k, HOOK) do { if (IN(k) && IN((k) + 1)) { xcd_arrive(bar); HOOK; xcd_wait(bar); } } while (0)
template <int L> __device__ __forceinline__ void layer_program(const Frame& F0, const int lo, const int hi, const XcdBarrier& bar, LAS unsigned char* ring) {
    {
        constexpr int l = L; constexpr int pb = 2 + 11 * l;
        const int mrows = (l == 0) ? MT : ML;
        const int xrows = (l == 0) ? XS_ROWS : 32768;
        if (IN(pb + 0)) REPS(pb + 0) { phase_norm1(F0, l); } SEAM(pb + 0);
        if (IN(pb + 1)) REPS(pb + 1) {
            const Frame F = fresh(F0);
            pg8::Gemm g{((bf16_t*)(F.ws + WS_H)), ((bf16_t*)(F.ws + WS_WIN)) + (size_t)l * PW * DM, DM}; pg8::StaticOrder S; if (l == NL - 1) { S.init(ML, PW, F.G, F.bx, 0); S.ex_n = 32; S.ex_pm0 = ML / 256; S.ex_pn0 = AW / 256; } else S.init(MT, PW, F.G, F.bx, 0);
            EpiProj E{((bf16_t*)(F.ws + WS_P)), F.in(I_BIN) + l * PW};
            pg8::gemm_phase<EpiProj, pg8::StaticOrder, true, true>(ring, g, S, E, F.wave);
        } SEAM(pb + 1);
        if (IN(pb + 2)) REPS(pb + 2) { phase_prep(F0, l); phase_glu_sc(F0, l, mrows); } SEAMP(pb + 2, conv_taps_fill(F0, l));
        if (IN(pb + 3)) REPS(pb + 3) { phase_conv2(F0, l, mrows, IN(pb + 2) && DUP_MASK == 0u); phase_attn(F0, l); } SEAM(pb + 3);
        if (IN(pb + 4)) REPS(pb + 4) {
            { const Frame F = fresh(F0); pg8::StaticOrder S; S.init(mrows, DM, F.G, F.bx, 0);
              pg8::Gemm g{((bf16_t*)(F.ws + WS_ATT)), ((bf16_t*)(F.ws + WS_WAO)) + (size_t)l * DM * AW, AW}; EpiGate<false> E{((bf16_t*)(F.ws + WS_MX)), (const unsigned char*)(((bf16_t*)(F.ws + WS_P)) + GATE_COL)}; pg8::gemm_phase<EpiGate<false>, pg8::StaticOrder, true, true>(ring, g, S, E, F.wave); }
            { const Frame F = fresh(F0); pg8::StaticOrder S; S.init(mrows, DM, F.G, F.bx, 0);
              pg8::Gemm g{((bf16_t*)(F.ws + WS_CONV)), ((bf16_t*)(F.ws + WS_WCO)) + (size_t)l * DM * CWD, CWD}; EpiGate<true> E{((bf16_t*)(F.ws + WS_MX)), (const unsigned char*)(((bf16_t*)(F.ws + WS_P)) + GATE_COL) + DM}; pg8::gemm_phase<EpiGate<true>, pg8::StaticOrder, true, true>(ring, g, S, E, F.wave); }
            { const Frame F = fresh(F0); pg8::StaticOrder S; S.init(mrows, DM, F.G, F.bx, 0);
              pg8::Gemm g{((bf16_t*)(F.ws + WS_SC)), ((bf16_t*)(F.ws + WS_WSO)) + (size_t)l * DM * SWD, SWD}; EpiGate<true> E{((bf16_t*)(F.ws + WS_MX)), (const unsigned char*)(((bf16_t*)(F.ws + WS_P)) + GATE_COL) + 2 * DM}; pg8::gemm_phase<EpiGate<true>, pg8::StaticOrder, true, true>(ring, g, S, E, F.wave); }
        } SEAM(pb + 4);
        if (IN(pb + 5)) REPS(pb + 5) {
            const Frame F = fresh(F0);
            pg8::Gemm g{((bf16_t*)(F.ws + WS_MX)), ((bf16_t*)(F.ws + WS_WO)) + (size_t)l * DM * DM, DM}; pg8::StaticOrder S; S.init(mrows, DM, F.G, F.bx, 0);
            EpiDelta E{((bf16_t*)(F.ws + WS_XM)), ((float*)(F.ws + WS_MOD)) + (size_t)l * 5 * 12288 + 2 * DM};
            pg8::gemm_phase<EpiDelta, pg8::StaticOrder, true, true>(ring, g, S, E, F.wave);
        } SEAMP(pb + 5, router_fill(F0, l));
        if (IN(pb + 6)) REPS(pb + 6) { phase_norm2p(F0, l, mrows, IN(pb + 5) && DUP_MASK == 0u); } SEAM(pb + 6);
        if (IN(pb + 7)) REPS(pb + 7) { phase_rank(F0, l); } SEAM(pb + 7);
        if (IN(pb + 9)) REPS(pb + 9) {
            const Frame F = fresh(F0);
            pg8::StaticOrder S; S.init(xrows, 2048, F.G, F.bx, 1);
            LAS int* gidx = (LAS int*)(F.lds + RING_BYTES + 1024);
            { pg8::Unit u;
              for (int si = 0; S.next(si, u); ++si) if (F.tid < 256) { const int rho = u.pm * 256 + F.tid; int src;
                  if (rho < 32768) src = ((rho >> 9) & 3) * SEQ + ((const int*)(F.ws + WS_IDX))[rho];
                  else { const int i = (rho - 32768) & 255; if (i < 128) src = ML + (i >> 5) * CTXL + ((const int*)(F.ws + WS_IDX))[rho]; else { src = 0; ((float*)(F.ws + WS_GATE))[rho] = 0.f; } }
                  gidx[si * 256 + F.tid] = src; } }
            __syncthreads();
            pg8::Gemm g{(const bf16_t*)(F.ws + WS_H8), (const bf16_t*)(F.ws + WS_W13 + (size_t)l * NE * 2048 * DM), DM / 2};
            EpiSwiglu E{(unsigned char*)(F.ws + WS_HID)};
            pg8::gemm_phase<EpiSwiglu, pg8::StaticOrder, true, true, true, true>(ring, g, S, E, F.wave, gidx);
        } SEAM(pb + 9);
        if (IN(pb + 10)) REPS(pb + 10) {
            const Frame F = fresh(F0);
            pg8::Gemm g{(const bf16_t*)(F.ws + WS_HID), (const bf16_t*)(F.ws + WS_W2 + (size_t)l * NE * DM * FF), FF / 2}; pg8::StaticOrder S; S.init(xrows, DM, F.G, F.bx, 1);
            EpiY E{((bf16_t*)(F.ws + WS_Y)), ((float*)(F.ws + WS_GATE))};
            pg8::gemm_phase<EpiY, pg8::StaticOrder, true, true, false, true>(ring, g, S, E, F.wave);
        } SEAM(pb + 10);
    }
}
struct Args { const float* in[26]; float* out; unsigned char* ws; int ph_lo, ph_hi; };
__global__ void __launch_bounds__(NWAVES * 64, 2) mk_fwd(Args args) {
    extern __shared__ __attribute__((aligned(16))) unsigned char lds[];
    Frame F;
    F.lds = (LAS unsigned char*)lds;
    volatile LAS unsigned* MISC = (volatile LAS unsigned*)(F.lds + MISC_OFF);
    F.wave = __builtin_amdgcn_readfirstlane((int)threadIdx.x >> 6); F.tid = F.wave * 64 + mk_lane_id(); F.lane = F.tid & 63;
    F.G = gridDim.x; F.bx = blockIdx.x; F.gw = blockIdx.x * NWAVES + F.wave; F.ngw = F.G * NWAVES;
    F.karg = (const CAS unsigned char*)__builtin_amdgcn_kernarg_segment_ptr(); F.out = nullptr; F.ws = nullptr;
    unsigned char* ws = args.ws;
    for (int u = F.tid; u < (LDS_BYTES - RING_BYTES) / 4; u += NWAVES * 64) ((LAS unsigned*)(F.lds + RING_BYTES))[u] = 0u;
    __syncthreads();
    const int lo = args.ph_lo, hi = args.ph_hi;
    XcdBarrier bar; bar.bar = (unsigned*)(ws + WS_CTL) + CW_BAR; bar.x = 0; bar.st = nullptr; bar.w0 = (F.wave == 0);
    if (hi - lo > 1) bar = xcd_barrier_post((unsigned*)(ws + WS_CTL) + CW_BAR, MISC + 8, F.wave == 0);
    LAS unsigned char* ring = F.lds + RING_OFF;
    const Frame& F0 = F;

    if (IN(0)) REPS(0) { phase_pa(F0); } SEAM(0);
    if (IN(1)) REPS(1) { phase_pa2(F0); } SEAM(1);
    layer_program<0>(F0, lo, hi, bar, ring);
    layer_program<1>(F0, lo, hi, bar, ring);
    if (IN(24)) REPS(24) { phase_final(F0); }
#undef IN
#undef SEAM
}

extern "C" void kernel_launch(void* const* d_in, const int* in_sizes, int n_in, void* d_out, int out_size, void* d_ws, size_t ws_size, hipStream_t stream) {
    static int grid = 0;
    if (grid == 0) {
        if (n_in != 26 || out_size != ML * DM || ws_size < WS_END) { fprintf(stderr, "kernel_launch: unexpected shapes (n_in %d, out %d, ws %zu < %zu)\n", n_in, out_size, ws_size, (size_t)WS_END); grid = -1; return; }
        int dev = 0, cus = 0, per_cu = 0;
        if (hipGetDevice(&dev) != hipSuccess || hipDeviceGetAttribute(&cus, hipDeviceAttributeMultiprocessorCount, dev) != hipSuccess) { grid = -1; return; }
        if (hipFuncSetAttribute((const void*)mk_fwd, hipFuncAttributeMaxDynamicSharedMemorySize, LDS_BYTES) != hipSuccess) { fprintf(stderr, "kernel_launch: hipFuncSetAttribute failed\n"); grid = -1; return; }
        if (hipOccupancyMaxActiveBlocksPerMultiprocessor(&per_cu, (const void*)mk_fwd, NWAVES * 64, LDS_BYTES) != hipSuccess || per_cu < 1) fprintf(stderr, "kernel_launch: occupancy query says %d\n", per_cu);
        (void)hipGetLastError();
        grid = cus;
    }
    if (grid < 0) return;
    (void)hipMemsetAsync((char*)d_ws + WS_CTL, 0, CTL_ZERO_BYTES, stream);
    Args a{};
    for (int i = 0; i < 26; ++i) a.in[i] = (const float*)d_in[i];
    a.out = (float*)d_out; a.ws = (unsigned char*)d_ws;
#if MK_PER_PHASE
    for (int p = 0; p < NPHASE; ++p) { a.ph_lo = p; a.ph_hi = p + 1; hipLaunchKernelGGL(mk_fwd, dim3(grid), dim3(NWAVES * 64), LDS_BYTES, stream, a); }
#else
    a.ph_lo = 0; a.ph_hi = NPHASE; hipLaunchKernelGGL(mk_fwd, dim3(grid), dim3(NWAVES * 64), LDS_BYTES, stream, a);
#endif
}
```

```cpp
#include <hip/hip_runtime.h>
#include <cstdio>
#include <cstdint>

#ifndef MK_PER_PHASE
#define MK_PER_PHASE 0
#endif

__device__ __forceinline__ int mk_lane_id() { unsigned z = 0u; asm volatile("" : "+v"(z)); return (int)__builtin_amdgcn_mbcnt_hi(~0u, __builtin_amdgcn_mbcnt_lo(~0u, z)); }
namespace pg8 {
#define PG8_LAS __attribute__((address_space(3)))
typedef unsigned short bf16_t;
typedef short bf16x8 __attribute__((ext_vector_type(8)));
typedef float f32x4 __attribute__((ext_vector_type(4)));
typedef float f32x2 __attribute__((ext_vector_type(2)));
typedef unsigned u32x4 __attribute__((ext_vector_type(4)));
typedef unsigned u32x2 __attribute__((ext_vector_type(2)));
typedef int i32x4 __attribute__((ext_vector_type(4)));
typedef int i32x8 __attribute__((ext_vector_type(8)));
constexpr int BM = 256, BK = 64, HALF = 128, HTB = HALF * BK * 2, STAGE_BYTES = 8 * HTB, NXCD = 8, WGM = 8;

__host__ __device__ __forceinline__ int lds_byte(int r, int c) { const int st = (r >> 4) * 2 + (c >> 5), rr = r & 15, cc = c & 31, ob = rr * 64 + cc * 2; return st * 1024 + (ob ^ (((ob >> 9) & 1) << 5)); }
__host__ __device__ __forceinline__ void stage_rc(int b, int& R, int& C) { const int st = b / 1024, sb = b % 1024, swz = sb ^ (((sb >> 9) & 1) << 5); R = (st >> 1) * 16 + swz / 64; C = (st & 1) * 32 + (swz % 64) / 2; }
__host__ __device__ __forceinline__ int perm32(int rho) { const int n = rho >> 4, i = rho & 15; return 8 * (i >> 2) + 4 * n + (i & 3); }

struct Unit { int pm, pn, pb; };
struct Gemm { const bf16_t* A; const bf16_t* Bt; int K; };

struct StaticOrder {
    int nM, nN, nwg, G, c, moe, ex_n, ex_pm0, ex_pn0;
    __host__ __device__ void init(int M, int N, int G_, int c_, int moe_) { nM = M / BM; nN = N / BM; nwg = nM * nN; G = G_; c = c_; moe = moe_; ex_n = 0; ex_pm0 = 0; ex_pn0 = 0; }
    __host__ __device__ bool next(int i, Unit& u) const {
        const long L = (long)i * G + c; if (L >= nwg + ex_n) return false;
        if (L >= nwg) { const int q = (int)L - nwg; u.pm = ex_pm0 + (q & 3); u.pn = ex_pn0 + (q >> 2); u.pb = u.pn; return true; }
        int wgid = (int)L; { const int q = nwg / NXCD, r = nwg % NXCD, xcd = wgid % NXCD, off = wgid / NXCD; wgid = (xcd < r ? xcd * (q + 1) : r * (q + 1) + (xcd - r) * q) + off; }
        const int nig = WGM * nN, gid = wgid / nig, fm = gid * WGM, gsz = (nM - fm) < WGM ? (nM - fm) : WGM;
        u.pm = fm + ((wgid % nig) % gsz); u.pn = (wgid % nig) / gsz;
        u.pb = moe ? ((u.pm < 128 ? (u.pm >> 3) : (u.pm - 128)) * nN + u.pn) : u.pn;
        return true;
    }
    __device__ __forceinline__ void a_ready(const Unit&) const {}
    __device__ __forceinline__ void done(const Unit&) const {}
};

__device__ __forceinline__ unsigned cvt_pk_bf16(float lo, float hi) { unsigned r; asm volatile("v_cvt_pk_bf16_f32 %0, %1, %2" : "=v"(r) : "v"(lo), "v"(hi)); return r; }

template <class Epi, class Sched, bool ALIGN_EPI = false, bool SP2 = false, bool GATHER = false, bool FP8 = false>
__device__ __forceinline__ void gemm_phase(PG8_LAS unsigned char* lds, const Gemm g, const Sched& S, const Epi& E, const int wave_id, const PG8_LAS int* gidx = nullptr) {
    static_assert(!GATHER || SP2, "GATHER is written for the SP2 loop");
    int tid_ = wave_id * 64 + mk_lane_id(); asm volatile("" : "+v"(tid_));
    const int tid = tid_, wid = __builtin_amdgcn_readfirstlane(tid >> 6), lane = tid & 63, wr = wid >> 2, wc = wid & 3, fr = lane & 15, fq = lane >> 4;
    const int K = g.K, nt = K / BK;
    unsigned voffA[2], voffB[2];
#pragma unroll
    for (int i = 0; i < 2; ++i) { int R, C; stage_rc(tid * 16 + i * 8192, R, C); const int Rb = Epi::PERM ? ((R & ~31) + perm32(R & 31)) : R;
        voffA[i] = (unsigned)(R * K + C) * 2u; voffB[i] = (unsigned)(Rb * K + C) * 2u; }
    int gR[2]; unsigned gC[2]; unsigned oc[2][2], on[2][2];
#pragma unroll
    for (int i = 0; i < 2; ++i) { int R, C; stage_rc(tid * 16 + i * 8192, R, C); gR[i] = R; gC[i] = (unsigned)C * 2u; }
#define PG8_GOFF(dst, slot) do { _Pragma("unroll") for (int _h = 0; _h < 2; ++_h) _Pragma("unroll") for (int _i = 0; _i < 2; ++_i) dst[_h][_i] = (unsigned)gidx[(slot) * 256 + _h * 128 + gR[_i]] * (unsigned)(K * 2) + gC[_i]; } while (0)
    const size_t kstep = (size_t)(BK * 2);
    const size_t hstep = (size_t)HALF * K * 2;
    const size_t tstep = 2 * hstep;
    const unsigned ldsw = (unsigned)wid * 1024u;
    const int aoff = lds_byte(wr * 64 + fr, fq * 8), boff = lds_byte(wc * 32 + fr, fq * 8);
#define PG8_SA(b, h) (((b) * 2 + (h)) * HTB)
#define PG8_SB(b, h) ((4 + (b) * 2 + (h)) * HTB)
#define PG8_STAGE(bufoff, gbase, voff) do { _Pragma("unroll") for (int _i = 0; _i < 2; ++_i) \
        __builtin_amdgcn_global_load_lds((const unsigned*)((const char*)(gbase) + (voff)[_i]), (PG8_LAS unsigned*)(lds + (bufoff) + ldsw + _i * 8192), 16, 0, 0); } while (0)
#define PG8_STAGE_G(bufoff, kt_, o0, o1) do { const char* _gb = (const char*)g.A + (size_t)(kt_) * kstep; \
        __builtin_amdgcn_global_load_lds((const unsigned*)(_gb + (o0)), (PG8_LAS unsigned*)(lds + (bufoff) + ldsw), 16, 0, 0); \
        __builtin_amdgcn_global_load_lds((const unsigned*)(_gb + (o1)), (PG8_LAS unsigned*)(lds + (bufoff) + ldsw + 8192), 16, 0, 0); } while (0)
#define PG8_LDA(dst, b, h) do { _Pragma("unroll") for (int m = 0; m < 4; ++m) { if constexpr (FP8) dst##8[m] = __builtin_shufflevector(*(const PG8_LAS i32x4*)(lds + PG8_SA(b, h) + aoff + m * 2048), *(const PG8_LAS i32x4*)(lds + PG8_SA(b, h) + aoff + m * 2048 + 1024), 0, 1, 2, 3, 4, 5, 6, 7); \
        else { _Pragma("unroll") for (int k = 0; k < 2; ++k) dst[m][k] = *(const PG8_LAS bf16x8*)(lds + PG8_SA(b, h) + aoff + m * 2048 + k * 1024); } } } while (0)
#define PG8_LDB(dst, b, h) do { _Pragma("unroll") for (int n = 0; n < 2; ++n) { if constexpr (FP8) dst##8[n] = __builtin_shufflevector(*(const PG8_LAS i32x4*)(lds + PG8_SB(b, h) + boff + n * 2048), *(const PG8_LAS i32x4*)(lds + PG8_SB(b, h) + boff + n * 2048 + 1024), 0, 1, 2, 3, 4, 5, 6, 7); \
        else { _Pragma("unroll") for (int k = 0; k < 2; ++k) dst[n][k] = *(const PG8_LAS bf16x8*)(lds + PG8_SB(b, h) + boff + n * 2048 + k * 1024); } } } while (0)
#define PG8_CAT(x, y) __builtin_shufflevector(__builtin_bit_cast(i32x4, x), __builtin_bit_cast(i32x4, y), 0, 1, 2, 3, 4, 5, 6, 7)
#define PG8_MMA(ai, bj, At, Bt) do { __builtin_amdgcn_s_setprio(1); _Pragma("unroll") for (int m = 0; m < 4; ++m) _Pragma("unroll") for (int n = 0; n < 2; ++n) { \
        if constexpr (FP8) acc[ai][bj][m][n] = __builtin_amdgcn_mfma_scale_f32_16x16x128_f8f6f4(Bt##8[n], At##8[m], acc[ai][bj][m][n], 0, 0, 0, 0x7F7F7F7F, 0, 0x7F7F7F7F); \
        else { _Pragma("unroll") for (int k = 0; k < 2; ++k) acc[ai][bj][m][n] = __builtin_amdgcn_mfma_f32_16x16x32_bf16(Bt[n][k], At[m][k], acc[ai][bj][m][n], 0, 0, 0); } } __builtin_amdgcn_s_setprio(0); \
        if constexpr (FP8) { _Pragma("unroll") for (int m = 0; m < 4; ++m) _Pragma("unroll") for (int n = 0; n < 2; ++n) asm volatile("" : "+a"(acc[ai][bj][m][n])); } } while (0)
#define PG8_WAIT_V(n) asm volatile("s_waitcnt vmcnt(" #n ")" ::: "memory")
#define PG8_WAIT_L(n) asm volatile("s_waitcnt lgkmcnt(" #n ")" ::: "memory")
#define PG8_BAR __builtin_amdgcn_s_barrier()
#define PG8_SCHED __builtin_amdgcn_sched_barrier(0)
    Unit cur, nxt; int ui = 0;
    if (!S.next(0, cur)) return;
    f32x4 acc[2][2][4][2];
#pragma unroll
    for (int a = 0; a < 2; ++a)
#pragma unroll
        for (int b = 0; b < 2; ++b)
#pragma unroll
            for (int m = 0; m < 4; ++m)
#pragma unroll
                for (int n = 0; n < 2; ++n) acc[a][b][m][n] = (f32x4){0.f, 0.f, 0.f, 0.f};
    bf16x8 At[4][2], B0[2][2], B1[2][2];
    i32x8 At8[4], B08[2], B18[2];
    const char* cA = (const char*)g.A + (size_t)cur.pm * tstep; const char* cB = (const char*)g.Bt + (size_t)cur.pb * tstep;
    S.a_ready(cur);
    if constexpr (SP2) {
        if constexpr (GATHER) { PG8_GOFF(oc, 0); }
        PG8_STAGE(PG8_SB(0, 0), cB, voffB); PG8_STAGE(PG8_SB(0, 1), cB + hstep, voffB);
        if constexpr (GATHER) { PG8_STAGE_G(PG8_SA(0, 0), 0, oc[0][0], oc[0][1]); PG8_STAGE_G(PG8_SA(0, 1), 0, oc[1][0], oc[1][1]); }
        else { PG8_STAGE(PG8_SA(0, 0), cA, voffA); PG8_STAGE(PG8_SA(0, 1), cA + hstep, voffA); }
        if (wr == 1) PG8_BAR;
        PG8_WAIT_V(2); PG8_BAR;
        PG8_STAGE(PG8_SB(1, 0), cB + kstep, voffB);
        if constexpr (GATHER) { PG8_STAGE_G(PG8_SA(1, 0), 1, oc[0][0], oc[0][1]); } else { PG8_STAGE(PG8_SA(1, 0), cA + kstep, voffA); }
        PG8_STAGE(PG8_SB(1, 1), cB + hstep + kstep, voffB);
        PG8_WAIT_V(6); PG8_BAR;
    } else {
        PG8_STAGE(PG8_SB(0, 0), cB, voffB); PG8_STAGE(PG8_SA(0, 0), cA, voffA); PG8_STAGE(PG8_SB(0, 1), cB + hstep, voffB); PG8_STAGE(PG8_SA(0, 1), cA + hstep, voffA);
        if (wr == 1) PG8_BAR;
        PG8_WAIT_V(4); PG8_BAR;
        PG8_STAGE(PG8_SB(1, 0), cB + kstep, voffB); PG8_STAGE(PG8_SA(1, 0), cA + kstep, voffA); PG8_STAGE(PG8_SB(1, 1), cB + hstep + kstep, voffB);
        PG8_WAIT_V(6); PG8_BAR;
    }
    for (;;) {
        const bool has_next = S.next(ui + 1, nxt);
        if constexpr (GATHER) { if (has_next) { PG8_GOFF(on, ui + 1); } else { _Pragma("unroll") for (int _h = 0; _h < 2; ++_h) _Pragma("unroll") for (int _i = 0; _i < 2; ++_i) on[_h][_i] = oc[_h][_i]; } }
        const char* nA = has_next ? (const char*)g.A + (size_t)nxt.pm * tstep : cA; const char* nB = has_next ? (const char*)g.Bt + (size_t)nxt.pb * tstep : cB;
#pragma nounroll
        for (int t = 0; t < nt; t += 2) {
            const bool last = (t == nt - 2);
            const char* a1 = cA + (size_t)(t + 1) * kstep;
            const char* a2 = last ? nA : cA + (size_t)(t + 2) * kstep; const char* b2 = last ? nB : cB + (size_t)(t + 2) * kstep;
            const char* a3 = a2 + kstep; const char* b3 = b2 + kstep;
            if (last && has_next) S.a_ready(nxt);
            if constexpr (SP2) {
            const int kt2 = last ? 0 : t + 2, kt3 = kt2 + 1;
            unsigned s00, s01, s10, s11; if constexpr (GATHER) { s00 = last ? on[0][0] : oc[0][0]; s01 = last ? on[0][1] : oc[0][1]; s10 = last ? on[1][0] : oc[1][0]; s11 = last ? on[1][1] : oc[1][1]; }
            PG8_LDB(B0, 0, 0); PG8_LDB(B1, 0, 1); PG8_SCHED; PG8_LDA(At, 0, 0);
            if constexpr (GATHER) { PG8_STAGE_G(PG8_SA(1, 1), t + 1, oc[1][0], oc[1][1]); } else { PG8_STAGE(PG8_SA(1, 1), a1 + hstep, voffA); }
            PG8_WAIT_V(8); PG8_WAIT_L(0); PG8_BAR; PG8_MMA(0, 0, At, B0); PG8_MMA(0, 1, At, B1); PG8_BAR; PG8_SCHED;
            PG8_LDA(At, 0, 1); PG8_STAGE(PG8_SB(0, 0), b2, voffB); PG8_STAGE(PG8_SB(0, 1), b2 + hstep, voffB);
            if constexpr (GATHER) { PG8_STAGE_G(PG8_SA(0, 0), kt2, s00, s01); } else { PG8_STAGE(PG8_SA(0, 0), a2, voffA); }
            PG8_WAIT_V(8); PG8_WAIT_L(0); PG8_BAR; PG8_MMA(1, 0, At, B0); PG8_MMA(1, 1, At, B1); PG8_BAR; PG8_SCHED;
            PG8_LDB(B0, 1, 0); PG8_LDB(B1, 1, 1); PG8_SCHED; PG8_LDA(At, 1, 0);
            if constexpr (GATHER) { PG8_STAGE_G(PG8_SA(0, 1), kt2, s10, s11); } else { PG8_STAGE(PG8_SA(0, 1), a2 + hstep, voffA); }
            PG8_WAIT_V(8); PG8_WAIT_L(0); PG8_BAR; PG8_MMA(0, 0, At, B0); PG8_MMA(0, 1, At, B1); PG8_BAR; PG8_SCHED;
            PG8_LDA(At, 1, 1); PG8_STAGE(PG8_SB(1, 0), b3, voffB); PG8_STAGE(PG8_SB(1, 1), b3 + hstep, voffB);
            if constexpr (GATHER) { PG8_STAGE_G(PG8_SA(1, 0), kt3, s00, s01); } else { PG8_STAGE(PG8_SA(1, 0), a3, voffA); }
            PG8_WAIT_V(8); PG8_WAIT_L(0); PG8_BAR; PG8_MMA(1, 0, At, B0); PG8_MMA(1, 1, At, B1); PG8_BAR; PG8_SCHED;
            } else {
            PG8_LDB(B0, 0, 0); PG8_SCHED; PG8_LDA(At, 0, 0); PG8_STAGE(PG8_SA(1, 1), a1 + hstep, voffA);
            PG8_WAIT_L(8); PG8_BAR; PG8_WAIT_L(0); PG8_MMA(0, 0, At, B0); PG8_BAR; PG8_SCHED;
            PG8_LDB(B1, 0, 1); PG8_STAGE(PG8_SB(0, 0), b2, voffB);
            PG8_BAR; PG8_WAIT_L(0); PG8_MMA(0, 1, At, B1); PG8_BAR;
            PG8_LDA(At, 0, 1); PG8_STAGE(PG8_SA(0, 0), a2, voffA);
            PG8_BAR; PG8_WAIT_L(0); PG8_MMA(1, 0, At, B0); PG8_BAR; PG8_SCHED;
            PG8_STAGE(PG8_SB(0, 1), b2 + hstep, voffB);
            PG8_WAIT_V(6); PG8_BAR; PG8_MMA(1, 1, At, B1); PG8_BAR;
            PG8_LDB(B0, 1, 0); PG8_SCHED; PG8_LDA(At, 1, 0); PG8_STAGE(PG8_SA(0, 1), a2 + hstep, voffA);
            PG8_WAIT_L(8); PG8_BAR; PG8_WAIT_L(0); PG8_MMA(0, 0, At, B0); PG8_BAR; PG8_SCHED;
            PG8_LDB(B1, 1, 1); PG8_STAGE(PG8_SB(1, 0), b3, voffB);
            PG8_BAR; PG8_WAIT_L(0); PG8_MMA(0, 1, At, B1); PG8_BAR;
            PG8_LDA(At, 1, 1); PG8_STAGE(PG8_SA(1, 0), a3, voffA);
            PG8_BAR; PG8_WAIT_L(0); PG8_MMA(1, 0, At, B0); PG8_BAR; PG8_SCHED;
            PG8_STAGE(PG8_SB(1, 1), b3 + hstep, voffB);
            PG8_WAIT_V(6); PG8_BAR; PG8_MMA(1, 1, At, B1); PG8_BAR;
            }
        }
        if constexpr (ALIGN_EPI) { if (wr == 0) PG8_BAR; }
        { int t2_ = mk_lane_id(); asm volatile("" : "+v"(t2_)); const int l2_ = t2_ & 63;
          E(acc, cur, wr, wc, l2_ & 15, l2_ >> 4); } S.done(cur);
        if (!has_next) break;
#pragma unroll
        for (int a = 0; a < 2; ++a)
#pragma unroll
            for (int b = 0; b < 2; ++b)
#pragma unroll
                for (int m = 0; m < 4; ++m)
#pragma unroll
                    for (int n = 0; n < 2; ++n) acc[a][b][m][n] = (f32x4){0.f, 0.f, 0.f, 0.f};
        cur = nxt; cA = nA; cB = nB; ++ui;
        if constexpr (GATHER) { _Pragma("unroll") for (int _h = 0; _h < 2; ++_h) _Pragma("unroll") for (int _i = 0; _i < 2; ++_i) oc[_h][_i] = on[_h][_i]; }
        if constexpr (ALIGN_EPI) { if (wr == 1) PG8_BAR; }
    }
    PG8_WAIT_V(0);
    if constexpr (!ALIGN_EPI) { if (wr == 0) PG8_BAR; }
    PG8_BAR;
#undef PG8_SA
#undef PG8_SB
#undef PG8_STAGE
#undef PG8_STAGE_G
#undef PG8_GOFF
#undef PG8_LDA
#undef PG8_LDB
#undef PG8_MMA
#undef PG8_CAT
#undef PG8_WAIT_V
#undef PG8_WAIT_L
#undef PG8_BAR
#undef PG8_SCHED
}
}

using pg8::bf16_t; using pg8::f32x4; using pg8::f32x2; using pg8::u32x4; using pg8::u32x2; using pg8::cvt_pk_bf16;
constexpr int NWAVES = 8;
constexpr int NB = 4, SEQ = 4096, DM = 2048, NL = 2, CTXL = 256, NH = 16, HD = 64, AW = 1024, CWD = 512, SWD = 512, PW = 11776, NE = 16, FF = 1024;
constexpr int ML = NB * SEQ, MC = NB * CTXL, MT = ML + MC;
constexpr int CAP_L = 512, CAP_C = 32;
constexpr int GATE_COL = 5632;
constexpr int XS_ROWS = 32768 + 16 * 256;
constexpr float EPS = 1e-6f;
constexpr float LOG2E = 1.4426950408889634f;
constexpr int NPHASE = 25;

constexpr size_t MiB = 1u << 20;
constexpr size_t WS_CTL = 0, CTL_ZERO_BYTES = 1 * MiB;
constexpr size_t WS_MOD = 1 * MiB;
constexpr size_t WS_ADAP = 2 * MiB;
constexpr size_t WS_ROPE = 10 * MiB;
constexpr size_t WS_AFFT = 11 * MiB;
constexpr size_t WS_SLOT = 13 * MiB;
constexpr size_t WS_IDX = 15 * MiB;
constexpr size_t WS_GATE = 15 * MiB + 512 * 1024;
constexpr size_t WS_WIN = 16 * MiB;
constexpr size_t WS_WAO = 108 * MiB;
constexpr size_t WS_WCO = 116 * MiB;
constexpr size_t WS_WSO = 120 * MiB;
constexpr size_t WS_WO = 124 * MiB;
constexpr size_t WS_W13 = 140 * MiB;
constexpr size_t WS_W2 = 396 * MiB;
constexpr size_t WS_H = 524 * MiB;
constexpr size_t WS_MX = 592 * MiB;
constexpr size_t WS_P = 660 * MiB;
constexpr size_t WS_XS = 660 * MiB;
constexpr size_t WS_HID = 804 * MiB;
constexpr size_t WS_H8 = 660 * MiB;
constexpr size_t WS_Y = 876 * MiB;
constexpr size_t WS_QR = 1052 * MiB, WS_QP = 1084 * MiB, WS_KR = 1116 * MiB, WS_VT = 1148 * MiB;
constexpr size_t WS_QC = 1180 * MiB, WS_KC = 1182 * MiB, WS_VCT = 1184 * MiB;
constexpr size_t WS_ATT = 1186 * MiB;
constexpr size_t WS_CONV = 1220 * MiB;
constexpr size_t WS_SC = 1237 * MiB;
constexpr size_t WS_XM = 1052 * MiB;
constexpr size_t WS_MSH = WS_ROPE + 16384;
constexpr size_t WS_TAB = 1254 * MiB;
constexpr size_t WS_U = 1258 * MiB;
constexpr size_t WS_MA2 = 1 * MiB + 768 * 1024;
constexpr size_t WS_X1 = 1276 * MiB;
constexpr size_t WS_END = 1340 * MiB;
static_assert(WS_P + (size_t)MT * PW * 2 <= WS_QR && WS_Y + (size_t)XS_ROWS * DM * 2 <= WS_QR && WS_XM + (size_t)MT * DM * 4 <= WS_CONV, "ws map");
constexpr int CW_BAR = 4096;

constexpr int RING_OFF = 0, RING_BYTES = 131072;
constexpr int MISC_OFF = RING_BYTES + 320;
constexpr int LDS_BYTES = 147456;

#define GAS __attribute__((address_space(1)))
#define CAS __attribute__((address_space(4)))
#define LAS __attribute__((address_space(3)))
#define LDS_WAIT() asm volatile("s_waitcnt lgkmcnt(0)" ::: "memory")
#define VM_WAIT() asm volatile("s_waitcnt vmcnt(0)" ::: "memory")
__device__ __forceinline__ unsigned f2bf(float f) { unsigned u = __builtin_bit_cast(unsigned, f); return (u + 0x7fffu + ((u >> 16) & 1u)) >> 16; }
__device__ __forceinline__ unsigned pk2(float lo, float hi) { return f2bf(lo) | (f2bf(hi) << 16); }
__device__ __forceinline__ float bflo(unsigned w) { return __builtin_bit_cast(float, w << 16); }
__device__ __forceinline__ float bfhi(unsigned w) { return __builtin_bit_cast(float, w & 0xffff0000u); }
__device__ __forceinline__ float bf1(bf16_t h) { return __builtin_bit_cast(float, ((unsigned)h) << 16); }
__device__ __forceinline__ float wave_sum(float v) {
#pragma unroll
    for (int o = 1; o < 64; o <<= 1) v += __shfl_xor(v, o);
    return v;
}
__device__ __forceinline__ float wave_max(float v) {
#pragma unroll
    for (int o = 1; o < 64; o <<= 1) v = fmaxf(v, __shfl_xor(v, o));
    return v;
}
__device__ __forceinline__ float sigmoidf_(float x) { return __builtin_amdgcn_rcpf(1.0f + __expf(-x)); }
__device__ __forceinline__ unsigned pk4_gate(float a, float b, float c, float d) {
    const unsigned fa = __float_as_uint(a * 255.0f + 8388608.0f), fb = __float_as_uint(b * 255.0f + 8388608.0f), fc = __float_as_uint(c * 255.0f + 8388608.0f), fd = __float_as_uint(d * 255.0f + 8388608.0f);
    return __builtin_amdgcn_perm(__builtin_amdgcn_perm(fd, fc, 0x0c0c0400u), __builtin_amdgcn_perm(fb, fa, 0x0c0c0400u), 0x05040100u);
}
__device__ __forceinline__ unsigned pk4_bytes(f32x4 f) {
    const unsigned fa = __float_as_uint(f.x), fb = __float_as_uint(f.y), fc = __float_as_uint(f.z), fd = __float_as_uint(f.w);
    return __builtin_amdgcn_perm(__builtin_amdgcn_perm(fd, fc, 0x0c0c0400u), __builtin_amdgcn_perm(fb, fa, 0x0c0c0400u), 0x05040100u);
}
__device__ __forceinline__ f32x4 gate4(unsigned w) { return (f32x4){(float)(w & 0xffu), (float)((w >> 8) & 0xffu), (float)((w >> 16) & 0xffu), (float)(w >> 24)}; }

#define XB_TMO      128
#define XB_XCNT(j)  (256  + 64 * (j))
#define XB_XSUB(j)  (1280 + 64 * (j))
#define XB_XGEN(j)  (2304 + 64 * (j))
#define XB_TOP      3328
#define XB_TOPGEN   3392
#define XCD_BAR_WORDS 3456
#define XB_SPIN_CAP (1u << 18)
__device__ __forceinline__ unsigned xb_ld(unsigned* p)              { return __hip_atomic_load(p, __ATOMIC_RELAXED, __HIP_MEMORY_SCOPE_AGENT); }
__device__ __forceinline__ unsigned xb_add(unsigned* p, unsigned v) { return __hip_atomic_fetch_add(p, v, __ATOMIC_RELAXED, __HIP_MEMORY_SCOPE_AGENT); }
__device__ __forceinline__ unsigned xb_xcc_id() { return (unsigned)__builtin_amdgcn_s_getreg((3 << 11) | 20) & 0xFu; }
#define XB_SPIN(cond, bar) do { unsigned _sp = 0; while (cond) { __builtin_amdgcn_s_sleep(1); \
    if ((++_sp & 255u) == 0u) { if (xb_ld(&(bar)[XB_TMO])) break; if (_sp > XB_SPIN_CAP) { atomicAdd(&(bar)[XB_TMO], 1u); break; } } } } while (0)
struct XcdBarrier { unsigned* bar; unsigned x; volatile LAS unsigned* st; bool w0; };
__device__ __forceinline__ XcdBarrier xcd_barrier_post(unsigned* bar, volatile LAS unsigned* st, bool w0) {
    XcdBarrier b; b.bar = bar; b.x = xb_xcc_id(); b.st = st; b.w0 = w0;
    if (b.w0 && mk_lane_id() == 0) (void)xb_add(&bar[XB_XCNT(b.x)], 1u);
    return b;
}
__device__ __forceinline__ void xcd_barrier_complete(unsigned* bar, unsigned x, unsigned& nloc, unsigned& nx) {
    const unsigned G = gridDim.x * gridDim.y * gridDim.z;
    unsigned sum, cnt, mine, sp = 0u;
    for (;;) {
        sum = 0u; cnt = 0u; mine = 0u;
#pragma unroll
        for (unsigned j = 0; j < 16; ++j) { const unsigned c = xb_ld(&bar[XB_XCNT(j)]); sum += c; cnt += (c > 0u) ? 1u : 0u; mine = (j == x) ? c : mine; }
        if (sum == G) break;
        __builtin_amdgcn_s_sleep(1);
        if ((++sp & 255u) == 0u) { if (xb_ld(&bar[XB_TMO])) break; if (sp > XB_SPIN_CAP) { atomicAdd(&bar[XB_TMO], 1u); break; } }
    }
    nloc = mine > 0u ? mine : 1u; nx = cnt > 0u ? cnt : 1u;
}
__device__ __forceinline__ void xcd_arrive(const XcdBarrier& b) {
    asm volatile("s_waitcnt vmcnt(0)" ::: "memory");
    __syncthreads();
    if (b.w0 && mk_lane_id() == 0) {
        unsigned* bar = b.bar;
        __builtin_amdgcn_s_waitcnt(0);
        unsigned nloc = b.st[0], nx = b.st[1];
        if (nloc == 0u) { xcd_barrier_complete(bar, b.x, nloc, nx); b.st[0] = nloc; b.st[1] = nx; }
        const unsigned old = xb_add(&bar[XB_XSUB(b.x)], 1u);
        const unsigned gen = old / nloc;
        if (old + 1u == (gen + 1u) * nloc) {
            __builtin_amdgcn_fence(__ATOMIC_RELEASE, "agent");
            asm volatile("s_waitcnt vmcnt(0)" ::: "memory");
            (void)xb_add(&bar[XB_TOP], 1u);
        }
        b.st[2] = (gen + 1u) * nx;
    }
}
__device__ __forceinline__ void xcd_wait(const XcdBarrier& b) {
    if (b.w0 && mk_lane_id() == 0) {
        unsigned* bar = b.bar;
        const unsigned target = b.st[2];
        XB_SPIN(xb_ld(&bar[XB_TOP]) < target, bar);
        __builtin_amdgcn_fence(__ATOMIC_ACQUIRE, "agent");
        asm volatile("s_waitcnt vmcnt(0)" ::: "memory");
    }
    __syncthreads();
}
__device__ __forceinline__ void xcd_barrier(const XcdBarrier& b) { xcd_arrive(b); xcd_wait(b); }

struct Frame {
    LAS unsigned char* lds;
    int tid, lane, wave, G, bx, gw, ngw;
    const CAS unsigned char* karg;
    unsigned char* ws; float* out;
    __device__ __forceinline__ const float* in(int i) const { return ((const float* const CAS*)karg)[i]; }
};
__device__ __forceinline__ Frame fresh(const Frame& F0) {
    Frame R; unsigned long long k = (unsigned long long)F0.karg; int t = F0.wave * 64 + mk_lane_id(), g = gridDim.x, bx = blockIdx.x; asm volatile("" : "+s"(k), "+v"(t), "+s"(g), "+s"(bx));
    R.karg = (const CAS unsigned char*)k; R.lds = F0.lds; R.tid = t; R.lane = t & 63; R.wave = F0.wave; R.G = g; R.bx = bx; R.gw = bx * NWAVES + R.wave; R.ngw = g * NWAVES;
    R.out = ((float* const CAS*)R.karg)[26]; R.ws = ((unsigned char* const CAS*)R.karg)[27]; return R;
}
enum { I_X = 0, I_C, I_CTX, I_CCTX, I_WADA, I_BADA, I_GN1, I_GN2, I_WIN, I_BIN, I_GQ, I_GK, I_RPB, I_WAO, I_CDW, I_CDB, I_CLG, I_CLB, I_WCO, I_SCW, I_WSO, I_WO, I_WR, I_WE1, I_WE3, I_WE2 };

__device__ __forceinline__ void conv_item(const float* W, int K, int N, bf16_t* WT, int k0, int n0, int drow0, LAS float* scr, int lane) {
    { const int rr = lane >> 3, cq = lane & 7; f32x4 t[8];
#pragma unroll
      for (int i = 0; i < 8; ++i) t[i] = *(const f32x4*)(W + (size_t)(k0 + 8 * i + rr) * N + n0 + 4 * cq);
#pragma unroll
      for (int i = 0; i < 8; ++i) { LAS float* d = scr + (8 * i + rr) * 33 + 4 * cq; d[0] = t[i].x; d[1] = t[i].y; d[2] = t[i].z; d[3] = t[i].w; } }
    LDS_WAIT(); asm volatile("" ::: "memory");
    const int c = lane & 7;
#pragma unroll
    for (int j = 0; j < 4; ++j) { const int n = (lane >> 3) + 8 * j; const LAS float* s = scr + (8 * c) * 33 + n;
        u32x4 o; o.x = pk2(s[0 * 33], s[1 * 33]); o.y = pk2(s[2 * 33], s[3 * 33]); o.z = pk2(s[4 * 33], s[5 * 33]); o.w = pk2(s[6 * 33], s[7 * 33]);
        *(u32x4*)(WT + (size_t)(drow0 + n) * K + k0 + 8 * c) = o; }
    LDS_WAIT(); asm volatile("" ::: "memory");
}
__device__ __forceinline__ unsigned pk4_fp8(float a, float b, float c, float d) { int r = __builtin_amdgcn_cvt_pk_fp8_f32(a, b, 0, false); r = __builtin_amdgcn_cvt_pk_fp8_f32(c, d, r, true); return (unsigned)r; }
__device__ __forceinline__ void conv_item8(const float* W, int K, int N, unsigned char* WT, int k0, int n0, int drow0, float scale, LAS float* scr, int lane) {
    { const int rr = lane >> 3, cq = lane & 7; f32x4 t[8];
#pragma unroll
      for (int i = 0; i < 8; ++i) t[i] = *(const f32x4*)(W + (size_t)(k0 + 8 * i + rr) * N + n0 + 4 * cq);
#pragma unroll
      for (int i = 0; i < 8; ++i) { LAS float* d = scr + (8 * i + rr) * 33 + 4 * cq; d[0] = t[i].x; d[1] = t[i].y; d[2] = t[i].z; d[3] = t[i].w; } }
    LDS_WAIT(); asm volatile("" ::: "memory");
    const int c = lane & 7;
#pragma unroll
    for (int j = 0; j < 4; ++j) { const int n = (lane >> 3) + 8 * j; const LAS float* s = scr + (8 * c) * 33 + n;
        u32x2 o; o.x = pk4_fp8(s[0 * 33] * scale, s[1 * 33] * scale, s[2 * 33] * scale, s[3 * 33] * scale); o.y = pk4_fp8(s[4 * 33] * scale, s[5 * 33] * scale, s[6 * 33] * scale, s[7 * 33] * scale);
        *(u32x2*)(WT + (size_t)(drow0 + n) * K + k0 + 8 * c) = o; }
    LDS_WAIT(); asm volatile("" ::: "memory");
}
constexpr float W13_SCALE = 64.0f, W2_SCALE = 32.0f;
constexpr int CI_IN = 32 * 368, CI_AO = 16 * 64, CI_CO = 8 * 64, CI_SO = 8 * 64, CI_O = 32 * 64, CI_E1 = 16 * 32 * 32, CI_E3 = CI_E1, CI_E2 = 16 * 16 * 64;
constexpr int CI_LAYER = CI_IN + CI_AO + CI_CO + CI_SO + CI_O + CI_E1 + CI_E3 + CI_E2;
constexpr int ADA_ITEMS = 2 * 16 * 48;

__device__ __forceinline__ void ada_item(const Frame& F, int it, LAS float* scr) {
    const int lane = F.lane;
    const int l = it / 768, r = it % 768, kc = r / 48, cg = r % 48;
    const float* c = F.in(I_C); const float* cc = F.in(I_CCTX);
    for (int q = lane; q < 640; q += 64) { const int v = q >> 7, rr = q & 127, k = kc * 128 + rr; const float cv = (v < 4) ? c[v * DM + k] : cc[k]; scr[q] = cv / (1.0f + expf(-cv)); }
    LDS_WAIT(); asm volatile("" ::: "memory");
    f32x4 acc[5];
#pragma unroll
    for (int v = 0; v < 5; ++v) acc[v] = (f32x4){0.f, 0.f, 0.f, 0.f};
    const float* wp = F.in(I_WADA) + (size_t)l * DM * 12288 + (size_t)(kc * 128) * 12288 + cg * 256 + lane * 4;
#pragma unroll 8
    for (int rr = 0; rr < 128; ++rr) { const f32x4 w = *(const f32x4*)(wp + (size_t)rr * 12288);
#pragma unroll
        for (int v = 0; v < 5; ++v) acc[v] += w * scr[v * 128 + rr]; }
#pragma unroll
    for (int v = 0; v < 5; ++v) *(f32x4*)(((float*)(F.ws + WS_ADAP)) + (size_t)((l * 16 + kc) * 5 + v) * 12288 + cg * 256 + lane * 4) = acc[v];
    LDS_WAIT(); asm volatile("" ::: "memory");
}

__device__ __forceinline__ void phase_pa(const Frame& F0) {
    const Frame F = fresh(F0);
    LAS float* scr = (LAS float*)(F.lds + RING_OFF + F.wave * 16384);
    const int lane = F.lane;
    const int total = ADA_ITEMS + 2 * CI_LAYER;
    if (F.gw == 0) {
        for (int l = 0; l < NL; ++l) { float mq = fabsf(F.in(I_GQ)[l * 64 + lane]), mk = fabsf(F.in(I_GK)[l * 64 + lane]), mr = 0.f;
            for (int i = lane; i < NH * 15 * 31; i += 64) mr = fmaxf(mr, fabsf(F.in(I_RPB)[l * NH * 15 * 31 + i]));
            mq = wave_max(mq); mk = wave_max(mk); mr = wave_max(mr);
            if (lane == 0) ((float*)(F.ws + WS_MSH))[l] = 8.1f * mq * mk + mr; }
    }
    for (int it = F.gw; it < total; it += F.ngw) {
        if (it < ADA_ITEMS) { ada_item(F, it, scr); continue; }
        int r = it - ADA_ITEMS; const int l = r / CI_LAYER; r -= l * CI_LAYER;
        if (r < CI_IN) { const int kb = r / 368, nb = r % 368; conv_item(F.in(I_WIN) + (size_t)l * DM * PW, DM, PW, ((bf16_t*)(F.ws + WS_WIN)) + (size_t)l * PW * DM, 64 * kb, 32 * nb, 32 * nb, scr, lane); continue; } r -= CI_IN;
        if (r < CI_AO) { const int kb = r / 64, nb = r % 64; conv_item(F.in(I_WAO) + (size_t)l * AW * DM, AW, DM, ((bf16_t*)(F.ws + WS_WAO)) + (size_t)l * DM * AW, 64 * kb, 32 * nb, 32 * nb, scr, lane); continue; } r -= CI_AO;
        if (r < CI_CO) { const int kb = r / 64, nb = r % 64; conv_item(F.in(I_WCO) + (size_t)l * CWD * DM, CWD, DM, ((bf16_t*)(F.ws + WS_WCO)) + (size_t)l * DM * CWD, 64 * kb, 32 * nb, 32 * nb, scr, lane); continue; } r -= CI_CO;
        if (r < CI_SO) { const int kb = r / 64, nb = r % 64; conv_item(F.in(I_WSO) + (size_t)l * SWD * DM, SWD, DM, ((bf16_t*)(F.ws + WS_WSO)) + (size_t)l * DM * SWD, 64 * kb, 32 * nb, 32 * nb, scr, lane); continue; } r -= CI_SO;
        if (r < CI_O) { const int kb = r / 64, nb = r % 64; conv_item(F.in(I_WO) + (size_t)l * DM * DM, DM, DM, ((bf16_t*)(F.ws + WS_WO)) + (size_t)l * DM * DM, 64 * kb, 32 * nb, 32 * nb, scr, lane); continue; } r -= CI_O;
        if (r < CI_E1 + CI_E3) { const int w3 = r >= CI_E1; if (w3) r -= CI_E1; const int e = r / 1024, q = r % 1024, kb = q / 32, nb = q % 32, n0 = 32 * nb;
            conv_item8(F.in(w3 ? I_WE3 : I_WE1) + (size_t)(l * NE + e) * DM * FF, DM, FF, ((unsigned char*)(F.ws + WS_W13)) + (size_t)(l * NE + e) * 2048 * DM, 64 * kb, n0, (n0 >> 7) * 256 + (n0 & 127) + (w3 ? 128 : 0), W13_SCALE, scr, lane); continue; } r -= CI_E1 + CI_E3;
        { const int e = r / 1024, q = r % 1024, kb = q / 64, nb = q % 64;
            conv_item8(F.in(I_WE2) + (size_t)(l * NE + e) * FF * DM, FF, DM, ((unsigned char*)(F.ws + WS_W2)) + (size_t)(l * NE + e) * DM * FF, 64 * kb, 32 * nb, 32 * nb, W2_SCALE, scr, lane); }
    }
}
__device__ __forceinline__ void phase_pa2(const Frame& F0) {
    const Frame F = fresh(F0);
    const int gt = F.bx * 512 + F.tid, nt = F.G * 512;
    for (int i = gt; i < 2 * 5 * 12288; i += nt) { const int l = i / 61440, r = i % 61440, v = r / 12288, n = r % 12288;
        float s = F.in(I_BADA)[l * 12288 + n];
#pragma unroll
        for (int kc = 0; kc < 16; ++kc) s += ((float*)(F.ws + WS_ADAP))[(size_t)((l * 16 + kc) * 5 + v) * 12288 + n];
        ((float*)(F.ws + WS_MOD))[i] = s; }
    for (int i = gt; i < 2 * 5 * DM; i += nt) { const int l = i / (5 * DM), r = i % (5 * DM), v = r / DM, c = r % DM, n = 4 * DM + c;
        float s = F.in(I_BADA)[l * 12288 + n];
#pragma unroll
        for (int kc = 0; kc < 16; ++kc) s += ((float*)(F.ws + WS_ADAP))[(size_t)((l * 16 + kc) * 5 + v) * 12288 + n];
        ((float*)(F.ws + WS_MA2))[i] = F.in(I_GN2)[l * DM + c] * (s + 1.0f); }
    for (int idx = gt; idx < NL * NH * 15 * 64; idx += nt) {
        const int dd = (idx & 63) - 16, ro = (idx >> 6) % 15, lh = (idx >> 6) / 15;
        ((float*)(F.ws + WS_TAB))[idx] = (dd >= 0 && dd < 31) ? (F.in(I_RPB)[(lh * 15 + ro) * 31 + dd] - ((const float*)(F.ws + WS_MSH))[lh >> 4]) * LOG2E : 0.f; }
    for (int i = gt; i < 1024; i += nt) { const int pos = i >> 4, f = i & 15; const float freq = 1.0f / powf(10000.0f, (float)f * (1.0f / 16.0f)); const float ang = (float)pos * freq;
        ((float*)(F.ws + WS_ROPE))[2 * i] = cosf(ang); ((float*)(F.ws + WS_ROPE))[2 * i + 1] = sinf(ang); }
}

__device__ __forceinline__ const float* xrow_ptr(const Frame& F, int lx, int row) {
    if (lx == 0) return (row < ML) ? F.in(I_X) + (size_t)row * DM : F.in(I_CTX) + (size_t)(row - ML) * DM;
    return F.out + (size_t)row * DM;
}
__device__ __forceinline__ void load_row_f32(const float* p, int lane, f32x4 (&v)[8]) {
#pragma unroll
    for (int j = 0; j < 4; ++j) { v[2 * j] = *(const f32x4*)(p + 8 * lane + 512 * j); v[2 * j + 1] = *(const f32x4*)(p + 8 * lane + 512 * j + 4); }
}
__device__ __forceinline__ void combine_rows2(const Frame& F, int lprev, const int (&row)[2], const bool (&ok)[2], f32x4 (&v)[2][8]) {
    const int lane = F.lane;
    f32x4 a[2][8]; int sl[2]; bool lat[2]; int bb[2];
#pragma unroll
    for (int u = 0; u < 2; ++u) { lat[u] = row[u] < ML; bb[u] = lat[u] ? (row[u] >> 12) : ((row[u] - ML) >> 8);
        if (ok[u]) { if (lprev == 0) load_row_f32(xrow_ptr(F, 0, row[u]), lane, v[u]);
            else { const bf16_t* xb = ((const bf16_t*)(F.ws + WS_X1)) + (size_t)row[u] * DM + 8 * lane;
#pragma unroll
                for (int j = 0; j < 4; ++j) { const u32x4 w = *(const u32x4*)(xb + 512 * j); v[u][2 * j] = (f32x4){bflo(w.x), bfhi(w.x), bflo(w.y), bfhi(w.y)}; v[u][2 * j + 1] = (f32x4){bflo(w.z), bfhi(w.z), bflo(w.w), bfhi(w.w)}; } }
            const bf16_t* dl = ((const bf16_t*)(F.ws + WS_XM)) + (size_t)row[u] * DM + 8 * lane;
#pragma unroll
            for (int j = 0; j < 4; ++j) { const u32x4 w = *(const u32x4*)(dl + 512 * j);
                v[u][2 * j] += (f32x4){bflo(w.x), bfhi(w.x), bflo(w.y), bfhi(w.y)}; v[u][2 * j + 1] += (f32x4){bflo(w.z), bfhi(w.z), bflo(w.w), bfhi(w.w)}; } }
        sl[u] = (ok[u] && lane < 16) ? ((const int*)(F.ws + WS_SLOT))[(size_t)row[u] * 16 + lane] : 0x7fffffff;
#pragma unroll
        for (int j = 0; j < 8; ++j) a[u][j] = (f32x4){0.f, 0.f, 0.f, 0.f}; }
    for (int e = 0; e < 16; ++e) {
#pragma unroll
        for (int u = 0; u < 2; ++u) {
            const int sv = __builtin_amdgcn_readlane(sl[u], e);
            if (sv < (lat[u] ? CAP_L : CAP_C)) {
                const int yr = lat[u] ? ((e * 4 + bb[u]) * 512 + sv) : (32768 + e * 256 + bb[u] * 32 + sv);
                const bf16_t* yp = ((bf16_t*)(F.ws + WS_Y)) + (size_t)yr * DM + 8 * lane;
#pragma unroll
                for (int j = 0; j < 4; ++j) { const u32x4 w = *(const u32x4*)(yp + 512 * j);
                    a[u][2 * j] += (f32x4){bflo(w.x), bfhi(w.x), bflo(w.y), bfhi(w.y)}; a[u][2 * j + 1] += (f32x4){bflo(w.z), bfhi(w.z), bflo(w.w), bfhi(w.w)}; }
            }
        }
    }
#pragma unroll
    for (int u = 0; u < 2; ++u) {
        const float* g2 = ((float*)(F.ws + WS_MOD)) + (size_t)(lprev * 5 + (lat[u] ? bb[u] : 4)) * 12288 + 5 * DM + 8 * lane;
#pragma unroll
        for (int j = 0; j < 4; ++j) { const f32x4 m0 = *(const f32x4*)(g2 + 512 * j), m1 = *(const f32x4*)(g2 + 512 * j + 4); v[u][2 * j] += m0 * a[u][2 * j]; v[u][2 * j + 1] += m1 * a[u][2 * j + 1]; } }
}
__device__ __forceinline__ void phase_norm1(const Frame& F0, int l) {
    const Frame F = fresh(F0);
    const int lane = F.lane;
    for (int r0 = F.gw; r0 < MT; r0 += 2 * F.ngw) {
        const int row[2] = {r0, r0 + F.ngw}; const bool ok[2] = {true, r0 + F.ngw < MT};
        f32x4 v[2][8];
        if (l == 0) {
#pragma unroll
            for (int u = 0; u < 2; ++u) if (ok[u]) { if (row[u] < ML) load_row_f32(F.in(I_X) + (size_t)row[u] * DM, lane, v[u]); else load_row_f32(F.in(I_CTX) + (size_t)(row[u] - ML) * DM, lane, v[u]); }
        } else {
            combine_rows2(F, l - 1, row, ok, v);
#pragma unroll
            for (int u = 0; u < 2; ++u) if (ok[u] && row[u] < ML) {
#pragma unroll
                for (int j = 0; j < 4; ++j) { u32x4 o; o.x = pk2(v[u][2 * j].x, v[u][2 * j].y); o.y = pk2(v[u][2 * j].z, v[u][2 * j].w); o.z = pk2(v[u][2 * j + 1].x, v[u][2 * j + 1].y); o.w = pk2(v[u][2 * j + 1].z, v[u][2 * j + 1].w);
                    *(u32x4*)(((bf16_t*)(F.ws + WS_X1)) + (size_t)row[u] * DM + 8 * lane + 512 * j) = o; } }
        }
#pragma unroll
        for (int u = 0; u < 2; ++u) if (ok[u]) {
            const int bs = row[u] < ML ? (row[u] >> 12) : 4;
            float ss = 0.f;
#pragma unroll
            for (int j = 0; j < 8; ++j) ss += (v[u][j].x * v[u][j].x + v[u][j].y * v[u][j].y) + (v[u][j].z * v[u][j].z + v[u][j].w * v[u][j].w);
            const float rinv = 1.0f / sqrtf(wave_sum(ss) * (1.0f / DM) + EPS);
            const float* g1 = F.in(I_GN1) + l * DM + 8 * lane; const float* md = ((float*)(F.ws + WS_MOD)) + (size_t)(l * 5 + bs) * 12288 + 8 * lane;
#pragma unroll
            for (int j = 0; j < 4; ++j) {
                const f32x4 ga = *(const f32x4*)(g1 + 512 * j), gb = *(const f32x4*)(g1 + 512 * j + 4);
                const f32x4 sha = *(const f32x4*)(md + 512 * j), shb = *(const f32x4*)(md + 512 * j + 4);
                const f32x4 sca = *(const f32x4*)(md + DM + 512 * j), scb = *(const f32x4*)(md + DM + 512 * j + 4);
                const f32x4 ha = (v[u][2 * j] * rinv * ga) * (sca + 1.0f) + sha, hb = (v[u][2 * j + 1] * rinv * gb) * (scb + 1.0f) + shb;
                u32x4 o; o.x = pk2(ha.x, ha.y); o.y = pk2(ha.z, ha.w); o.z = pk2(hb.x, hb.y); o.w = pk2(hb.z, hb.w);
                *(u32x4*)(((bf16_t*)(F.ws + WS_H)) + (size_t)row[u] * DM + 8 * lane + 512 * j) = o; }
        }
    }
}
__device__ __forceinline__ void phase_final(const Frame& F0) {
    const Frame F = fresh(F0);
    const int lane = F.lane;
    for (int r0 = F.gw; r0 < ML; r0 += 2 * F.ngw) {
        const int row[2] = {r0, r0 + F.ngw}; const bool ok[2] = {true, r0 + F.ngw < ML};
        f32x4 v[2][8]; combine_rows2(F, NL - 1, row, ok, v);
#pragma unroll
        for (int u = 0; u < 2; ++u) if (ok[u]) {
#pragma unroll
            for (int j = 0; j < 4; ++j) { *(f32x4*)(F.out + (size_t)row[u] * DM + 8 * lane + 512 * j) = v[u][2 * j]; *(f32x4*)(F.out + (size_t)row[u] * DM + 8 * lane + 512 * j + 4) = v[u][2 * j + 1]; } }
    }
}

struct EpiProj {
    static constexpr bool PERM = true;
    bf16_t* O; const float* bias;
    __device__ __forceinline__ void operator()(const f32x4 (&acc)[2][2][4][2], const pg8::Unit& u, int wr, int wc, int fr, int fq) const {
        const int row0 = u.pm * 256 + wr * 64 + fr, col0 = u.pn * 256 + wc * 32 + 8 * fq; const bool sg = u.pn >= (GATE_COL / 256);
        f32x4 bv[2][2];
#pragma unroll
        for (int bj = 0; bj < 2; ++bj)
#pragma unroll
            for (int n = 0; n < 2; ++n) bv[bj][n] = *(const f32x4*)(bias + col0 + bj * 128 + 4 * n);
#pragma unroll
        for (int ai = 0; ai < 2; ++ai)
#pragma unroll
            for (int m = 0; m < 4; ++m) { bf16_t* rowp = O + (size_t)(row0 + ai * 128 + m * 16) * PW + col0;
#pragma unroll
                for (int bj = 0; bj < 2; ++bj) { f32x4 v0 = acc[ai][bj][m][0] + bv[bj][0], v1 = acc[ai][bj][m][1] + bv[bj][1];
                    if (sg) {
                        u32x2 q; q.x = pk4_gate(sigmoidf_(v0.x), sigmoidf_(v0.y), sigmoidf_(v0.z), sigmoidf_(v0.w)); q.y = pk4_gate(sigmoidf_(v1.x), sigmoidf_(v1.y), sigmoidf_(v1.z), sigmoidf_(v1.w));
                        *(u32x2*)((unsigned char*)rowp + (GATE_COL - col0) + bj * 128) = q; continue; }
                    u32x4 w; w.x = cvt_pk_bf16(v0[0], v0[1]); w.y = cvt_pk_bf16(v0[2], v0[3]); w.z = cvt_pk_bf16(v1[0], v1[1]); w.w = cvt_pk_bf16(v1[2], v1[3]);
                    *(u32x4*)(rowp + bj * 128) = w; } }
    }
};
template <bool ACCUM> struct EpiGate {
    static constexpr bool PERM = true;
    bf16_t* O; const unsigned char* Pg;
    __device__ __forceinline__ void operator()(const f32x4 (&acc)[2][2][4][2], const pg8::Unit& u, int wr, int wc, int fr, int fq) const {
        const int row0 = u.pm * 256 + wr * 64 + fr, col0 = u.pn * 256 + wc * 32 + 8 * fq;
        u32x2 gw[2][4][2];
#pragma unroll
        for (int ai = 0; ai < 2; ++ai)
#pragma unroll
            for (int m = 0; m < 4; ++m)
#pragma unroll
                for (int bj = 0; bj < 2; ++bj) gw[ai][m][bj] = *(const u32x2*)(Pg + (size_t)(row0 + ai * 128 + m * 16) * (PW * 2) + col0 + bj * 128);
#pragma unroll
        for (int ai = 0; ai < 2; ++ai) {
            u32x4 pw[4][2];
            if (ACCUM) {
#pragma unroll
                for (int m = 0; m < 4; ++m)
#pragma unroll
                    for (int bj = 0; bj < 2; ++bj) pw[m][bj] = *(const u32x4*)(O + (size_t)(row0 + ai * 128 + m * 16) * DM + col0 + bj * 128);
            }
#pragma unroll
            for (int m = 0; m < 4; ++m) { const size_t row = (size_t)(row0 + ai * 128 + m * 16);
#pragma unroll
                for (int bj = 0; bj < 2; ++bj) {
                    f32x4 v0 = acc[ai][bj][m][0] * gate4(gw[ai][m][bj].x), v1 = acc[ai][bj][m][1] * gate4(gw[ai][m][bj].y);
                    if (ACCUM) { const u32x4 p = pw[m][bj]; v0 = v0 * (1.0f / 255.0f) + (f32x4){bflo(p.x), bfhi(p.x), bflo(p.y), bfhi(p.y)}; v1 = v1 * (1.0f / 255.0f) + (f32x4){bflo(p.z), bfhi(p.z), bflo(p.w), bfhi(p.w)}; }
                    else { v0 *= (1.0f / 255.0f); v1 *= (1.0f / 255.0f); }
                    u32x4 w; w.x = cvt_pk_bf16(v0[0], v0[1]); w.y = cvt_pk_bf16(v0[2], v0[3]); w.z = cvt_pk_bf16(v1[0], v1[1]); w.w = cvt_pk_bf16(v1[2], v1[3]);
                    *(u32x4*)(O + row * DM + col0 + bj * 128) = w; } }
        }
    }
};
struct EpiDelta {
    static constexpr bool PERM = true;
    bf16_t* O; const float* mod;
    __device__ __forceinline__ void operator()(const f32x4 (&acc)[2][2][4][2], const pg8::Unit& u, int wr, int wc, int fr, int fq) const {
        const int row0 = u.pm * 256 + wr * 64 + fr, col0 = u.pn * 256 + wc * 32 + 8 * fq;
        const int bs = (u.pm < 64) ? (u.pm >> 4) : 4;
        f32x4 mv[2][2];
#pragma unroll
        for (int bj = 0; bj < 2; ++bj)
#pragma unroll
            for (int n = 0; n < 2; ++n) mv[bj][n] = *(const f32x4*)(mod + (size_t)bs * 12288 + col0 + bj * 128 + 4 * n);
#pragma unroll
        for (int ai = 0; ai < 2; ++ai)
#pragma unroll
            for (int m = 0; m < 4; ++m) { bf16_t* rowp = O + (size_t)(row0 + ai * 128 + m * 16) * DM + col0;
#pragma unroll
                for (int bj = 0; bj < 2; ++bj) { const f32x4 v0 = acc[ai][bj][m][0] * mv[bj][0], v1 = acc[ai][bj][m][1] * mv[bj][1];
                    u32x4 w; w.x = cvt_pk_bf16(v0[0], v0[1]); w.y = cvt_pk_bf16(v0[2], v0[3]); w.z = cvt_pk_bf16(v1[0], v1[1]); w.w = cvt_pk_bf16(v1[2], v1[3]);
                    *(u32x4*)(rowp + bj * 128) = w; } }
    }
};
struct EpiSwiglu {
    static constexpr bool PERM = true;
    unsigned char* O;
    __device__ __forceinline__ void operator()(const f32x4 (&acc)[2][2][4][2], const pg8::Unit& u, int wr, int wc, int fr, int fq) const {
        const int row0 = u.pm * 256 + wr * 64 + fr, col0 = u.pn * 128 + wc * 32 + 8 * fq; constexpr float SC = 1.0f / W13_SCALE;
#pragma unroll
        for (int ai = 0; ai < 2; ++ai)
#pragma unroll
            for (int m = 0; m < 4; ++m) { float h[8];
#pragma unroll
                for (int n = 0; n < 2; ++n)
#pragma unroll
                    for (int q = 0; q < 4; ++q) { const float a = acc[ai][0][m][n][q] * SC, b3 = acc[ai][1][m][n][q] * SC; h[4 * n + q] = a * sigmoidf_(a) * b3; }
                u32x2 w; w.x = pk4_fp8(h[0], h[1], h[2], h[3]); w.y = pk4_fp8(h[4], h[5], h[6], h[7]);
                *(u32x2*)(O + (size_t)(row0 + ai * 128 + m * 16) * FF + col0) = w; }
    }
};
struct EpiY {
    static constexpr bool PERM = true;
    bf16_t* O; const float* gate;
    __device__ __forceinline__ void operator()(const f32x4 (&acc)[2][2][4][2], const pg8::Unit& u, int wr, int wc, int fr, int fq) const {
        const int row0 = u.pm * 256 + wr * 64 + fr, col0 = u.pn * 256 + wc * 32 + 8 * fq;
        float gts[2][4];
#pragma unroll
        for (int ai = 0; ai < 2; ++ai)
#pragma unroll
            for (int m = 0; m < 4; ++m) gts[ai][m] = gate[row0 + ai * 128 + m * 16];
#pragma unroll
        for (int ai = 0; ai < 2; ++ai)
#pragma unroll
            for (int m = 0; m < 4; ++m) { const int row = row0 + ai * 128 + m * 16; const float gt = gts[ai][m] * (1.0f / W2_SCALE);
#pragma unroll
                for (int bj = 0; bj < 2; ++bj) { const f32x4 v0 = acc[ai][bj][m][0] * gt, v1 = acc[ai][bj][m][1] * gt;
                    u32x4 w; w.x = cvt_pk_bf16(v0[0], v0[1]); w.y = cvt_pk_bf16(v0[2], v0[3]); w.z = cvt_pk_bf16(v1[0], v1[1]); w.w = cvt_pk_bf16(v1[2], v1[3]);
                    *(u32x4*)(O + (size_t)row * DM + col0 + bj * 128) = w; } }
    }
};

__device__ __forceinline__ void load64bf(const bf16_t* p, float (&x)[64]) {
#pragma unroll
    for (int i = 0; i < 8; ++i) { const u32x4 w = *(const u32x4*)(p + 8 * i);
        x[8 * i + 0] = bflo(w.x); x[8 * i + 1] = bfhi(w.x); x[8 * i + 2] = bflo(w.y); x[8 * i + 3] = bfhi(w.y); x[8 * i + 4] = bflo(w.z); x[8 * i + 5] = bfhi(w.z); x[8 * i + 6] = bflo(w.w); x[8 * i + 7] = bfhi(w.w); }
}
__device__ __forceinline__ void store64bf(bf16_t* p, const float (&x)[64]) {
#pragma unroll
    for (int i = 0; i < 8; ++i) { u32x4 w; w.x = pk2(x[8 * i], x[8 * i + 1]); w.y = pk2(x[8 * i + 2], x[8 * i + 3]); w.z = pk2(x[8 * i + 4], x[8 * i + 5]); w.w = pk2(x[8 * i + 6], x[8 * i + 7]); *(u32x4*)(p + 8 * i) = w; }
}
__device__ __forceinline__ void headnorm(float (&x)[64], const float* g) {
    float ss = 0.f;
#pragma unroll
    for (int i = 0; i < 64; ++i) ss += x[i] * x[i];
    const float rinv = 1.0f / sqrtf(ss * (1.0f / 64.0f) + EPS);
#pragma unroll
    for (int i = 0; i < 64; ++i) x[i] = x[i] * rinv * g[i];
}
__device__ __forceinline__ void rope64(float (&x)[64], const float* rrow, const float* rcol) {
#pragma unroll
    for (int i = 0; i < 16; ++i) { const float c = rrow[2 * i], s = rrow[2 * i + 1]; const float a = x[i], b = x[i + 16]; x[i] = a * c - b * s; x[i + 16] = b * c + a * s; }
#pragma unroll
    for (int i = 0; i < 16; ++i) { const float c = rcol[2 * i], s = rcol[2 * i + 1]; const float a = x[32 + i], b = x[48 + i]; x[32 + i] = a * c - b * s; x[48 + i] = b * c + a * s; }
}
template <bool PLAIN, bool ROT>
__device__ __forceinline__ void prep_head(const u32x4 (&w)[8], const f32x4 g0, const f32x4 g1, bf16_t* plain_dst, bf16_t* rot_dst, const float* rope, int rowpos, int rsub, int c) {
#pragma unroll
    for (int j = 0; j < 8; ++j) {
        float x[8] = {bflo(w[j].x), bfhi(w[j].x), bflo(w[j].y), bfhi(w[j].y), bflo(w[j].z), bfhi(w[j].z), bflo(w[j].w), bfhi(w[j].w)};
        float ss = 0.f;
#pragma unroll
        for (int e = 0; e < 8; ++e) ss += x[e] * x[e];
        ss += __shfl_xor(ss, 1); ss += __shfl_xor(ss, 2); ss += __shfl_xor(ss, 4);
        const float rinv = 1.0f / sqrtf(ss * (1.0f / 64.0f) + EPS);
        x[0] *= rinv * g0.x; x[1] *= rinv * g0.y; x[2] *= rinv * g0.z; x[3] *= rinv * g0.w; x[4] *= rinv * g1.x; x[5] *= rinv * g1.y; x[6] *= rinv * g1.z; x[7] *= rinv * g1.w;
        const size_t o = (size_t)(8 * j) * 64;
        if constexpr (PLAIN) { u32x4 p; p.x = pk2(x[0], x[1]); p.y = pk2(x[2], x[3]); p.z = pk2(x[4], x[5]); p.w = pk2(x[6], x[7]); *(GAS u32x4*)(plain_dst + o) = p; }
        if constexpr (ROT) {
            const int pos = (c < 4) ? rowpos : (8 * j + rsub);
            const float* rp = rope + pos * 32 + 16 * (c & 1);
            const f32x4 t0 = *(const GAS f32x4*)rp, t1 = *(const GAS f32x4*)(rp + 4), t2 = *(const GAS f32x4*)(rp + 8), t3 = *(const GAS f32x4*)(rp + 12);
            const float cs[8] = {t0.x, t0.z, t1.x, t1.z, t2.x, t2.z, t3.x, t3.z}, sn[8] = {t0.y, t0.w, t1.y, t1.w, t2.y, t2.w, t3.y, t3.w};
            const float sg = (c & 2) ? 1.0f : -1.0f;
            float y[8];
#pragma unroll
            for (int e = 0; e < 8; ++e) { const float xp = __shfl_xor(x[e], 2); y[e] = x[e] * cs[e] + sg * xp * sn[e]; }
            u32x4 p; p.x = pk2(y[0], y[1]); p.y = pk2(y[2], y[3]); p.z = pk2(y[4], y[5]); p.w = pk2(y[6], y[7]); *(GAS u32x4*)(rot_dst + o) = p; }
    }
}
__device__ __forceinline__ void phase_prep(const Frame& F0, int l) {
    const Frame Fp = fresh(F0); const Frame& F = Fp;
    const int lane = F.lane, rsub = lane >> 3, c = lane & 7;
    LAS unsigned* scr = (LAS unsigned*)(F.lds + RING_OFF + F.wave * 16384);
    const float* gqp = F.in(I_GQ) + l * 64 + 8 * c; const float* gkp = F.in(I_GK) + l * 64 + 8 * c;
    const f32x4 gq0 = *(const f32x4*)gqp, gq1 = *(const f32x4*)(gqp + 4), gk0 = *(const f32x4*)gkp, gk1 = *(const f32x4*)(gkp + 4);
    const float* rope = (const float*)(F.ws + WS_ROPE);
    for (int it = F.gw; it < (MT / 64) * NH; it += F.ngw) {
        Frame F = Fp; { unsigned long long w_ = (unsigned long long)Fp.ws; asm volatile("" : "+s"(w_)); F.ws = (unsigned char*)w_; }
        const int ch = it >> 4, h = it & 15, r0 = ch * 64; const bool lat = r0 < ML;
        const int b = lat ? (r0 >> 12) : ((r0 - ML) >> 8), t0 = lat ? (r0 & 4095) : ((r0 - ML) & 255);
        const size_t hb = (size_t)(b * NH + h);
        const bool doq = !lat && l == 0;
        const bf16_t* pbase = ((const bf16_t*)(F.ws + WS_P)) + (size_t)(r0 + rsub) * PW + h * 64 + 8 * c;
        u32x4 qw[8], kw[8], vw[8];
#pragma unroll
        for (int j = 0; j < 8; ++j) { const bf16_t* p = pbase + (size_t)(8 * j) * PW; qw[j] = doq ? *(const GAS u32x4*)p : (u32x4){0u, 0u, 0u, 0u}; kw[j] = *(const GAS u32x4*)(p + AW); vw[j] = *(const GAS u32x4*)(p + 2 * AW); }
#pragma unroll
        for (int j = 0; j < 8; ++j) { LAS unsigned* d = scr + (8 * j + rsub) * 33 + 4 * c; d[0] = vw[j].x; d[1] = vw[j].y; d[2] = vw[j].z; d[3] = vw[j].w; }
        if (lat) {
            const size_t tb = (hb * SEQ + t0 + rsub) * 64 + 8 * c;
            prep_head<false, true>(kw, gk0, gk1, nullptr, ((bf16_t*)(F.ws + WS_KR)) + tb, rope, t0 >> 6, rsub, c);
        } else {
            const size_t tb = (hb * CTXL + t0 + rsub) * 64 + 8 * c;
            if (doq) prep_head<true, false>(qw, gq0, gq1, ((bf16_t*)(F.ws + WS_QC)) + tb, nullptr, rope, 0, rsub, c);
            prep_head<true, false>(kw, gk0, gk1, ((bf16_t*)(F.ws + WS_KC)) + tb, nullptr, rope, 0, rsub, c);
        }
        LDS_WAIT(); asm volatile("" ::: "memory");
        const int dsub = lane >> 3, oct = lane & 7, sh = (dsub & 1) * 16;
        const LAS unsigned* sp = scr + (8 * oct) * 33 + (dsub >> 1);
#define PREP_VT(VT0, STEP) do { GAS unsigned char* vt = (VT0); _Pragma("unroll") for (int i = 0; i < 8; ++i) { unsigned o[4]; \
            _Pragma("unroll") for (int q = 0; q < 4; ++q) { const unsigned w0 = sp[(2 * q) * 33 + 4 * i], w1 = sp[(2 * q + 1) * 33 + 4 * i]; o[q] = ((w0 >> sh) & 0xffffu) | ((w1 >> sh) << 16); } \
            *(GAS u32x4*)vt = (u32x4){o[0], o[1], o[2], o[3]}; vt += (STEP); } } while (0)
        if (lat) PREP_VT((GAS unsigned char*)(((bf16_t*)(F.ws + WS_VT)) + (hb * 64 + dsub) * SEQ + t0 + 8 * oct), 8 * SEQ * 2);
        else PREP_VT((GAS unsigned char*)(((bf16_t*)(F.ws + WS_VCT)) + (hb * 64 + dsub) * CTXL + t0 + 8 * oct), 8 * CTXL * 2);
#undef PREP_VT
        LDS_WAIT(); asm volatile("" ::: "memory");
    }
}

__device__ __forceinline__ void phase_glu(const Frame& F0, int l, int nrows) {
    const Frame F = fresh(F0);
    const int gt = F.bx * 512 + F.tid, nt = F.G * 512;
    for (int it = gt; it < nrows * 64; it += 2 * nt) {
        u32x4 aw[2], gw[2]; bool ok[2]; int row[2], c0[2];
#pragma unroll
        for (int u = 0; u < 2; ++u) { const int i2 = it + u * nt; ok[u] = i2 < nrows * 64; row[u] = i2 >> 6; c0[u] = (i2 & 63) * 8;
            if (ok[u]) { aw[u] = *(const GAS u32x4*)(((const bf16_t*)(F.ws + WS_P)) + (size_t)row[u] * PW + 3072 + c0[u]); gw[u] = *(const GAS u32x4*)(((const bf16_t*)(F.ws + WS_P)) + (size_t)row[u] * PW + 3584 + c0[u]); } }
#pragma unroll
        for (int u = 0; u < 2; ++u) if (ok[u]) {
            u32x4 o; o.x = pk2(bflo(aw[u].x) * sigmoidf_(bflo(gw[u].x)), bfhi(aw[u].x) * sigmoidf_(bfhi(gw[u].x))); o.y = pk2(bflo(aw[u].y) * sigmoidf_(bflo(gw[u].y)), bfhi(aw[u].y) * sigmoidf_(bfhi(gw[u].y)));
            o.z = pk2(bflo(aw[u].z) * sigmoidf_(bflo(gw[u].z)), bfhi(aw[u].z) * sigmoidf_(bfhi(gw[u].z))); o.w = pk2(bflo(aw[u].w) * sigmoidf_(bflo(gw[u].w)), bfhi(aw[u].w) * sigmoidf_(bfhi(gw[u].w)));
            *(GAS u32x4*)(((bf16_t*)(F.ws + WS_U)) + (size_t)row[u] * CWD + c0[u]) = o; }
    }
}
__device__ __forceinline__ void phase_conv(const Frame& F0, int l, int nrows) {
    const Frame F = fresh(F0);
    const int lane = F.lane, c0 = 8 * lane;
    LAS float* wl = (LAS float*)(F.lds + RING_OFF);
    { const float* dw = F.in(I_CDW) + (size_t)l * 31 * CWD; float tv[31];
#pragma unroll
      for (int i = 0; i < 31; ++i) tv[i] = ((const GAS float*)dw)[F.tid + 512 * i];
#pragma unroll
      for (int i = 0; i < 31; ++i) wl[512 * i + ((F.tid >> 2) & 1) * 256 + (F.tid >> 3) * 4 + (F.tid & 3)] = tv[i]; }
    __syncthreads();
    const float* dbp = F.in(I_CDB) + l * CWD + c0; const float* lgp = F.in(I_CLG) + l * CWD + c0; const float* lbp = F.in(I_CLB) + l * CWD + c0;
    const f32x4 db0 = *(const f32x4*)dbp, db1 = *(const f32x4*)(dbp + 4), lg0 = *(const f32x4*)lgp, lg1 = *(const f32x4*)(lgp + 4), lb0 = *(const f32x4*)lbp, lb1 = *(const f32x4*)(lbp + 4);
    for (int un = F.gw; un < nrows / 4; un += F.ngw) {
        const int r0 = 4 * un; const bool lat = r0 < ML; const int sbeg = lat ? (r0 & ~4095) : (ML + ((r0 - ML) & ~255)), send = sbeg + (lat ? SEQ : CTXL);
        const bf16_t* ub = ((const bf16_t*)(F.ws + WS_U)) + c0;
        f32x4 acc[4][2];
#pragma unroll
        for (int t = 0; t < 4; ++t) { acc[t][0] = db0; acc[t][1] = db1; }
        f32x4 w[4][2];
#pragma unroll
        for (int i = 0; i < 34; ++i) {
#pragma unroll
            for (int j = 3; j > 0; --j) { w[j][0] = w[j - 1][0]; w[j][1] = w[j - 1][1]; }
            if (i < 31) { w[0][0] = *(const LAS f32x4*)(wl + i * CWD + 4 * lane); w[0][1] = *(const LAS f32x4*)(wl + i * CWD + 256 + 4 * lane); }
            const int r = r0 - 15 + i;
            if (r >= sbeg && r < send) {
                const u32x4 xw = *(const GAS u32x4*)(ub + (size_t)r * CWD);
                const f32x4 x0 = (f32x4){bflo(xw.x), bfhi(xw.x), bflo(xw.y), bfhi(xw.y)}, x1 = (f32x4){bflo(xw.z), bfhi(xw.z), bflo(xw.w), bfhi(xw.w)};
#pragma unroll
                for (int t = 0; t < 4; ++t) { const int k = i - t; if (k >= 0 && k < 31) { acc[t][0] += w[t][0] * x0; acc[t][1] += w[t][1] * x1; } }
            }
            if ((i & 7) == 7) asm volatile("" ::: "memory");
        }
#pragma unroll
        for (int t = 0; t < 4; ++t) {
            float s = (acc[t][0].x + acc[t][0].y) + (acc[t][0].z + acc[t][0].w) + (acc[t][1].x + acc[t][1].y) + (acc[t][1].z + acc[t][1].w);
            const float mean = wave_sum(s) * (1.0f / 512.0f);
            const f32x4 d0 = acc[t][0] - mean, d1 = acc[t][1] - mean;
            float s2 = (d0.x * d0.x + d0.y * d0.y) + (d0.z * d0.z + d0.w * d0.w) + (d1.x * d1.x + d1.y * d1.y) + (d1.z * d1.z + d1.w * d1.w);
            const float rstd = 1.0f / sqrtf(wave_sum(s2) * (1.0f / 512.0f) + EPS);
            const f32x4 y0 = d0 * rstd * lg0 + lb0, y1 = d1 * rstd * lg1 + lb1;
            u32x4 o; o.x = pk2(y0.x * sigmoidf_(y0.x), y0.y * sigmoidf_(y0.y)); o.y = pk2(y0.z * sigmoidf_(y0.z), y0.w * sigmoidf_(y0.w)); o.z = pk2(y1.x * sigmoidf_(y1.x), y1.y * sigmoidf_(y1.y)); o.w = pk2(y1.z * sigmoidf_(y1.z), y1.w * sigmoidf_(y1.w));
            *(GAS u32x4*)(((bf16_t*)(F.ws + WS_CONV)) + (size_t)(r0 + t) * CWD + c0) = o;
        }
    }
    __syncthreads();
}
__device__ __forceinline__ void phase_shortconv(const Frame& F0, int l, int nrows) {
    const Frame F = fresh(F0);
    const int gt = F.bx * 512 + F.tid, nt = F.G * 512;
    const float* sw = F.in(I_SCW) + (size_t)l * 3 * SWD;
    for (int it = gt; it < nrows * 64; it += nt) {
        const int row = it >> 6, c0 = (it & 63) * 8; const bool lat = row < ML; const int sbeg = lat ? (row & ~4095) : (ML + ((row - ML) & ~255)), send = sbeg + (lat ? SEQ : CTXL);
        float acc[8];
#pragma unroll
        for (int q = 0; q < 8; ++q) acc[q] = 0.f;
#pragma unroll
        for (int k = 0; k < 3; ++k) { const int r = row + k - 1;
            if (r >= sbeg && r < send) { const u32x4 cw = *(const u32x4*)(((bf16_t*)(F.ws + WS_P)) + (size_t)r * PW + 4608 + c0), xw = *(const u32x4*)(((bf16_t*)(F.ws + WS_P)) + (size_t)r * PW + 5120 + c0);
                const f32x4 w0 = *(const f32x4*)(sw + k * SWD + c0), w1 = *(const f32x4*)(sw + k * SWD + c0 + 4);
                acc[0] += w0.x * bflo(cw.x) * bflo(xw.x); acc[1] += w0.y * bfhi(cw.x) * bfhi(xw.x); acc[2] += w0.z * bflo(cw.y) * bflo(xw.y); acc[3] += w0.w * bfhi(cw.y) * bfhi(xw.y);
                acc[4] += w1.x * bflo(cw.z) * bflo(xw.z); acc[5] += w1.y * bfhi(cw.z) * bfhi(xw.z); acc[6] += w1.z * bflo(cw.w) * bflo(xw.w); acc[7] += w1.w * bfhi(cw.w) * bfhi(xw.w); } }
        const u32x4 bw = *(const u32x4*)(((bf16_t*)(F.ws + WS_P)) + (size_t)row * PW + 4096 + c0);
        u32x4 o; o.x = pk2(acc[0] * bflo(bw.x), acc[1] * bfhi(bw.x)); o.y = pk2(acc[2] * bflo(bw.y), acc[3] * bfhi(bw.y)); o.z = pk2(acc[4] * bflo(bw.z), acc[5] * bfhi(bw.z)); o.w = pk2(acc[6] * bflo(bw.w), acc[7] * bfhi(bw.w));
        *(u32x4*)(((bf16_t*)(F.ws + WS_SC)) + (size_t)row * SWD + c0) = o;
    }
}

__device__ __forceinline__ void phase_glu_sc(const Frame& F0, int l, int nrows) {
    const Frame F = fresh(F0);
    const int gt = F.bx * 512 + F.tid, nt = F.G * 512;
    const int c0 = (gt & 63) * 8;
    const float* sw = F.in(I_SCW) + (size_t)l * 3 * SWD + c0;
    f32x4 w0[3], w1[3];
#pragma unroll
    for (int k = 0; k < 3; ++k) { w0[k] = *(const f32x4*)(sw + k * SWD); w1[k] = *(const f32x4*)(sw + k * SWD + 4); }
    for (int it = gt; it < nrows * 64; it += nt) {
        const int row = it >> 6; const bool lat = row < ML; const int sbeg = lat ? (row & ~4095) : (ML + ((row - ML) & ~255)), send = sbeg + (lat ? SEQ : CTXL);
        const bf16_t* pr = ((const bf16_t*)(F.ws + WS_P)) + (size_t)row * PW + c0;
        const u32x4 aw = *(const GAS u32x4*)(pr + 3072), gw = *(const GAS u32x4*)(pr + 3584), bw = *(const GAS u32x4*)(pr + 4096);
        u32x4 cw[3], xw[3];
#pragma unroll
        for (int k = 0; k < 3; ++k) { const int r = row + k - 1; const bool ok = r >= sbeg && r < send; const bf16_t* p = pr + (ptrdiff_t)(k - 1) * PW;
            cw[k] = ok ? *(const GAS u32x4*)(p + 4608) : (u32x4){0u, 0u, 0u, 0u}; xw[k] = ok ? *(const GAS u32x4*)(p + 5120) : (u32x4){0u, 0u, 0u, 0u}; }
        { u32x4 o; o.x = pk2(bflo(aw.x) * sigmoidf_(bflo(gw.x)), bfhi(aw.x) * sigmoidf_(bfhi(gw.x))); o.y = pk2(bflo(aw.y) * sigmoidf_(bflo(gw.y)), bfhi(aw.y) * sigmoidf_(bfhi(gw.y)));
          o.z = pk2(bflo(aw.z) * sigmoidf_(bflo(gw.z)), bfhi(aw.z) * sigmoidf_(bfhi(gw.z))); o.w = pk2(bflo(aw.w) * sigmoidf_(bflo(gw.w)), bfhi(aw.w) * sigmoidf_(bfhi(gw.w)));
          *(GAS u32x4*)(((bf16_t*)(F.ws + WS_U)) + (size_t)row * CWD + c0) = o; }
        float acc[8];
#pragma unroll
        for (int q = 0; q < 8; ++q) acc[q] = 0.f;
#pragma unroll
        for (int k = 0; k < 3; ++k) {
            acc[0] += w0[k].x * bflo(cw[k].x) * bflo(xw[k].x); acc[1] += w0[k].y * bfhi(cw[k].x) * bfhi(xw[k].x); acc[2] += w0[k].z * bflo(cw[k].y) * bflo(xw[k].y); acc[3] += w0[k].w * bfhi(cw[k].y) * bfhi(xw[k].y);
            acc[4] += w1[k].x * bflo(cw[k].z) * bflo(xw[k].z); acc[5] += w1[k].y * bfhi(cw[k].z) * bfhi(xw[k].z); acc[6] += w1[k].z * bflo(cw[k].w) * bflo(xw[k].w); acc[7] += w1[k].w * bfhi(cw[k].w) * bfhi(xw[k].w); }
        u32x4 o; o.x = pk2(acc[0] * bflo(bw.x), acc[1] * bfhi(bw.x)); o.y = pk2(acc[2] * bflo(bw.y), acc[3] * bfhi(bw.y)); o.z = pk2(acc[4] * bflo(bw.z), acc[5] * bfhi(bw.z)); o.w = pk2(acc[6] * bflo(bw.w), acc[7] * bfhi(bw.w));
        *(GAS u32x4*)(((bf16_t*)(F.ws + WS_SC)) + (size_t)row * SWD + c0) = o;
    }
}

using pg8::bf16x8;
typedef __bf16 bf16x2_t __attribute__((ext_vector_type(2)));
__device__ __forceinline__ unsigned cvtpk_s(float lo, float hi) { f32x2 v = {lo, hi}; bf16x2_t b = __builtin_convertvector(v, bf16x2_t); return __builtin_bit_cast(unsigned, b); }
struct KF { bf16x8 k[2][2]; };
struct VF { bf16x8 v[4]; };
__device__ __forceinline__ void attn_step(const KF& fk, const VF& fv, const bf16x8 (&q)[2], f32x4 (&o)[4], float& ls, const f32x4 t0, const f32x4 t1) {
    constexpr float C = 0.125f * LOG2E;
    f32x4 s0 = (f32x4){0.f, 0.f, 0.f, 0.f}, s1 = (f32x4){0.f, 0.f, 0.f, 0.f};
    s0 = __builtin_amdgcn_mfma_f32_16x16x32_bf16(fk.k[0][0], q[0], s0, 0, 0, 0); s0 = __builtin_amdgcn_mfma_f32_16x16x32_bf16(fk.k[0][1], q[1], s0, 0, 0, 0);
    s1 = __builtin_amdgcn_mfma_f32_16x16x32_bf16(fk.k[1][0], q[0], s1, 0, 0, 0); s1 = __builtin_amdgcn_mfma_f32_16x16x32_bf16(fk.k[1][1], q[1], s1, 0, 0, 0);
    float p[8];
#pragma unroll
    for (int e = 0; e < 4; ++e) { p[e] = __builtin_amdgcn_exp2f(s0[e] * C + t0[e]); p[4 + e] = __builtin_amdgcn_exp2f(s1[e] * C + t1[e]); }
    ls += ((p[0] + p[1]) + (p[2] + p[3])) + ((p[4] + p[5]) + (p[6] + p[7]));
    const bf16x8 pb = __builtin_bit_cast(bf16x8, (u32x4){cvtpk_s(p[0], p[1]), cvtpk_s(p[2], p[3]), cvtpk_s(p[4], p[5]), cvtpk_s(p[6], p[7])});
#pragma unroll
    for (int dt = 0; dt < 4; ++dt) o[dt] = __builtin_amdgcn_mfma_f32_16x16x32_bf16(fv.v[dt], pb, o[dt], 0, 0, 0);
}
__device__ __forceinline__ float lane_xor(float v, int lane, int m) { return __builtin_bit_cast(float, __builtin_amdgcn_ds_bpermute((lane ^ m) << 2, __builtin_bit_cast(int, v))); }
template <bool ROT>
__device__ __forceinline__ void q_tile_from_w(const u32x4 w0, const u32x4 w1, const f32x4 (&gv)[4], const LAS float* rr, const LAS float* rc, int lane, bf16x8 (&qo)[2]);
template <bool ROT>
__device__ __forceinline__ void q_tile_from_p(const bf16_t* prow, const f32x4 (&gv)[4], const LAS float* rr, const LAS float* rc, int lane, bf16x8 (&qo)[2]) {
    const u32x4 w0 = *(const GAS u32x4*)prow, w1 = *(const GAS u32x4*)(prow + 32);
    q_tile_from_w<ROT>(w0, w1, gv, rr, rc, lane, qo);
}
template <bool ROT>
__device__ __forceinline__ void q_tile_from_w(const u32x4 w0, const u32x4 w1, const f32x4 (&gv)[4], const LAS float* rr, const LAS float* rc, int lane, bf16x8 (&qo)[2]) {
    const int g = lane >> 4;
    float x[16] = {bflo(w0.x), bfhi(w0.x), bflo(w0.y), bfhi(w0.y), bflo(w0.z), bfhi(w0.z), bflo(w0.w), bfhi(w0.w), bflo(w1.x), bfhi(w1.x), bflo(w1.y), bfhi(w1.y), bflo(w1.z), bfhi(w1.z), bflo(w1.w), bfhi(w1.w)};
    float ss = 0.f;
#pragma unroll
    for (int e = 0; e < 16; ++e) ss += x[e] * x[e];
    ss += lane_xor(ss, lane, 16); ss += lane_xor(ss, lane, 32);
    const float rinv = 1.0f / sqrtf(ss * (1.0f / 64.0f) + EPS);
#pragma unroll
    for (int e = 0; e < 16; ++e) x[e] = x[e] * rinv * gv[e >> 2][e & 3];
    if constexpr (ROT) {
        const float sg = (g & 2) ? 1.0f : -1.0f;
#pragma unroll
        for (int hf = 0; hf < 2; ++hf) { const LAS float* tp = hf ? rc : rr;
            const f32x4 t0 = *(const LAS f32x4*)tp, t1 = *(const LAS f32x4*)(tp + 4), t2 = *(const LAS f32x4*)(tp + 8), t3 = *(const LAS f32x4*)(tp + 12);
            const float cs[8] = {t0.x, t0.z, t1.x, t1.z, t2.x, t2.z, t3.x, t3.z}, sn[8] = {t0.y, t0.w, t1.y, t1.w, t2.y, t2.w, t3.y, t3.w};
#pragma unroll
            for (int e = 0; e < 8; ++e) { const float xv = x[8 * hf + e], xp = lane_xor(xv, lane, 32); x[8 * hf + e] = xv * cs[e] + sg * xp * sn[e]; } }
    }
    qo[0] = __builtin_bit_cast(bf16x8, (u32x4){pk2(x[0], x[1]), pk2(x[2], x[3]), pk2(x[4], x[5]), pk2(x[6], x[7])});
    qo[1] = __builtin_bit_cast(bf16x8, (u32x4){pk2(x[8], x[9]), pk2(x[10], x[11]), pk2(x[12], x[13]), pk2(x[14], x[15])});
}
constexpr int ATT_NS = 6, ATT_SLOT = 16384, ATT_TABC = ATT_NS * ATT_SLOT, ATT_ROPE = ATT_TABC + 4096;
__device__ __forceinline__ void glds16(const void* sbase, unsigned voff, unsigned lds_dst) { unsigned keep;
    asm volatile("s_mov_b32 %0, m0\n\ts_mov_b32 m0, %3\n\ts_nop 0\n\tglobal_load_lds_dwordx4 %1, %2\n\ts_mov_b32 m0, %0" : "=&s"(keep) : "v"(voff), "s"(sbase), "s"(lds_dst) : "memory"); }
constexpr int CV_ROWS = 65536;
__device__ __forceinline__ void conv_taps_fill(const Frame& F0, int l) {
    const Frame F = fresh(F0);
    LAS float* wl = (LAS float*)(F.lds + RING_OFF);
    const float* dw = F.in(I_CDW) + (size_t)l * 31 * CWD; float tv[31];
#pragma unroll
    for (int i = 0; i < 31; ++i) tv[i] = ((const GAS float*)dw)[F.tid + 512 * i];
#pragma unroll
    for (int i = 0; i < 31; ++i) wl[512 * i + ((F.tid >> 2) & 1) * 256 + (F.tid >> 3) * 4 + (F.tid & 3)] = tv[i];
}
__device__ __forceinline__ void phase_conv2(const Frame& F0, int l, int nrows, bool prefilled) {
    if (!prefilled) conv_taps_fill(F0, l);
    const Frame F = fresh(F0);
    const int lane = F.lane, wave = F.wave, c0 = 8 * lane;
    LAS float* wl = (LAS float*)(F.lds + RING_OFF);
    const float* dbp = F.in(I_CDB) + l * CWD + c0; const float* lgp = F.in(I_CLG) + l * CWD + c0; const float* lbp = F.in(I_CLB) + l * CWD + c0;
    const f32x4 db0 = *(const f32x4*)dbp, db1 = *(const f32x4*)(dbp + 4), lg0 = *(const f32x4*)lgp, lg1 = *(const f32x4*)(lgp + 4), lb0 = *(const f32x4*)lbp, lb1 = *(const f32x4*)(lbp + 4);
    const unsigned ldsb = (unsigned)(unsigned long long)(F.lds + RING_OFF) + (unsigned)CV_ROWS;
    const LAS unsigned char* rowsL = F.lds + RING_OFF + CV_ROWS;
    __syncthreads();
#define CV_STAGE(ti_) do { const int r0_ = 32 * (ti_); const bool lat_ = r0_ < ML; const int sbeg_ = lat_ ? (r0_ & ~4095) : (ML + ((r0_ - ML) & ~255)), send_ = sbeg_ + (lat_ ? SEQ : CTXL); \
        const bf16_t* ub_ = (const bf16_t*)(F.ws + WS_U); \
        _Pragma("nounroll") for (int j = wave; j < 62; j += 8) { const int r = r0_ - 15 + j; \
            if (r >= sbeg_ && r < send_) glds16(ub_ + (size_t)r * CWD, (unsigned)lane * 16u, ldsb + (unsigned)j * 1024u); \
            else *(LAS u32x4*)(rowsL + j * 1024 + lane * 16) = (u32x4){0u, 0u, 0u, 0u}; } } while (0)
    f32x4 acc[4][2];
    int tcur = -1, tnext = F.bx; const int ntile = nrows / 32;
#pragma nounroll
    for (;;) {
        if (tnext < ntile) CV_STAGE(tnext);
        if (tcur >= 0) {
            const int r0 = 32 * tcur;
#pragma unroll
            for (int t = 0; t < 4; ++t) {
                float s = (acc[t][0].x + acc[t][0].y) + (acc[t][0].z + acc[t][0].w) + (acc[t][1].x + acc[t][1].y) + (acc[t][1].z + acc[t][1].w);
                const float mean = wave_sum(s) * (1.0f / 512.0f);
                const f32x4 d0 = acc[t][0] - mean, d1 = acc[t][1] - mean;
                float s2 = (d0.x * d0.x + d0.y * d0.y) + (d0.z * d0.z + d0.w * d0.w) + (d1.x * d1.x + d1.y * d1.y) + (d1.z * d1.z + d1.w * d1.w);
                const float rstd = 1.0f / sqrtf(wave_sum(s2) * (1.0f / 512.0f) + EPS);
                const f32x4 y0 = d0 * rstd * lg0 + lb0, y1 = d1 * rstd * lg1 + lb1;
                u32x4 o; o.x = pk2(y0.x * sigmoidf_(y0.x), y0.y * sigmoidf_(y0.y)); o.y = pk2(y0.z * sigmoidf_(y0.z), y0.w * sigmoidf_(y0.w)); o.z = pk2(y1.x * sigmoidf_(y1.x), y1.y * sigmoidf_(y1.y)); o.w = pk2(y1.z * sigmoidf_(y1.z), y1.w * sigmoidf_(y1.w));
                *(GAS u32x4*)(((bf16_t*)(F.ws + WS_CONV)) + (size_t)(r0 + 4 * wave + t) * CWD + c0) = o;
            }
        }
        if (tnext >= ntile) break;
        asm volatile("s_waitcnt vmcnt(0)" ::: "memory");
        __syncthreads();
#pragma unroll
        for (int t = 0; t < 4; ++t) { acc[t][0] = db0; acc[t][1] = db1; }
        f32x4 w[4][2];
        const LAS unsigned char* myrows = rowsL + (4 * wave) * 1024 + lane * 16;
#pragma unroll
        for (int i = 0; i < 34; ++i) {
#pragma unroll
            for (int j = 3; j > 0; --j) { w[j][0] = w[j - 1][0]; w[j][1] = w[j - 1][1]; }
            if (i < 31) { w[0][0] = *(const LAS f32x4*)(wl + i * CWD + 4 * lane); w[0][1] = *(const LAS f32x4*)(wl + i * CWD + 256 + 4 * lane); }
            const u32x4 xw = *(const LAS u32x4*)(myrows + i * 1024);
            const f32x4 x0 = (f32x4){bflo(xw.x), bfhi(xw.x), bflo(xw.y), bfhi(xw.y)}, x1 = (f32x4){bflo(xw.z), bfhi(xw.z), bflo(xw.w), bfhi(xw.w)};
#pragma unroll
            for (int t = 0; t < 4; ++t) { const int k = i - t; if (k >= 0 && k < 31) { acc[t][0] += w[t][0] * x0; acc[t][1] += w[t][1] * x1; } }
        }
        __syncthreads();
        tcur = tnext; tnext += F.G;
    }
#undef CV_STAGE
    asm volatile("s_waitcnt vmcnt(0)" ::: "memory");
    __syncthreads();
}
template <bool CTXQ>
__device__ __forceinline__ void attn_block(const Frame& Fu, int l, int b, int h, int rgp, float msh) {
    Frame F = Fu; { unsigned long long w = (unsigned long long)Fu.ws; asm volatile("" : "+s"(w)); F.ws = (unsigned char*)w; }
    int lane_ = F.lane; asm volatile("" : "+v"(lane_));
    const int lane = lane_, fr = lane & 15, g = lane >> 4, wave = F.wave, bh = b * NH + h;
    const int rg = rgp * 2 + (wave >> 2), j = wave & 3, r0 = 4 * rg, c0 = 16 * j, bs = min(max(16 * j - 8, 0), 32);
    const unsigned ldsb = (unsigned)(unsigned long long)(F.lds + RING_OFF);
    const LAS unsigned char* ring = F.lds + RING_OFF;
    const int kmin = CTXQ ? 0 : min(max(8 * rgp - 4, 0), 56), kmax = CTXQ ? -1 : min(max(8 * rgp + 7 - 4, 0), 56) + 7, nloc = kmax - kmin + 1, nrow = nloc + 4;
    constexpr bool active = true; constexpr int NT = CTXQ ? 1 : 4;
    const int tid = wave * 64 + lane, dk = tid >> 3, dc = (tid & 7) ^ ((dk >> 1) & 7), du = (2 * (tid & 7)) ^ (dk & 14);
    const unsigned kdo = (unsigned)(dk * 64 + 8 * dc) * 2u, vdl = (unsigned)(dk * SEQ + 4 * du) * 2u, vdc = (unsigned)(dk * CTXL + 4 * du) * 2u;
    const bf16_t* kloc = ((const bf16_t*)(F.ws + WS_KR)) + (size_t)bh * SEQ * 64; const bf16_t* vloc = ((const bf16_t*)(F.ws + WS_VT)) + (size_t)bh * 64 * SEQ;
    const bf16_t* kctx = ((const bf16_t*)(F.ws + WS_KC)) + (size_t)bh * CTXL * 64; const bf16_t* vctx = ((const bf16_t*)(F.ws + WS_VCT)) + (size_t)bh * 64 * CTXL;
#define ATT_ISSUE(s_) do { const int s2_ = min((s_), nrow - 1); const unsigned dst_ = ldsb + (unsigned)(((s_) % ATT_NS) * ATT_SLOT + wave * 1024); \
        if (s2_ < nloc) { glds16(kloc + (size_t)(kmin + s2_) * 4096, kdo, dst_); glds16(vloc + (kmin + s2_) * 64, vdl, dst_ + 8192u); } \
        else { glds16(kctx + (size_t)(s2_ - nloc) * 4096, kdo, dst_); glds16(vctx + (s2_ - nloc) * 64, vdc, dst_ + 8192u); } } while (0)
#define ATT_FRAGS(slot_, koffA, koffB, voffA, voffB, xr) do { const LAS unsigned char* sl_ = ring + (slot_) * ATT_SLOT; \
        kf.k[0][0] = *(const LAS bf16x8*)(sl_ + (koffA)); kf.k[0][1] = *(const LAS bf16x8*)(sl_ + (koffB)); kf.k[1][0] = *(const LAS bf16x8*)(sl_ + (koffA) + 2048); kf.k[1][1] = *(const LAS bf16x8*)(sl_ + (koffB) + 2048); \
        _Pragma("unroll") for (int dt = 0; dt < 4; ++dt) { const u32x2 lo_ = *(const LAS u32x2*)(sl_ + (((voffA)) ^ (xr)) + dt * 2048), hi_ = *(const LAS u32x2*)(sl_ + (((voffB)) ^ (xr)) + dt * 2048); \
            vf.v[dt] = __builtin_bit_cast(bf16x8, (u32x4){lo_.x, lo_.y, hi_.x, hi_.y}); } } while (0)
#define ATT_ROWSYNC(s_) do { asm volatile("s_waitcnt vmcnt(%0)" :: "n"(2 * (ATT_NS - 2)) : "memory");     \
        asm volatile("s_barrier" ::: "memory");                                                                  \
        ATT_ISSUE((s_) + ATT_NS - 1); } while (0)
    bf16x8 q[4][2];
    const bf16_t* qraw = ((const bf16_t*)(F.ws + WS_P)) + (size_t)(b * SEQ + r0 * 64 + c0) * PW + h * 64;
    const unsigned qlo = (unsigned)(fr * PW + 8 * g);
    if constexpr (CTXQ) {
        const bf16_t* qc = ((const bf16_t*)(F.ws + WS_QC)) + ((size_t)bh * CTXL + 128 * rgp + 16 * wave + fr) * 64 + 8 * g;
#pragma unroll
        for (int ks = 0; ks < 2; ++ks) q[0][ks] = *(const GAS bf16x8*)(qc + 32 * ks);
    } else {
        f32x4 gv[4]; { const float* gq = F.in(I_GQ) + l * 64 + 8 * g; gv[0] = *(const f32x4*)gq; gv[1] = *(const f32x4*)(gq + 4); gv[2] = *(const f32x4*)(gq + 32); gv[3] = *(const f32x4*)(gq + 36); }
        const LAS float* ropet = (const LAS float*)(F.lds + RING_OFF + ATT_ROPE) + 16 * (g & 1);
        u32x4 qw[4][2];
#pragma unroll
        for (int i = 0; i < 4; ++i) { qw[i][0] = *(const GAS u32x4*)(qraw + (size_t)i * 64 * PW + qlo); qw[i][1] = *(const GAS u32x4*)(qraw + (size_t)i * 64 * PW + qlo + 32); }
#pragma unroll
        for (int i = 0; i < 4; ++i) { q_tile_from_w<true>(qw[i][0], qw[i][1], gv, ropet + (r0 + i) * 32, ropet + (c0 + fr) * 32, lane, q[i]); asm volatile("" : "+v"(q[i][0]), "+v"(q[i][1]) :: "memory"); }
    }
    f32x4 o[4][4]; float ls[4];
#pragma unroll
    for (int i = 0; i < 4; ++i) { ls[i] = 0.f;
#pragma unroll
        for (int dt = 0; dt < 4; ++dt) o[i][dt] = (f32x4){0.f, 0.f, 0.f, 0.f}; }
    int rsv[4];
#pragma unroll
    for (int i = 0; i < 4; ++i) rsv[i] = min(max(r0 + i - 4, 0), 56);
    asm volatile("s_waitcnt vmcnt(0)" ::: "memory");
#pragma unroll
    for (int s = 0; s < ATT_NS - 1; ++s) ATT_ISSUE(s);
    KF kf; VF vf;
    if constexpr (!CTXQ) {
        const int swz = ((fr >> 1) + ((bs >> 1) & 7)) & 7;
        const int kA = bs * 128 + fr * 128 + ((g ^ (swz & 3)) + 4 * (swz >> 2)) * 16, kB = bs * 128 + fr * 128 + ((g ^ (swz & 3)) + 4 * (1 ^ (swz >> 2))) * 16;
        const int vm = fr & 14, u0 = (bs >> 2) + g;
        const int vA = 8192 + fr * 128 + (u0 ^ vm) * 8, vB = 8192 + fr * 128 + ((u0 + 4) ^ vm) * 8;
        const int cq = c0 + fr, csq = min(max(cq - 8, 0), 48);
        f32x4 mb0, mb1;
#pragma unroll
        for (int e = 0; e < 4; ++e) { const int ka_ = bs + 4 * g + e, kb_ = ka_ + 16; mb0[e] = (ka_ >= csq && ka_ < csq + 16) ? 0.f : -__builtin_inff(); mb1[e] = (kb_ >= csq && kb_ < csq + 16) ? 0.f : -__builtin_inff(); }
        const LAS float* tl = (const LAS float*)(F.lds + RING_OFF + ATT_TABC) + 16 + (bs + 4 * g - cq + 15);
#pragma nounroll
        for (int s = 0; s < nloc; ++s) {
            ATT_ROWSYNC(s);
            const int kr = kmin + s;
            if (kr >= rsv[0] && kr <= rsv[3] + 7) {
                ATT_FRAGS(s % ATT_NS, kA, kB, vA, vB, 0);
#pragma unroll
                for (int i = 0; i < 4; ++i) if (kr >= rsv[i] && kr <= rsv[i] + 7) {
                    const LAS float* tr = tl + (kr - (r0 + i) + 7) * 64;
                    const f32x4 t0 = (f32x4){tr[0], tr[1], tr[2], tr[3]} + mb0, t1 = (f32x4){tr[16], tr[17], tr[18], tr[19]} + mb1;
                    attn_step(kf, vf, q[i], o[i], ls[i], t0, t1); __builtin_amdgcn_sched_barrier(0); }
            }
        }
    }
    {
        if constexpr (!CTXQ) { f32x4 gv[4]; const float* gq = F.in(I_GQ) + l * 64 + 8 * g; gv[0] = *(const f32x4*)gq; gv[1] = *(const f32x4*)(gq + 4); gv[2] = *(const f32x4*)(gq + 32); gv[3] = *(const f32x4*)(gq + 36);
          const LAS float* ropet = (const LAS float*)(F.lds + RING_OFF + ATT_ROPE);
          u32x4 qw[4][2];
#pragma unroll
          for (int i = 0; i < 4; ++i) { qw[i][0] = *(const GAS u32x4*)(qraw + (size_t)i * 64 * PW + qlo); qw[i][1] = *(const GAS u32x4*)(qraw + (size_t)i * 64 * PW + qlo + 32); }
#pragma unroll
          for (int i = 0; i < 4; ++i) { q_tile_from_w<false>(qw[i][0], qw[i][1], gv, ropet, ropet, lane, q[i]); asm volatile("" : "+v"(q[i][0]), "+v"(q[i][1]) :: "memory"); } }
        asm volatile("s_waitcnt vmcnt(0)" ::: "memory");
        const int swz = (fr >> 1) & 7;
        const int kA = fr * 128 + ((g ^ (swz & 3)) + 4 * (swz >> 2)) * 16, kB = fr * 128 + ((g ^ (swz & 3)) + 4 * (1 ^ (swz >> 2))) * 16;
        const int vm = fr & 14;
        const int vA = 8192 + fr * 128 + (g ^ vm) * 8, vB = 8192 + fr * 128 + ((g + 4) ^ vm) * 8;
        const f32x4 tm = (f32x4){msh, msh, msh, msh};
#pragma nounroll
        for (int s = nloc; s < nrow; ++s) {
            ATT_ROWSYNC(s);
            if (active)
#pragma unroll
            for (int hf = 0; hf < 2; ++hf) {
                ATT_FRAGS(s % ATT_NS, kA + hf * 4096, kB + hf * 4096, vA, vB, hf * 64);
#pragma unroll
                for (int i = 0; i < NT; ++i) { attn_step(kf, vf, q[i], o[i], ls[i], tm, tm); __builtin_amdgcn_sched_barrier(0); }
            }
        }
    }
    asm volatile("s_waitcnt vmcnt(0)" ::: "memory");
    asm volatile("s_barrier" ::: "memory");
#undef ATT_ISSUE
#undef ATT_FRAGS
#undef ATT_ROWSYNC
#pragma unroll
    for (int i = 0; i < NT; ++i) {
        float lt = ls[i]; lt += lane_xor(lt, lane, 16); lt += lane_xor(lt, lane, 32);
        const float inv = 1.0f / lt;
        const int orow = CTXQ ? (ML + b * CTXL + 128 * rgp + 16 * wave + fr) : (b * SEQ + (r0 + i) * 64 + c0 + fr);
        bf16_t* op = ((bf16_t*)(F.ws + WS_ATT)) + (size_t)orow * AW + h * 64 + 4 * g;
        if (active) {
#pragma unroll
            for (int dt = 0; dt < 4; ++dt) { const f32x4 v = o[i][dt] * inv; u32x2 w; w.x = cvtpk_s(v.x, v.y); w.y = cvtpk_s(v.z, v.w); *(GAS u32x2*)(op + 16 * dt) = w; } }
    }
}
__device__ __forceinline__ void phase_attn(const Frame& F0, int l) {
    const Frame F = fresh(F0);
    LAS float* tabc = (LAS float*)(F.lds + RING_OFF + ATT_TABC);
    const float msh = -((const float*)(F.ws + WS_MSH))[l] * LOG2E;
    int curh = -1;
    { int t_ = F.tid; for (int i = t_; i < 2048; i += 512) ((LAS float*)(F.lds + RING_OFF + ATT_ROPE))[i] = ((const GAS float*)(F.ws + WS_ROPE))[i]; }
    for (int u = F.bx; u < 512; u += F.G) {
        const int h = u & 15, rest = u >> 4, b = rest >> 3, rgp = rest & 7;
        if (h != curh) { __syncthreads(); int t_ = F.tid; unsigned long long w_ = (unsigned long long)F.ws; asm volatile("" : "+v"(t_), "+s"(w_));
            for (int i = t_; i < 960; i += 512) ((LAS float*)(F.lds + RING_OFF + ATT_TABC))[i] = ((const GAS float*)((unsigned char*)w_ + WS_TAB))[(size_t)(l * NH + h) * 960 + i]; __syncthreads(); curh = h; }
        attn_block<false>(F, l, b, h, rgp, msh);
    }
    __syncthreads();
    if (l == 0) for (int u = F.bx; u < NB * NH * 2; u += F.G) attn_block<true>(F, l, u >> 5, (u >> 1) & 15, u & 1, msh);
    __syncthreads();
}

__device__ __forceinline__ void router_fill(const Frame& F0, int l) {
    const Frame F = fresh(F0);
    const int tid = F.tid;
    LAS float* wt = (LAS float*)(F.lds + RING_OFF);
    const float* wr = F.in(I_WR) + (size_t)l * DM * NE;
#pragma unroll 1
    for (int i0 = 0; i0 < DM * NE; i0 += 512 * 16) { float tv[16];
#pragma unroll
        for (int j = 0; j < 16; ++j) tv[j] = ((const GAS float*)wr)[i0 + 512 * j + tid];
#pragma unroll
        for (int j = 0; j < 16; ++j) { const int i = i0 + 512 * j + tid; wt[(i & 15) * DM + ((i >> 4) ^ ((i & 15) << 2))] = tv[j]; } }
}
__device__ __forceinline__ void phase_norm2(const Frame& F0, int l, int nrows, bool prefilled) {
    if (!prefilled) router_fill(F0, l);
    const Frame F = fresh(F0);
    const int tid = F.tid, lane = F.lane;
    LAS float* wt = (LAS float*)(F.lds + RING_OFF);
    __syncthreads();
    const int myexp = ((lane >> 5) & 1) * 8 + ((lane >> 4) & 1) * 4 + ((lane >> 3) & 1) * 2 + ((lane >> 2) & 1);
    for (int r0 = F.gw; r0 < nrows; r0 += 2 * F.ngw) {
        const int row[2] = {r0, min(r0 + F.ngw, nrows - 1)}; const bool ok1 = r0 + F.ngw < nrows;
        f32x4 v[2][8]; float rinv[2];
#pragma unroll
        for (int u = 0; u < 2; ++u) { const float* xp = xrow_ptr(F, 0, row[u]) + 4 * lane; const bf16_t* xb = ((const bf16_t*)(F.ws + WS_X1)) + (size_t)row[u] * DM + 4 * lane; const bf16_t* dl = ((const bf16_t*)(F.ws + WS_XM)) + (size_t)row[u] * DM + 4 * lane; float ss = 0.f;
#pragma unroll
            for (int k = 0; k < 8; ++k) { const u32x2 dw = *(const u32x2*)(dl + 256 * k); f32x4 xv; if (l == 0) xv = *(const f32x4*)(xp + 256 * k); else { const u32x2 xw = *(const u32x2*)(xb + 256 * k); xv = (f32x4){bflo(xw.x), bfhi(xw.x), bflo(xw.y), bfhi(xw.y)}; }
                v[u][k] = xv + (f32x4){bflo(dw.x), bfhi(dw.x), bflo(dw.y), bfhi(dw.y)}; ss += (v[u][k].x * v[u][k].x + v[u][k].y * v[u][k].y) + (v[u][k].z * v[u][k].z + v[u][k].w * v[u][k].w); }
            rinv[u] = ss; }
        rinv[0] = 1.0f / sqrtf(wave_sum(rinv[0]) * (1.0f / DM) + EPS); rinv[1] = 1.0f / sqrtf(wave_sum(rinv[1]) * (1.0f / DM) + EPS);
        const float* g2 = F.in(I_GN2) + l * DM + 4 * lane;
#pragma unroll
        for (int u = 0; u < 2; ++u) { const int bs = row[u] < ML ? (row[u] >> 12) : 4; const float* md = ((float*)(F.ws + WS_MOD)) + (size_t)(l * 5 + bs) * 12288 + 4 * lane;
#pragma unroll
            for (int k = 0; k < 8; ++k) { const f32x4 g = *(const f32x4*)(g2 + 256 * k), sh = *(const f32x4*)(md + 3 * DM + 256 * k), scl = *(const f32x4*)(md + 4 * DM + 256 * k);
                v[u][k] = (v[u][k] * rinv[u] * g) * (scl + 1.0f) + sh;
                if (u == 0 || ok1) *(unsigned*)(((unsigned char*)(F.ws + WS_H8)) + (size_t)row[u] * DM + 4 * lane + 256 * k) = pk4_fp8(v[u][k].x, v[u][k].y, v[u][k].z, v[u][k].w); } }
        float s[2][16];
#pragma unroll
        for (int e = 0; e < 16; ++e) { f32x4 a0 = {0.f, 0.f, 0.f, 0.f}, a1 = {0.f, 0.f, 0.f, 0.f};
#pragma unroll
            for (int k = 0; k < 8; ++k) { const f32x4 w = *(const LAS f32x4*)(wt + e * DM + 4 * (lane ^ e) + 256 * k); a0 += v[0][k] * w; a1 += v[1][k] * w; }
            float s0 = (a0.x + a0.y) + (a0.z + a0.w), s1 = (a1.x + a1.y) + (a1.z + a1.w);
            asm volatile("" : "+v"(s0), "+v"(s1) :: "memory");
            s[0][e] = s0; s[1][e] = s1; }
#pragma unroll
        for (int u = 0; u < 2; ++u) {
#pragma unroll
            for (int st = 0; st < 4; ++st) { const int d = 32 >> st, n = 8 >> st; const bool hi = (lane & d) != 0;
#pragma unroll
                for (int i = 0; i < 8; ++i) if (i < n) { const float a = s[u][i], b = s[u][i + n]; const float send = hi ? a : b, keep = hi ? b : a; s[u][i] = keep + __shfl_xor(send, d); } }
            float lg = s[u][0]; lg += __shfl_xor(lg, 2); lg += __shfl_xor(lg, 1);
            float mx = lg;
#pragma unroll
            for (int d = 4; d < 64; d <<= 1) mx = fmaxf(mx, __shfl_xor(mx, d));
            const float p = expf(lg - mx); float sum = p;
#pragma unroll
            for (int d = 4; d < 64; d <<= 1) sum += __shfl_xor(sum, d);
            const float aff = p / sum;
            if ((lane & 3) == 0 && (u == 0 || ok1)) { const int r = row[u];
                if (r < ML) ((float*)(F.ws + WS_AFFT))[((size_t)(r >> 12) * NE + myexp) * SEQ + (r & 4095)] = aff;
                else ((float*)(F.ws + WS_AFFT))[(size_t)NB * NE * SEQ + ((size_t)((r - ML) >> 8) * NE + myexp) * CTXL + ((r - ML) & 255)] = aff; }
        }
    }
    __syncthreads();
}

__device__ __forceinline__ void phase_norm2p(const Frame& F0, int l, int nrows, bool prefilled) {
    if (!prefilled) router_fill(F0, l);
    const Frame F = fresh(F0);
    const int lane = F.lane;
    LAS float* wt = (LAS float*)(F.lds + RING_OFF);
    __syncthreads();
    const int myexp = ((lane >> 5) & 1) * 8 + ((lane >> 4) & 1) * 4 + ((lane >> 3) & 1) * 2 + ((lane >> 2) & 1);
    f32x4 xr[8]; u32x2 xbw[8], dr[8];
#define N2_LOAD(row_) do { const int rr_ = (row_); const bf16_t* dl_ = ((const bf16_t*)(F.ws + WS_XM)) + (size_t)rr_ * DM + 4 * lane; \
        if (l == 0) { const float* xp_ = xrow_ptr(F, 0, rr_) + 4 * lane; _Pragma("unroll") for (int k = 0; k < 8; ++k) xr[k] = *(const f32x4*)(xp_ + 256 * k); } \
        else { const bf16_t* xb_ = ((const bf16_t*)(F.ws + WS_X1)) + (size_t)rr_ * DM + 4 * lane; _Pragma("unroll") for (int k = 0; k < 8; ++k) xbw[k] = *(const u32x2*)(xb_ + 256 * k); } \
        _Pragma("unroll") for (int k = 0; k < 8; ++k) dr[k] = *(const u32x2*)(dl_ + 256 * k); } while (0)
    if (F.gw < nrows) N2_LOAD(F.gw);
#pragma nounroll
    for (int r = F.gw; r < nrows; r += F.ngw) {
        f32x4 v[8]; float ss = 0.f;
#pragma unroll
        for (int k = 0; k < 8; ++k) { const f32x4 xv = (l == 0) ? xr[k] : (f32x4){bflo(xbw[k].x), bfhi(xbw[k].x), bflo(xbw[k].y), bfhi(xbw[k].y)};
            v[k] = xv + (f32x4){bflo(dr[k].x), bfhi(dr[k].x), bflo(dr[k].y), bfhi(dr[k].y)}; ss += (v[k].x * v[k].x + v[k].y * v[k].y) + (v[k].z * v[k].z + v[k].w * v[k].w); }
        const int bs = r < ML ? (r >> 12) : 4;
        const float* ma = ((const float*)(F.ws + WS_MA2)) + (size_t)(l * 5 + bs) * DM + 4 * lane; const float* mb = ((const float*)(F.ws + WS_MOD)) + (size_t)(l * 5 + bs) * 12288 + 3 * DM + 4 * lane;
        f32x4 A[8], B[8];
#pragma unroll
        for (int k = 0; k < 8; ++k) { A[k] = *(const f32x4*)(ma + 256 * k); B[k] = *(const f32x4*)(mb + 256 * k); }
        asm volatile("" ::: "memory");
        if (r + F.ngw < nrows) N2_LOAD(r + F.ngw);
        asm volatile("" ::: "memory");
        const float rinv = 1.0f / sqrtf(wave_sum(ss) * (1.0f / DM) + EPS);
#pragma unroll
        for (int k = 0; k < 8; ++k) { v[k] = (v[k] * rinv) * A[k] + B[k];
            *(unsigned*)(((unsigned char*)(F.ws + WS_H8)) + (size_t)r * DM + 4 * lane + 256 * k) = pk4_fp8(v[k].x, v[k].y, v[k].z, v[k].w); }
        float s[16];
#pragma unroll
        for (int e = 0; e < 16; ++e) { f32x4 a0 = {0.f, 0.f, 0.f, 0.f};
#pragma unroll
            for (int k = 0; k < 8; ++k) { const f32x4 w = *(const LAS f32x4*)(wt + e * DM + 4 * (lane ^ e) + 256 * k); a0 += v[k] * w; }
            float s0 = (a0.x + a0.y) + (a0.z + a0.w);
            asm volatile("" : "+v"(s0));
            s[e] = s0; }
#pragma unroll
        for (int st = 0; st < 4; ++st) { const int d = 32 >> st, n = 8 >> st; const bool hi = (lane & d) != 0;
#pragma unroll
            for (int i = 0; i < 8; ++i) if (i < n) { const float a = s[i], b = s[i + n]; const float send = hi ? a : b, keep = hi ? b : a; s[i] = keep + __shfl_xor(send, d); } }
        float lg = s[0]; lg += __shfl_xor(lg, 2); lg += __shfl_xor(lg, 1);
        float mx = lg;
#pragma unroll
        for (int d = 4; d < 64; d <<= 1) mx = fmaxf(mx, __shfl_xor(mx, d));
        const float p = expf(lg - mx); float sum = p;
#pragma unroll
        for (int d = 4; d < 64; d <<= 1) sum += __shfl_xor(sum, d);
        const float aff = p / sum;
        if ((lane & 3) == 0) {
            if (r < ML) ((float*)(F.ws + WS_AFFT))[((size_t)(r >> 12) * NE + myexp) * SEQ + (r & 4095)] = aff;
            else ((float*)(F.ws + WS_AFFT))[(size_t)NB * NE * SEQ + ((size_t)((r - ML) >> 8) * NE + myexp) * CTXL + ((r - ML) & 255)] = aff; }
    }
#undef N2_LOAD
    __syncthreads();
}
__device__ __forceinline__ int block_count8(LAS int* slots, int par, int wave, int lane, int wc) {
    if (lane == 0) slots[par * 8 + wave] = wc;
    __syncthreads();
    typedef int i32x4 __attribute__((ext_vector_type(4)));
    const i32x4 a = *(const LAS i32x4*)(slots + par * 8), b = *(const LAS i32x4*)(slots + par * 8 + 4);
    return (a.x + a.y) + (a.z + a.w) + (b.x + b.y) + (b.z + b.w);
}
__device__ __forceinline__ void block_count8x3(LAS int* slots, int par, int wave, int lane, int w1, int w2, int w3, int& t1, int& t2, int& t3) {
    if (lane == 0) { slots[par * 24 + wave] = w1; slots[par * 24 + 8 + wave] = w2; slots[par * 24 + 16 + wave] = w3; }
    __syncthreads();
    typedef int i32x4 __attribute__((ext_vector_type(4)));
    const LAS i32x4* p = (const LAS i32x4*)(slots + par * 24);
    const i32x4 a = p[0], b = p[1], c = p[2], d = p[3], e = p[4], f = p[5];
    t1 = (a.x + a.y) + (a.z + a.w) + (b.x + b.y) + (b.z + b.w); t2 = (c.x + c.y) + (c.z + c.w) + (d.x + d.y) + (d.z + d.w); t3 = (e.x + e.y) + (e.z + e.w) + (f.x + f.y) + (f.z + f.w);
}
__device__ __forceinline__ int block_excl_scan(LAS int* slots, int wave, int lane, int c, int& total) {
    int incl = c;
#pragma unroll
    for (int o = 1; o < 64; o <<= 1) { const int t = __shfl_up(incl, o); if (lane >= o) incl += t; }
    __syncthreads();
    if (lane == 63) slots[wave] = incl;
    __syncthreads();
    int base = 0, tot = 0;
#pragma unroll
    for (int w = 0; w < 8; ++w) { const int x = slots[w]; tot += x; if (w < wave) base += x; }
    total = tot; return base + incl - c;
}
template <int NV>
__device__ __forceinline__ void rank_group(const Frame& F, const float* src, int ntok, int cap, int* slot_out  , int rho0) {
    const int tid = F.tid, lane = F.lane, wave = F.wave;
    LAS int* cs = (LAS int*)(F.lds + RING_OFF);
    LAS int* cs3 = cs + 32;
    const bool act = NV * tid < ntok;
    float val[NV]; unsigned key[NV];
    if constexpr (NV == 8) { const f32x4 a = *(const f32x4*)(src + 8 * tid), b = *(const f32x4*)(src + 8 * tid + 4); val[0] = a.x; val[1] = a.y; val[2] = a.z; val[3] = a.w; val[4] = b.x; val[5] = b.y; val[6] = b.z; val[7] = b.w; }
    else { val[0] = act ? src[tid] : 0.f; }
#pragma unroll
    for (int i = 0; i < NV; ++i) key[i] = act ? __builtin_bit_cast(unsigned, val[i]) : 0u;
    unsigned prefix = 0u; int par = 0;
    { const unsigned cand = 1u << 30; int wc = 0;
#pragma unroll
      for (int i = 0; i < NV; ++i) wc += (int)__builtin_popcountll(__ballot(key[i] >= cand));
      if (block_count8(cs, par, wave, lane, wc) >= cap) prefix = cand;
      par ^= 1; }
    for (int bit = 28; bit >= 0; bit -= 2) {
        const unsigned c1 = prefix | (1u << bit), c2 = prefix | (2u << bit), c3 = prefix | (3u << bit); int w1 = 0, w2 = 0, w3 = 0;
#pragma unroll
        for (int i = 0; i < NV; ++i) { w1 += (int)__builtin_popcountll(__ballot(key[i] >= c1)); w2 += (int)__builtin_popcountll(__ballot(key[i] >= c2)); w3 += (int)__builtin_popcountll(__ballot(key[i] >= c3)); }
        int t1, t2, t3; block_count8x3(cs3, par, wave, lane, w1, w2, w3, t1, t2, t3);
        prefix = (t3 >= cap) ? c3 : (t2 >= cap) ? c2 : (t1 >= cap) ? c1 : prefix;
        par ^= 1;
    }
    const unsigned T = prefix;
    int wc = 0;
#pragma unroll
    for (int i = 0; i < NV; ++i) wc += (int)__builtin_popcountll(__ballot(key[i] > T));
    const int ngt = block_count8(cs, par, wave, lane, wc); par ^= 1;
    const int R = cap - ngt;
    int ceq = 0;
#pragma unroll
    for (int i = 0; i < NV; ++i) ceq += (key[i] == T) ? 1 : 0;
    int tot; int eqr = block_excl_scan(cs + 16, wave, lane, ceq, tot);
    bool sel[NV]; int csel = 0;
#pragma unroll
    for (int i = 0; i < NV; ++i) { const bool eq = key[i] == T; sel[i] = (key[i] > T) || (eq && eqr < R); eqr += eq ? 1 : 0; csel += sel[i] ? 1 : 0; }
    int sl = block_excl_scan(cs + 16, wave, lane, csel, tot);
    if (act) {
#pragma unroll
        for (int i = 0; i < NV; ++i) { const int t = NV * tid + i; slot_out[(size_t)t * 16] = sel[i] ? sl : 0x7fffffff;
            if (sel[i]) { ((int*)(F.ws + WS_IDX))[rho0 + sl] = t; ((float*)(F.ws + WS_GATE))[rho0 + sl] = val[i]; ++sl; } }
    }
    __syncthreads();
}
__device__ __forceinline__ void phase_rank(const Frame& F0, int l) {
    const Frame F = fresh(F0);
    const int nunits = 64 + ((l == 0) ? 64 : 0);
    for (int un = F.bx; un < nunits; un += F.G) {
        if (un < 64) { const int b = un >> 4, e = un & 15;
            rank_group<8>(F, ((float*)(F.ws + WS_AFFT)) + (size_t)un * SEQ, SEQ, CAP_L, ((int*)(F.ws + WS_SLOT)) + (size_t)(b * SEQ) * 16 + e, (e * 4 + b) * 512); }
        else { const int g = un - 64, b = g >> 4, e = g & 15;
            rank_group<1>(F, ((float*)(F.ws + WS_AFFT)) + (size_t)NB * NE * SEQ + (size_t)g * CTXL, CTXL, CAP_C, ((int*)(F.ws + WS_SLOT)) + (size_t)(ML + b * CTXL) * 16 + e, 32768 + e * 256 + b * 32); }
    }
}
__device__ __forceinline__ void phase_gather(const Frame& F0, int l) {
    const Frame F = fresh(F0);
    const int lane = F.lane; const int nrows = (l == 0) ? XS_ROWS : 32768;
    for (int rho = F.gw; rho < nrows; rho += F.ngw) {
        const bf16_t* src = nullptr;
        if (rho < 32768) { const int ge = rho >> 9, b = ge & 3; src = ((bf16_t*)(F.ws + WS_H)) + (size_t)(b * SEQ + ((int*)(F.ws + WS_IDX))[rho]) * DM; }
        else { const int i = (rho - 32768) & 255; if (i < 128) { const int b = i >> 5; src = ((bf16_t*)(F.ws + WS_H)) + (size_t)(ML + b * CTXL + ((int*)(F.ws + WS_IDX))[rho]) * DM; } else if (lane == 0) ((float*)(F.ws + WS_GATE))[rho] = 0.f; }
        bf16_t* dst = ((bf16_t*)(F.ws + WS_XS)) + (size_t)rho * DM + 8 * lane;
#pragma unroll
        for (int j = 0; j < 4; ++j) { const u32x4 w = src ? *(const u32x4*)(src + 8 * lane + 512 * j) : (u32x4){0u, 0u, 0u, 0u}; *(u32x4*)(dst + 512 * j) = w; }
    }
}

#ifndef PH_MASK
#define PH_MASK 0xFFFFFFFFu
#endif
#ifndef DUP_MASK
#define DUP_MASK 0x0u
#endif
#define SLOT_OF(k) (((k) < 2) ? (k) : (((k) - 2) % 11 + 2))
#define REPS(k) for (int rep_ = 0; rep_ < 1 + (int)((DUP_MASK >> SLOT_OF(k)) & 1u); ++rep_)
#define IN(k) (lo <= (k) && (k) < hi && ((PH_MASK >> (((k) < 2) ? (k) : (((k) - 2) % 11 + 2))) & 1u))
#define SEAM(k) do { if (IN(k) && IN((k) + 1)) xcd_barrier(bar); } while (0)
#define SEAMP(k, HOOK) do { if (IN(k) && IN((k) + 1)) { xcd_arrive(bar); HOOK; xcd_wait(bar); } } while (0)
template <int L> __device__ __forceinline__ void layer_program(const Frame& F0, const int lo, const int hi, const XcdBarrier& bar, LAS unsigned char* ring) {
    {
        constexpr int l = L; constexpr int pb = 2 + 11 * l;
        const int mrows = (l == 0) ? MT : ML;
        const int xrows = (l == 0) ? XS_ROWS : 32768;
        if (IN(pb + 0)) REPS(pb + 0) { phase_norm1(F0, l); } SEAM(pb + 0);
        if (IN(pb + 1)) REPS(pb + 1) {
            const Frame F = fresh(F0);
            pg8::Gemm g{((bf16_t*)(F.ws + WS_H)), ((bf16_t*)(F.ws + WS_WIN)) + (size_t)l * PW * DM, DM}; pg8::StaticOrder S; if (l == NL - 1) { S.init(ML, PW, F.G, F.bx, 0); S.ex_n = 32; S.ex_pm0 = ML / 256; S.ex_pn0 = AW / 256; } else S.init(MT, PW, F.G, F.bx, 0);
            EpiProj E{((bf16_t*)(F.ws + WS_P)), F.in(I_BIN) + l * PW};
            pg8::gemm_phase<EpiProj, pg8::StaticOrder, true, true>(ring, g, S, E, F.wave);
        } SEAM(pb + 1);
        if (IN(pb + 2)) REPS(pb + 2) { phase_prep(F0, l); phase_glu_sc(F0, l, mrows); } SEAMP(pb + 2, conv_taps_fill(F0, l));
        if (IN(pb + 3)) REPS(pb + 3) { phase_conv2(F0, l, mrows, IN(pb + 2) && DUP_MASK == 0u); phase_attn(F0, l); } SEAM(pb + 3);
        if (IN(pb + 4)) REPS(pb + 4) {
            { const Frame F = fresh(F0); pg8::StaticOrder S; S.init(mrows, DM, F.G, F.bx, 0);
              pg8::Gemm g{((bf16_t*)(F.ws + WS_ATT)), ((bf16_t*)(F.ws + WS_WAO)) + (size_t)l * DM * AW, AW}; EpiGate<false> E{((bf16_t*)(F.ws + WS_MX)), (const unsigned char*)(((bf16_t*)(F.ws + WS_P)) + GATE_COL)}; pg8::gemm_phase<EpiGate<false>, pg8::StaticOrder, true, true>(ring, g, S, E, F.wave); }
            { const Frame F = fresh(F0); pg8::StaticOrder S; S.init(mrows, DM, F.G, F.bx, 0);
              pg8::Gemm g{((bf16_t*)(F.ws + WS_CONV)), ((bf16_t*)(F.ws + WS_WCO)) + (size_t)l * DM * CWD, CWD}; EpiGate<true> E{((bf16_t*)(F.ws + WS_MX)), (const unsigned char*)(((bf16_t*)(F.ws + WS_P)) + GATE_COL) + DM}; pg8::gemm_phase<EpiGate<true>, pg8::StaticOrder, true, true>(ring, g, S, E, F.wave); }
            { const Frame F = fresh(F0); pg8::StaticOrder S; S.init(mrows, DM, F.G, F.bx, 0);
              pg8::Gemm g{((bf16_t*)(F.ws + WS_SC)), ((bf16_t*)(F.ws + WS_WSO)) + (size_t)l * DM * SWD, SWD}; EpiGate<true> E{((bf16_t*)(F.ws + WS_MX)), (const unsigned char*)(((bf16_t*)(F.ws + WS_P)) + GATE_COL) + 2 * DM}; pg8::gemm_phase<EpiGate<true>, pg8::StaticOrder, true, true>(ring, g, S, E, F.wave); }
        } SEAM(pb + 4);
        if (IN(pb + 5)) REPS(pb + 5) {
            const Frame F = fresh(F0);
            pg8::Gemm g{((bf16_t*)(F.ws + WS_MX)), ((bf16_t*)(F.ws + WS_WO)) + (size_t)l * DM * DM, DM}; pg8::StaticOrder S; S.init(mrows, DM, F.G, F.bx, 0);
            EpiDelta E{((bf16_t*)(F.ws + WS_XM)), ((float*)(F.ws + WS_MOD)) + (size_t)l * 5 * 12288 + 2 * DM};
            pg8::gemm_phase<EpiDelta, pg8::StaticOrder, true, true>(ring, g, S, E, F.wave);
        } SEAMP(pb + 5, router_fill(F0, l));
        if (IN(pb + 6)) REPS(pb + 6) { phase_norm2p(F0, l, mrows, IN(pb + 5) && DUP_MASK == 0u); } SEAM(pb + 6);
        if (IN(pb + 7)) REPS(pb + 7) { phase_rank(F0, l); } SEAM(pb + 7);
        if (IN(pb + 9)) REPS(pb + 9) {
            const Frame F = fresh(F0);
            pg8::StaticOrder S; S.init(xrows, 2048, F.G, F.bx, 1);
            LAS int* gidx = (LAS int*)(F.lds + RING_BYTES + 1024);
            { pg8::Unit u;
              for (int si = 0; S.next(si, u); ++si) if (F.tid < 256) { const int rho = u.pm * 256 + F.tid; int src;
                  if (rho < 32768) src = ((rho >> 9) & 3) * SEQ + ((const int*)(F.ws + WS_IDX))[rho];
                  else { const int i = (rho - 32768) & 255; if (i < 128) src = ML + (i >> 5) * CTXL + ((const int*)(F.ws + WS_IDX))[rho]; else { src = 0; ((float*)(F.ws + WS_GATE))[rho] = 0.f; } }
                  gidx[si * 256 + F.tid] = src; } }
            __syncthreads();
            pg8::Gemm g{(const bf16_t*)(F.ws + WS_H8), (const bf16_t*)(F.ws + WS_W13 + (size_t)l * NE * 2048 * DM), DM / 2};
            EpiSwiglu E{(unsigned char*)(F.ws + WS_HID)};
            pg8::gemm_phase<EpiSwiglu, pg8::StaticOrder, true, true, true, true>(ring, g, S, E, F.wave, gidx);
        } SEAM(pb + 9);
        if (IN(pb + 10)) REPS(pb + 10) {
            const Frame F = fresh(F0);
            pg8::Gemm g{(const bf16_t*)(F.ws + WS_HID), (const bf16_t*)(F.ws + WS_W2 + (size_t)l * NE * DM * FF), FF / 2}; pg8::StaticOrder S; S.init(xrows, DM, F.G, F.bx, 1);
            EpiY E{((bf16_t*)(F.ws + WS_Y)), ((float*)(F.ws + WS_GATE))};
            pg8::gemm_phase<EpiY, pg8::StaticOrder, true, true, false, true>(ring, g, S, E, F.wave);
        } SEAM(pb + 10);
    }
}
struct Args { const float* in[26]; float* out; unsigned char* ws; int ph_lo, ph_hi; };
__global__ void __launch_bounds__(NWAVES * 64, 2) mk_fwd(Args args) {
    extern __shared__ __attribute__((aligned(16))) unsigned char lds[];
    Frame F;
    F.lds = (LAS unsigned char*)lds;
    volatile LAS unsigned* MISC = (volatile LAS unsigned*)(F.lds + MISC_OFF);
    F.wave = __builtin_amdgcn_readfirstlane((int)threadIdx.x >> 6); F.tid = F.wave * 64 + mk_lane_id(); F.lane = F.tid & 63;
    F.G = gridDim.x; F.bx = blockIdx.x; F.gw = blockIdx.x * NWAVES + F.wave; F.ngw = F.G * NWAVES;
    F.karg = (const CAS unsigned char*)__builtin_amdgcn_kernarg_segment_ptr(); F.out = nullptr; F.ws = nullptr;
    unsigned char* ws = args.ws;
    for (int u = F.tid; u < (LDS_BYTES - RING_BYTES) / 4; u += NWAVES * 64) ((LAS unsigned*)(F.lds + RING_BYTES))[u] = 0u;
    __syncthreads();
    const int lo = args.ph_lo, hi = args.ph_hi;
    XcdBarrier bar; bar.bar = (unsigned*)(ws + WS_CTL) + CW_BAR; bar.x = 0; bar.st = nullptr; bar.w0 = (F.wave == 0);
    if (hi - lo > 1) bar = xcd_barrier_post((unsigned*)(ws + WS_CTL) + CW_BAR, MISC + 8, F.wave == 0);
    LAS unsigned char* ring = F.lds + RING_OFF;
    const Frame& F0 = F;

    if (IN(0)) REPS(0) { phase_pa(F0); } SEAM(0);
    if (IN(1)) REPS(1) { phase_pa2(F0); } SEAM(1);
    layer_program<0>(F0, lo, hi, bar, ring);
    layer_program<1>(F0, lo, hi, bar, ring);
    if (IN(24)) REPS(24) { phase_final(F0); }
#undef IN
#undef SEAM
}

extern "C" void kernel_launch(void* const* d_in, const int* in_sizes, int n_in, void* d_out, int out_size, void* d_ws, size_t ws_size, hipStream_t stream) {
    static int grid = 0;
    if (grid == 0) {
        if (n_in != 26 || out_size != ML * DM || ws_size < WS_END) { fprintf(stderr, "kernel_launch: unexpected shapes (n_in %d, out %d, ws %zu < %zu)\n", n_in, out_size, ws_size, (size_t)WS_END); grid = -1; return; }
        int dev = 0, cus = 0, per_cu = 0;
        if (hipGetDevice(&dev) != hipSuccess || hipDeviceGetAttribute(&cus, hipDeviceAttributeMultiprocessorCount, dev) != hipSuccess) { grid = -1; return; }
        if (hipFuncSetAttribute((const void*)mk_fwd, hipFuncAttributeMaxDynamicSharedMemorySize, LDS_BYTES) != hipSuccess) { fprintf(stderr, "kernel_launch: hipFuncSetAttribute failed\n"); grid = -1; return; }
        if (hipOccupancyMaxActiveBlocksPerMultiprocessor(&per_cu, (const void*)mk_fwd, NWAVES * 64, LDS_BYTES) != hipSuccess || per_cu < 1) fprintf(stderr, "kernel_launch: occupancy query says %d\n", per_cu);
        (void)hipGetLastError();
        grid = cus;
    }
    if (grid < 0) return;
    (void)hipMemsetAsync((char*)d_ws + WS_CTL, 0, CTL_ZERO_BYTES, stream);
    Args a{};
    for (int i = 0; i < 26; ++i) a.in[i] = (const float*)d_in[i];
    a.out = (float*)d_out; a.ws = (unsigned char*)d_ws;
#if MK_PER_PHASE
    for (int p = 0; p < NPHASE; ++p) { a.ph_lo = p; a.ph_hi = p + 1; hipLaunchKernelGGL(mk_fwd, dim3(grid), dim3(NWAVES * 64), LDS_BYTES, stream, a); }
#else
    a.ph_lo = 0; a.ph_hi = NPHASE; hipLaunchKernelGGL(mk_fwd, dim3(grid), dim3(NWAVES * 64), LDS_BYTES, stream, a);
#endif
}
```

```cpp
#include <hip/hip_runtime.h>
#include <cstdio>
#include <cstdint>

#ifndef MK_PER_PHASE
#define MK_PER_PHASE 0
#endif

__device__ __forceinline__ int mk_lane_id() { unsigned z = 0u; asm volatile("" : "+v"(z)); return (int)__builtin_amdgcn_mbcnt_hi(~0u, __builtin_amdgcn_mbcnt_lo(~0u, z)); }
namespace pg8 {
#define PG8_LAS __attribute__((address_space(3)))
typedef unsigned short bf16_t;
typedef short bf16x8 __attribute__((ext_vector_type(8)));
typedef float f32x4 __attribute__((ext_vector_type(4)));
typedef float f32x2 __attribute__((ext_vector_type(2)));
typedef unsigned u32x4 __attribute__((ext_vector_type(4)));
typedef unsigned u32x2 __attribute__((ext_vector_type(2)));
typedef int i32x4 __attribute__((ext_vector_type(4)));
typedef int i32x8 __attribute__((ext_vector_type(8)));
constexpr int BM = 256, BK = 64, HALF = 128, HTB = HALF * BK * 2, STAGE_BYTES = 8 * HTB, NXCD = 8, WGM = 8;

__host__ __device__ __forceinline__ int lds_byte(int r, int c) { const int st = (r >> 4) * 2 + (c >> 5), rr = r & 15, cc = c & 31, ob = rr * 64 + cc * 2; return st * 1024 + (ob ^ (((ob >> 9) & 1) << 5)); }
__host__ __device__ __forceinline__ void stage_rc(int b, int& R, int& C) { const int st = b / 1024, sb = b % 1024, swz = sb ^ (((sb >> 9) & 1) << 5); R = (st >> 1) * 16 + swz / 64; C = (st & 1) * 32 + (swz % 64) / 2; }
__host__ __device__ __forceinline__ int perm32(int rho) { const int n = rho >> 4, i = rho & 15; return 8 * (i >> 2) + 4 * n + (i & 3); }

struct Unit { int pm, pn, pb; };
struct Gemm { const bf16_t* A; const bf16_t* Bt; int K; };

struct StaticOrder {
    int nM, nN, nwg, G, c, moe, ex_n, ex_pm0, ex_pn0;
    __host__ __device__ void init(int M, int N, int G_, int c_, int moe_) { nM = M / BM; nN = N / BM; nwg = nM * nN; G = G_; c = c_; moe = moe_; ex_n = 0; ex_pm0 = 0; ex_pn0 = 0; }
    __host__ __device__ bool next(int i, Unit& u) const {
        const long L = (long)i * G + c; if (L >= nwg + ex_n) return false;
        if (L >= nwg) { const int q = (int)L - nwg; u.pm = ex_pm0 + (q & 3); u.pn = ex_pn0 + (q >> 2); u.pb = u.pn; return true; }
        int wgid = (int)L; { const int q = nwg / NXCD, r = nwg % NXCD, xcd = wgid % NXCD, off = wgid / NXCD; wgid = (xcd < r ? xcd * (q + 1) : r * (q + 1) + (xcd - r) * q) + off; }
        const int nig = WGM * nN, gid = wgid / nig, fm = gid * WGM, gsz = (nM - fm) < WGM ? (nM - fm) : WGM;
        u.pm = fm + ((wgid % nig) % gsz); u.pn = (wgid % nig) / gsz;
        u.pb = moe ? ((u.pm < 128 ? (u.pm >> 3) : (u.pm - 128)) * nN + u.pn) : u.pn;
        return true;
    }
    __device__ __forceinline__ void a_ready(const Unit&) const {}
    __device__ __forceinline__ void done(const Unit&) const {}
};

__device__ __forceinline__ unsigned cvt_pk_bf16(float lo, float hi) { unsigned r; asm volatile("v_cvt_pk_bf16_f32 %0, %1, %2" : "=v"(r) : "v"(lo), "v"(hi)); return r; }

template <class Epi, class Sched, bool ALIGN_EPI = false, bool SP2 = false, bool GATHER = false, bool FP8 = false>
__device__ __forceinline__ void gemm_phase(PG8_LAS unsigned char* lds, const Gemm g, const Sched& S, const Epi& E, const int wave_id, const PG8_LAS int* gidx = nullptr) {
    static_assert(!GATHER || SP2, "GATHER is written for the SP2 loop");
    int tid_ = wave_id * 64 + mk_lane_id(); asm volatile("" : "+v"(tid_));
    const int tid = tid_, wid = __builtin_amdgcn_readfirstlane(tid >> 6), lane = tid & 63, wr = wid >> 2, wc = wid & 3, fr = lane & 15, fq = lane >> 4;
    const int K = g.K, nt = K / BK;
    unsigned voffA[2], voffB[2];
#pragma unroll
    for (int i = 0; i < 2; ++i) { int R, C; stage_rc(tid * 16 + i * 8192, R, C); const int Rb = Epi::PERM ? ((R & ~31) + perm32(R & 31)) : R;
        voffA[i] = (unsigned)(R * K + C) * 2u; voffB[i] = (unsigned)(Rb * K + C) * 2u; }
    int gR[2]; unsigned gC[2]; unsigned oc[2][2], on[2][2];
#pragma unroll
    for (int i = 0; i < 2; ++i) { int R, C; stage_rc(tid * 16 + i * 8192, R, C); gR[i] = R; gC[i] = (unsigned)C * 2u; }
#define PG8_GOFF(dst, slot) do { _Pragma("unroll") for (int _h = 0; _h < 2; ++_h) _Pragma("unroll") for (int _i = 0; _i < 2; ++_i) dst[_h][_i] = (unsigned)gidx[(slot) * 256 + _h * 128 + gR[_i]] * (unsigned)(K * 2) + gC[_i]; } while (0)
    const size_t kstep = (size_t)(BK * 2);
    const size_t hstep = (size_t)HALF * K * 2;
    const size_t tstep = 2 * hstep;
    const unsigned ldsw = (unsigned)wid * 1024u;
    const int aoff = lds_byte(wr * 64 + fr, fq * 8), boff = lds_byte(wc * 32 + fr, fq * 8);
#define PG8_SA(b, h) (((b) * 2 + (h)) * HTB)
#define PG8_SB(b, h) ((4 + (b) * 2 + (h)) * HTB)
#define PG8_STAGE(bufoff, gbase, voff) do { _Pragma("unroll") for (int _i = 0; _i < 2; ++_i) \
        __builtin_amdgcn_global_load_lds((const unsigned*)((const char*)(gbase) + (voff)[_i]), (PG8_LAS unsigned*)(lds + (bufoff) + ldsw + _i * 8192), 16, 0, 0); } while (0)
#define PG8_STAGE_G(bufoff, kt_, o0, o1) do { const char* _gb = (const char*)g.A + (size_t)(kt_) * kstep; \
        __builtin_amdgcn_global_load_lds((const unsigned*)(_gb + (o0)), (PG8_LAS unsigned*)(lds + (bufoff) + ldsw), 16, 0, 0); \
        __builtin_amdgcn_global_load_lds((const unsigned*)(_gb + (o1)), (PG8_LAS unsigned*)(lds + (bufoff) + ldsw + 8192), 16, 0, 0); } while (0)
#define PG8_LDA(dst, b, h) do { _Pragma("unroll") for (int m = 0; m < 4; ++m) { if constexpr (FP8) dst##8[m] = __builtin_shufflevector(*(const PG8_LAS i32x4*)(lds + PG8_SA(b, h) + aoff + m * 2048), *(const PG8_LAS i32x4*)(lds + PG8_SA(b, h) + aoff + m * 2048 + 1024), 0, 1, 2, 3, 4, 5, 6, 7); \
        else { _Pragma("unroll") for (int k = 0; k < 2; ++k) dst[m][k] = *(const PG8_LAS bf16x8*)(lds + PG8_SA(b, h) + aoff + m * 2048 + k * 1024); } } } while (0)
#define PG8_LDB(dst, b, h) do { _Pragma("unroll") for (int n = 0; n < 2; ++n) { if constexpr (FP8) dst##8[n] = __builtin_shufflevector(*(const PG8_LAS i32x4*)(lds + PG8_SB(b, h) + boff + n * 2048), *(const PG8_LAS i32x4*)(lds + PG8_SB(b, h) + boff + n * 2048 + 1024), 0, 1, 2, 3, 4, 5, 6, 7); \
        else { _Pragma("unroll") for (int k = 0; k < 2; ++k) dst[n][k] = *(const PG8_LAS bf16x8*)(lds + PG8_SB(b, h) + boff + n * 2048 + k * 1024); } } } while (0)
#define PG8_CAT(x, y) __builtin_shufflevector(__builtin_bit_cast(i32x4, x), __builtin_bit_cast(i32x4, y), 0, 1, 2, 3, 4, 5, 6, 7)
#define PG8_MMA(ai, bj, At, Bt) do { __builtin_amdgcn_s_setprio(1); _Pragma("unroll") for (int m = 0; m < 4; ++m) _Pragma("unroll") for (int n = 0; n < 2; ++n) { \
        if constexpr (FP8) acc[ai][bj][m][n] = __builtin_amdgcn_mfma_scale_f32_16x16x128_f8f6f4(Bt##8[n], At##8[m], acc[ai][bj][m][n], 0, 0, 0, 0x7F7F7F7F, 0, 0x7F7F7F7F); \
        else { _Pragma("unroll") for (int k = 0; k < 2; ++k) acc[ai][bj][m][n] = __builtin_amdgcn_mfma_f32_16x16x32_bf16(Bt[n][k], At[m][k], acc[ai][bj][m][n], 0, 0, 0); } } __builtin_amdgcn_s_setprio(0); \
        if constexpr (FP8) { _Pragma("unroll") for (int m = 0; m < 4; ++m) _Pragma("unroll") for (int n = 0; n < 2; ++n) asm volatile("" : "+a"(acc[ai][bj][m][n])); } } while (0)
#define PG8_WAIT_V(n) asm volatile("s_waitcnt vmcnt(" #n ")" ::: "memory")
#define PG8_WAIT_L(n) asm volatile("s_waitcnt lgkmcnt(" #n ")" ::: "memory")
#define PG8_BAR __builtin_amdgcn_s_barrier()
#define PG8_SCHED __builtin_amdgcn_sched_barrier(0)
    Unit cur, nxt; int ui = 0;
    if (!S.next(0, cur)) return;
    f32x4 acc[2][2][4][2];
#pragma unroll
    for (int a = 0; a < 2; ++a)
#pragma unroll
        for (int b = 0; b < 2; ++b)
#pragma unroll
            for (int m = 0; m < 4; ++m)
#pragma unroll
                for (int n = 0; n < 2; ++n) acc[a][b][m][n] = (f32x4){0.f, 0.f, 0.f, 0.f};
    bf16x8 At[4][2], B0[2][2], B1[2][2];
    i32x8 At8[4], B08[2], B18[2];
    const char* cA = (const char*)g.A + (size_t)cur.pm * tstep; const char* cB = (const char*)g.Bt + (size_t)cur.pb * tstep;
    S.a_ready(cur);
    if constexpr (SP2) {
        if constexpr (GATHER) { PG8_GOFF(oc, 0); }
        PG8_STAGE(PG8_SB(0, 0), cB, voffB); PG8_STAGE(PG8_SB(0, 1), cB + hstep, voffB);
        if constexpr (GATHER) { PG8_STAGE_G(PG8_SA(0, 0), 0, oc[0][0], oc[0][1]); PG8_STAGE_G(PG8_SA(0, 1), 0, oc[1][0], oc[1][1]); }
        else { PG8_STAGE(PG8_SA(0, 0), cA, voffA); PG8_STAGE(PG8_SA(0, 1), cA + hstep, voffA); }
        if (wr == 1) PG8_BAR;
        PG8_WAIT_V(2); PG8_BAR;
        PG8_STAGE(PG8_SB(1, 0), cB + kstep, voffB);
        if constexpr (GATHER) { PG8_STAGE_G(PG8_SA(1, 0), 1, oc[0][0], oc[0][1]); } else { PG8_STAGE(PG8_SA(1, 0), cA + kstep, voffA); }
        PG8_STAGE(PG8_SB(1, 1), cB + hstep + kstep, voffB);
        PG8_WAIT_V(6); PG8_BAR;
    } else {
        PG8_STAGE(PG8_SB(0, 0), cB, voffB); PG8_STAGE(PG8_SA(0, 0), cA, voffA); PG8_STAGE(PG8_SB(0, 1), cB + hstep, voffB); PG8_STAGE(PG8_SA(0, 1), cA + hstep, voffA);
        if (wr == 1) PG8_BAR;
        PG8_WAIT_V(4); PG8_BAR;
        PG8_STAGE(PG8_SB(1, 0), cB + kstep, voffB); PG8_STAGE(PG8_SA(1, 0), cA + kstep, voffA); PG8_STAGE(PG8_SB(1, 1), cB + hstep + kstep, voffB);
        PG8_WAIT_V(6); PG8_BAR;
    }
    for (;;) {
        const bool has_next = S.next(ui + 1, nxt);
        if constexpr (GATHER) { if (has_next) { PG8_GOFF(on, ui + 1); } else { _Pragma("unroll") for (int _h = 0; _h < 2; ++_h) _Pragma("unroll") for (int _i = 0; _i < 2; ++_i) on[_h][_i] = oc[_h][_i]; } }
        const char* nA = has_next ? (const char*)g.A + (size_t)nxt.pm * tstep : cA; const char* nB = has_next ? (const char*)g.Bt + (size_t)nxt.pb * tstep : cB;
#pragma nounroll
        for (int t = 0; t < nt; t += 2) {
            const bool last = (t == nt - 2);
            const char* a1 = cA + (size_t)(t + 1) * kstep;
            const char* a2 = last ? nA : cA + (size_t)(t + 2) * kstep; const char* b2 = last ? nB : cB + (size_t)(t + 2) * kstep;
            const char* a3 = a2 + kstep; const char* b3 = b2 + kstep;
            if (last && has_next) S.a_ready(nxt);
            if constexpr (SP2) {
            const int kt2 = last ? 0 : t + 2, kt3 = kt2 + 1;
            unsigned s00, s01, s10, s11; if constexpr (GATHER) { s00 = last ? on[0][0] : oc[0][0]; s01 = last ? on[0][1] : oc[0][1]; s10 = last ? on[1][0] : oc[1][0]; s11 = last ? on[1][1] : oc[1][1]; }
            PG8_LDB(B0, 0, 0); PG8_LDB(B1, 0, 1); PG8_SCHED; PG8_LDA(At, 0, 0);
            if constexpr (GATHER) { PG8_STAGE_G(PG8_SA(1, 1), t + 1, oc[1][0], oc[1][1]); } else { PG8_STAGE(PG8_SA(1, 1), a1 + hstep, voffA); }
            PG8_WAIT_V(8); PG8_WAIT_L(0); PG8_BAR; PG8_MMA(0, 0, At, B0); PG8_MMA(0, 1, At, B1); PG8_BAR; PG8_SCHED;
            PG8_LDA(At, 0, 1); PG8_STAGE(PG8_SB(0, 0), b2, voffB); PG8_STAGE(PG8_SB(0, 1), b2 + hstep, voffB);
            if constexpr (GATHER) { PG8_STAGE_G(PG8_SA(0, 0), kt2, s00, s01); } else { PG8_STAGE(PG8_SA(0, 0), a2, voffA); }
            PG8_WAIT_V(8); PG8_WAIT_L(0); PG8_BAR; PG8_MMA(1, 0, At, B0); PG8_MMA(1, 1, At, B1); PG8_BAR; PG8_SCHED;
            PG8_LDB(B0, 1, 0); PG8_LDB(B1, 1, 1); PG8_SCHED; PG8_LDA(At, 1, 0);
            if constexpr (GATHER) { PG8_STAGE_G(PG8_SA(0, 1), kt2, s10, s11); } else { PG8_STAGE(PG8_SA(0, 1), a2 + hstep, voffA); }
            PG8_WAIT_V(8); PG8_WAIT_L(0); PG8_BAR; PG8_MMA(0, 0, At, B0); PG8_MMA(0, 1, At, B1); PG8_BAR; PG8_SCHED;
            PG8_LDA(At, 1, 1); PG8_STAGE(PG8_SB(1, 0), b3, voffB); PG8_STAGE(PG8_SB(1, 1), b3 + hstep, voffB);
            if constexpr (GATHER) { PG8_STAGE_G(PG8_SA(1, 0), kt3, s00, s01); } else { PG8_STAGE(PG8_SA(1, 0), a3, voffA); }
            PG8_WAIT_V(8); PG8_WAIT_L(0); PG8_BAR; PG8_MMA(1, 0, At, B0); PG8_MMA(1, 1, At, B1); PG8_BAR; PG8_SCHED;
            } else {
            PG8_LDB(B0, 0, 0); PG8_SCHED; PG8_LDA(At, 0, 0); PG8_STAGE(PG8_SA(1, 1), a1 + hstep, voffA);
            PG8_WAIT_L(8); PG8_BAR; PG8_WAIT_L(0); PG8_MMA(0, 0, At, B0); PG8_BAR; PG8_SCHED;
            PG8_LDB(B1, 0, 1); PG8_STAGE(PG8_SB(0, 0), b2, voffB);
            PG8_BAR; PG8_WAIT_L(0); PG8_MMA(0, 1, At, B1); PG8_BAR;
            PG8_LDA(At, 0, 1); PG8_STAGE(PG8_SA(0, 0), a2, voffA);
            PG8_BAR; PG8_WAIT_L(0); PG8_MMA(1, 0, At, B0); PG8_BAR; PG8_SCHED;
            PG8_STAGE(PG8_SB(0, 1), b2 + hstep, voffB);
            PG8_WAIT_V(6); PG8_BAR; PG8_MMA(1, 1, At, B1); PG8_BAR;
            PG8_LDB(B0, 1, 0); PG8_SCHED; PG8_LDA(At, 1, 0); PG8_STAGE(PG8_SA(0, 1), a2 + hstep, voffA);
            PG8_WAIT_L(8); PG8_BAR; PG8_WAIT_L(0); PG8_MMA(0, 0, At, B0); PG8_BAR; PG8_SCHED;
            PG8_LDB(B1, 1, 1); PG8_STAGE(PG8_SB(1, 0), b3, voffB);
            PG8_BAR; PG8_WAIT_L(0); PG8_MMA(0, 1, At, B1); PG8_BAR;
            PG8_LDA(At, 1, 1); PG8_STAGE(PG8_SA(1, 0), a3, voffA);
            PG8_BAR; PG8_WAIT_L(0); PG8_MMA(1, 0, At, B0); PG8_BAR; PG8_SCHED;
            PG8_STAGE(PG8_SB(1, 1), b3 + hstep, voffB);
            PG8_WAIT_V(6); PG8_BAR; PG8_MMA(1, 1, At, B1); PG8_BAR;
            }
        }
        if constexpr (ALIGN_EPI) { if (wr == 0) PG8_BAR; }
        { int t2_ = mk_lane_id(); asm volatile("" : "+v"(t2_)); const int l2_ = t2_ & 63;
          E(acc, cur, wr, wc, l2_ & 15, l2_ >> 4); } S.done(cur);
        if (!has_next) break;
#pragma unroll
        for (int a = 0; a < 2; ++a)
#pragma unroll
            for (int b = 0; b < 2; ++b)
#pragma unroll
                for (int m = 0; m < 4; ++m)
#pragma unroll
                    for (int n = 0; n < 2; ++n) acc[a][b][m][n] = (f32x4){0.f, 0.f, 0.f, 0.f};
        cur = nxt; cA = nA; cB = nB; ++ui;
        if constexpr (GATHER) { _Pragma("unroll") for (int _h = 0; _h < 2; ++_h) _Pragma("unroll") for (int _i = 0; _i < 2; ++_i) oc[_h][_i] = on[_h][_i]; }
        if constexpr (ALIGN_EPI) { if (wr == 1) PG8_BAR; }
    }
    PG8_WAIT_V(0);
    if constexpr (!ALIGN_EPI) { if (wr == 0) PG8_BAR; }
    PG8_BAR;
#undef PG8_SA
#undef PG8_SB
#undef PG8_STAGE
#undef PG8_STAGE_G
#undef PG8_GOFF
#undef PG8_LDA
#undef PG8_LDB
#undef PG8_MMA
#undef PG8_CAT
#undef PG8_WAIT_V
#undef PG8_WAIT_L
#undef PG8_BAR
#undef PG8_SCHED
}
}

using pg8::bf16_t; using pg8::f32x4; using pg8::f32x2; using pg8::u32x4; using pg8::u32x2; using pg8::cvt_pk_bf16;
constexpr int NWAVES = 8;
constexpr int NB = 4, SEQ = 4096, DM = 2048, NL = 2, CTXL = 256, NH = 16, HD = 64, AW = 1024, CWD = 512, SWD = 512, PW = 11776, NE = 16, FF = 1024;
constexpr int ML = NB * SEQ, MC = NB * CTXL, MT = ML + MC;
constexpr int CAP_L = 512, CAP_C = 32;
constexpr int GATE_COL = 5632;
constexpr int XS_ROWS = 32768 + 16 * 256;
constexpr float EPS = 1e-6f;
constexpr float LOG2E = 1.4426950408889634f;
constexpr int NPHASE = 25;

constexpr size_t MiB = 1u << 20;
constexpr size_t WS_CTL = 0, CTL_ZERO_BYTES = 1 * MiB;
constexpr size_t WS_MOD = 1 * MiB;
constexpr size_t WS_ADAP = 2 * MiB;
constexpr size_t WS_ROPE = 10 * MiB;
constexpr size_t WS_AFFT = 11 * MiB;
constexpr size_t WS_SLOT = 13 * MiB;
constexpr size_t WS_IDX = 15 * MiB;
constexpr size_t WS_GATE = 15 * MiB + 512 * 1024;
constexpr size_t WS_WIN = 16 * MiB;
constexpr size_t WS_WAO = 108 * MiB;
constexpr size_t WS_WCO = 116 * MiB;
constexpr size_t WS_WSO = 120 * MiB;
constexpr size_t WS_WO = 124 * MiB;
constexpr size_t WS_W13 = 140 * MiB;
constexpr size_t WS_W2 = 396 * MiB;
constexpr size_t WS_H = 524 * MiB;
constexpr size_t WS_MX = 592 * MiB;
constexpr size_t WS_P = 660 * MiB;
constexpr size_t WS_XS = 660 * MiB;
constexpr size_t WS_HID = 804 * MiB;
constexpr size_t WS_H8 = 660 * MiB;
constexpr size_t WS_Y = 876 * MiB;
constexpr size_t WS_QR = 1052 * MiB, WS_QP = 1084 * MiB, WS_KR = 1116 * MiB, WS_VT = 1148 * MiB;
constexpr size_t WS_QC = 1180 * MiB, WS_KC = 1182 * MiB, WS_VCT = 1184 * MiB;
constexpr size_t WS_ATT = 1186 * MiB;
constexpr size_t WS_CONV = 1220 * MiB;
constexpr size_t WS_SC = 1237 * MiB;
constexpr size_t WS_XM = 1052 * MiB;
constexpr size_t WS_MSH = WS_ROPE + 16384;
constexpr size_t WS_TAB = 1254 * MiB;
constexpr size_t WS_U = 1258 * MiB;
constexpr size_t WS_MA2 = 1 * MiB + 768 * 1024;
constexpr size_t WS_X1 = 1276 * MiB;
constexpr size_t WS_END = 1340 * MiB;
static_assert(WS_P + (size_t)MT * PW * 2 <= WS_QR && WS_Y + (size_t)XS_ROWS * DM * 2 <= WS_QR && WS_XM + (size_t)MT * DM * 4 <= WS_CONV, "ws map");
constexpr int CW_BAR = 4096;

constexpr int RING_OFF = 0, RING_BYTES = 131072;
constexpr int MISC_OFF = RING_BYTES + 320;
constexpr int LDS_BYTES = 147456;

#define GAS __attribute__((address_space(1)))
#define CAS __attribute__((address_space(4)))
#define LAS __attribute__((address_space(3)))
#define LDS_WAIT() asm volatile("s_waitcnt lgkmcnt(0)" ::: "memory")
#define VM_WAIT() asm volatile("s_waitcnt vmcnt(0)" ::: "memory")
__device__ __forceinline__ unsigned f2bf(float f) { unsigned u = __builtin_bit_cast(unsigned, f); return (u + 0x7fffu + ((u >> 16) & 1u)) >> 16; }
__device__ __forceinline__ unsigned pk2(float lo, float hi) { return f2bf(lo) | (f2bf(hi) << 16); }
__device__ __forceinline__ float bflo(unsigned w) { return __builtin_bit_cast(float, w << 16); }
__device__ __forceinline__ float bfhi(unsigned w) { return __builtin_bit_cast(float, w & 0xffff0000u); }
__device__ __forceinline__ float bf1(bf16_t h) { return __builtin_bit_cast(float, ((unsigned)h) << 16); }
__device__ __forceinline__ float wave_sum(float v) {
#pragma unroll
    for (int o = 1; o < 64; o <<= 1) v += __shfl_xor(v, o);
    return v;
}
__device__ __forceinline__ float wave_max(float v) {
#pragma unroll
    for (int o = 1; o < 64; o <<= 1) v = fmaxf(v, __shfl_xor(v, o));
    return v;
}
__device__ __forceinline__ float sig2_(float t) { return __builtin_amdgcn_rcpf(1.0f + __builtin_amdgcn_exp2f(t)); }
__device__ __forceinline__ float sigmoidf_(float x) { return __builtin_amdgcn_rcpf(1.0f + __expf(-x)); }
__device__ __forceinline__ unsigned pk4_gate(float a, float b, float c, float d) {
    const unsigned fa = __float_as_uint(a * 255.0f + 8388608.0f), fb = __float_as_uint(b * 255.0f + 8388608.0f), fc = __float_as_uint(c * 255.0f + 8388608.0f), fd = __float_as_uint(d * 255.0f + 8388608.0f);
    return __builtin_amdgcn_perm(__builtin_amdgcn_perm(fd, fc, 0x0c0c0400u), __builtin_amdgcn_perm(fb, fa, 0x0c0c0400u), 0x05040100u);
}
__device__ __forceinline__ unsigned pk4_bytes(f32x4 f) {
    const unsigned fa = __float_as_uint(f.x), fb = __float_as_uint(f.y), fc = __float_as_uint(f.z), fd = __float_as_uint(f.w);
    return __builtin_amdgcn_perm(__builtin_amdgcn_perm(fd, fc, 0x0c0c0400u), __builtin_amdgcn_perm(fb, fa, 0x0c0c0400u), 0x05040100u);
}
__device__ __forceinline__ f32x4 gate4(unsigned w) { return (f32x4){(float)(w & 0xffu), (float)((w >> 8) & 0xffu), (float)((w >> 16) & 0xffu), (float)(w >> 24)}; }

#define XB_TMO      128
#define XB_XCNT(j)  (256  + 64 * (j))
#define XB_XSUB(j)  (1280 + 64 * (j))
#define XB_XGEN(j)  (2304 + 64 * (j))
#define XB_TOP      3328
#define XB_TOPGEN   3392
#define XCD_BAR_WORDS 3456
#define XB_SPIN_CAP (1u << 18)
__device__ __forceinline__ unsigned xb_ld(unsigned* p)              { return __hip_atomic_load(p, __ATOMIC_RELAXED, __HIP_MEMORY_SCOPE_AGENT); }
__device__ __forceinline__ unsigned xb_add(unsigned* p, unsigned v) { return __hip_atomic_fetch_add(p, v, __ATOMIC_RELAXED, __HIP_MEMORY_SCOPE_AGENT); }
__device__ __forceinline__ unsigned xb_xcc_id() { return (unsigned)__builtin_amdgcn_s_getreg((3 << 11) | 20) & 0xFu; }
#define XB_SPIN(cond, bar) do { unsigned _sp = 0; while (cond) { __builtin_amdgcn_s_sleep(1); \
    if ((++_sp & 255u) == 0u) { if (xb_ld(&(bar)[XB_TMO])) break; if (_sp > XB_SPIN_CAP) { atomicAdd(&(bar)[XB_TMO], 1u); break; } } } } while (0)
struct XcdBarrier { unsigned* bar; unsigned x; volatile LAS unsigned* st; bool w0; };
__device__ __forceinline__ XcdBarrier xcd_barrier_post(unsigned* bar, volatile LAS unsigned* st, bool w0) {
    XcdBarrier b; b.bar = bar; b.x = xb_xcc_id(); b.st = st; b.w0 = w0;
    if (b.w0 && mk_lane_id() == 0) (void)xb_add(&bar[XB_XCNT(b.x)], 1u);
    return b;
}
__device__ __forceinline__ void xcd_barrier_complete(unsigned* bar, unsigned x, unsigned& nloc, unsigned& nx) {
    const unsigned G = gridDim.x * gridDim.y * gridDim.z;
    unsigned sum, cnt, mine, sp = 0u;
    for (;;) {
        sum = 0u; cnt = 0u; mine = 0u;
#pragma unroll
        for (unsigned j = 0; j < 16; ++j) { const unsigned c = xb_ld(&bar[XB_XCNT(j)]); sum += c; cnt += (c > 0u) ? 1u : 0u; mine = (j == x) ? c : mine; }
        if (sum == G) break;
        __builtin_amdgcn_s_sleep(1);
        if ((++sp & 255u) == 0u) { if (xb_ld(&bar[XB_TMO])) break; if (sp > XB_SPIN_CAP) { atomicAdd(&bar[XB_TMO], 1u); break; } }
    }
    nloc = mine > 0u ? mine : 1u; nx = cnt > 0u ? cnt : 1u;
}
__device__ __forceinline__ void xcd_arrive(const XcdBarrier& b) {
    asm volatile("s_waitcnt vmcnt(0)" ::: "memory");
    __syncthreads();
    if (b.w0 && mk_lane_id() == 0) {
        unsigned* bar = b.bar;
        __builtin_amdgcn_s_waitcnt(0);
        unsigned nloc = b.st[0], nx = b.st[1];
        if (nloc == 0u) { xcd_barrier_complete(bar, b.x, nloc, nx); b.st[0] = nloc; b.st[1] = nx; }
        const unsigned old = xb_add(&bar[XB_XSUB(b.x)], 1u);
        const unsigned gen = old / nloc;
        if (old + 1u == (gen + 1u) * nloc) {
            __builtin_amdgcn_fence(__ATOMIC_RELEASE, "agent");
            asm volatile("s_waitcnt vmcnt(0)" ::: "memory");
            (void)xb_add(&bar[XB_TOP], 1u);
        }
        b.st[2] = (gen + 1u) * nx;
    }
}
__device__ __forceinline__ void xcd_wait(const XcdBarrier& b) {
    if (b.w0 && mk_lane_id() == 0) {
        unsigned* bar = b.bar;
        const unsigned target = b.st[2];
        XB_SPIN(xb_ld(&bar[XB_TOP]) < target, bar);
        __builtin_amdgcn_fence(__ATOMIC_ACQUIRE, "agent");
        asm volatile("s_waitcnt vmcnt(0)" ::: "memory");
    }
    __syncthreads();
}
__device__ __forceinline__ void xcd_barrier(const XcdBarrier& b) { xcd_arrive(b); xcd_wait(b); }

struct Frame {
    LAS unsigned char* lds;
    int tid, lane, wave, G, bx, gw, ngw;
    const CAS unsigned char* karg;
    unsigned char* ws; float* out;
    __device__ __forceinline__ const float* in(int i) const { return ((const float* const CAS*)karg)[i]; }
};
__device__ __forceinline__ Frame fresh(const Frame& F0) {
    Frame R; unsigned long long k = (unsigned long long)F0.karg; int t = F0.wave * 64 + mk_lane_id(), g = gridDim.x, bx = blockIdx.x; asm volatile("" : "+s"(k), "+v"(t), "+s"(g), "+s"(bx));
    R.karg = (const CAS unsigned char*)k; R.lds = F0.lds; R.tid = t; R.lane = t & 63; R.wave = F0.wave; R.G = g; R.bx = bx; R.gw = bx * NWAVES + R.wave; R.ngw = g * NWAVES;
    R.out = ((float* const CAS*)R.karg)[26]; R.ws = ((unsigned char* const CAS*)R.karg)[27]; return R;
}
enum { I_X = 0, I_C, I_CTX, I_CCTX, I_WADA, I_BADA, I_GN1, I_GN2, I_WIN, I_BIN, I_GQ, I_GK, I_RPB, I_WAO, I_CDW, I_CDB, I_CLG, I_CLB, I_WCO, I_SCW, I_WSO, I_WO, I_WR, I_WE1, I_WE3, I_WE2 };

template <bool NT = false>
__device__ __forceinline__ void conv_item(const float* W, int K, int N, bf16_t* WT, int k0, int n0, int drow0, LAS float* scr, int lane) {
    const float sc = (N == PW && n0 >= 5632) ? -1.4426950408889634f : 1.0f;
    { const int rr = lane >> 3, cq = lane & 7; f32x4 t[8];
#pragma unroll
      for (int i = 0; i < 8; ++i) { const f32x4* p_ = (const f32x4*)(W + (size_t)(k0 + 8 * i + rr) * N + n0 + 4 * cq); t[i] = NT ? __builtin_nontemporal_load(p_) : *p_; }
#pragma unroll
      for (int i = 0; i < 8; ++i) { LAS float* d = scr + (8 * i + rr) * 33 + 4 * cq; d[0] = t[i].x; d[1] = t[i].y; d[2] = t[i].z; d[3] = t[i].w; } }
    LDS_WAIT(); asm volatile("" ::: "memory");
    const int c = lane & 7;
#pragma unroll
    for (int j = 0; j < 4; ++j) { const int n = (lane >> 3) + 8 * j; const LAS float* s = scr + (8 * c) * 33 + n;
        u32x4 o; o.x = pk2(s[0 * 33] * sc, s[1 * 33] * sc); o.y = pk2(s[2 * 33] * sc, s[3 * 33] * sc); o.z = pk2(s[4 * 33] * sc, s[5 * 33] * sc); o.w = pk2(s[6 * 33] * sc, s[7 * 33] * sc);
        *(u32x4*)(WT + (size_t)(drow0 + n) * K + k0 + 8 * c) = o; }
    LDS_WAIT(); asm volatile("" ::: "memory");
}
__device__ __forceinline__ unsigned pk4_fp8(float a, float b, float c, float d) { int r = __builtin_amdgcn_cvt_pk_fp8_f32(a, b, 0, false); r = __builtin_amdgcn_cvt_pk_fp8_f32(c, d, r, true); return (unsigned)r; }
template <bool NT = false>
__device__ __forceinline__ void conv_item8(const float* W, int K, int N, unsigned char* WT, int k0, int n0, int drow0, float scale, LAS float* scr, int lane) {
    { const int rr = lane >> 3, cq = lane & 7; f32x4 t[8];
#pragma unroll
      for (int i = 0; i < 8; ++i) { const f32x4* p_ = (const f32x4*)(W + (size_t)(k0 + 8 * i + rr) * N + n0 + 4 * cq); t[i] = NT ? __builtin_nontemporal_load(p_) : *p_; }
#pragma unroll
      for (int i = 0; i < 8; ++i) { LAS float* d = scr + (8 * i + rr) * 33 + 4 * cq; d[0] = t[i].x; d[1] = t[i].y; d[2] = t[i].z; d[3] = t[i].w; } }
    LDS_WAIT(); asm volatile("" ::: "memory");
    const int c = lane & 7;
#pragma unroll
    for (int j = 0; j < 4; ++j) { const int n = (lane >> 3) + 8 * j; const LAS float* s = scr + (8 * c) * 33 + n;
        u32x2 o; o.x = pk4_fp8(s[0 * 33] * scale, s[1 * 33] * scale, s[2 * 33] * scale, s[3 * 33] * scale); o.y = pk4_fp8(s[4 * 33] * scale, s[5 * 33] * scale, s[6 * 33] * scale, s[7 * 33] * scale);
        *(u32x2*)(WT + (size_t)(drow0 + n) * K + k0 + 8 * c) = o; }
    LDS_WAIT(); asm volatile("" ::: "memory");
}
constexpr float W13_SCALE = 64.0f, W2_SCALE = 32.0f;
constexpr int CI_IN = 32 * 368, CI_AO = 16 * 64, CI_CO = 8 * 64, CI_SO = 8 * 64, CI_O = 32 * 64, CI_E1 = 16 * 32 * 32, CI_E3 = CI_E1, CI_E2 = 16 * 16 * 64;
constexpr int CI_LAYER = CI_IN + CI_AO + CI_CO + CI_SO + CI_O + CI_E1 + CI_E3 + CI_E2;
constexpr int ADA_ITEMS = 2 * 16 * 48;

__device__ __forceinline__ void ada_item(const Frame& F, int it, LAS float* scr) {
    const int lane = F.lane;
    const int l = it / 768, r = it % 768, kc = r / 48, cg = r % 48;
    const float* c = F.in(I_C); const float* cc = F.in(I_CCTX);
    for (int q = lane; q < 640; q += 64) { const int v = q >> 7, rr = q & 127, k = kc * 128 + rr; const float cv = (v < 4) ? c[v * DM + k] : cc[k]; scr[q] = cv / (1.0f + expf(-cv)); }
    LDS_WAIT(); asm volatile("" ::: "memory");
    f32x4 acc[5];
#pragma unroll
    for (int v = 0; v < 5; ++v) acc[v] = (f32x4){0.f, 0.f, 0.f, 0.f};
    const float* wp = F.in(I_WADA) + (size_t)l * DM * 12288 + (size_t)(kc * 128) * 12288 + cg * 256 + lane * 4;
#pragma unroll 8
    for (int rr = 0; rr < 128; ++rr) { const f32x4 w = *(const f32x4*)(wp + (size_t)rr * 12288);
#pragma unroll
        for (int v = 0; v < 5; ++v) acc[v] += w * scr[v * 128 + rr]; }
#pragma unroll
    for (int v = 0; v < 5; ++v) *(f32x4*)(((float*)(F.ws + WS_ADAP)) + (size_t)((l * 16 + kc) * 5 + v) * 12288 + cg * 256 + lane * 4) = acc[v];
    LDS_WAIT(); asm volatile("" ::: "memory");
}

template <bool NT = false>
__device__ __forceinline__ void pa_conv(const Frame& F, int it, LAS float* scr, int lane);
__device__ __forceinline__ void phase_pa(const Frame& F0) {
    const Frame F = fresh(F0);
    LAS float* scr = (LAS float*)(F.lds + RING_OFF + F.wave * 16384);
    const int lane = F.lane;
    const int total = ADA_ITEMS + CI_IN + CI_AO + CI_CO + CI_SO;
    if (F.gw == 0) {
        for (int l = 0; l < NL; ++l) { float mq = fabsf(F.in(I_GQ)[l * 64 + lane]), mk = fabsf(F.in(I_GK)[l * 64 + lane]), mr = 0.f;
            for (int i = lane; i < NH * 15 * 31; i += 64) mr = fmaxf(mr, fabsf(F.in(I_RPB)[l * NH * 15 * 31 + i]));
            mq = wave_max(mq); mk = wave_max(mk); mr = wave_max(mr);
            if (lane == 0) ((float*)(F.ws + WS_MSH))[l] = 8.1f * mq * mk + mr; }
    }
    for (int it = F.gw; it < total; it += F.ngw) {
        if (it < ADA_ITEMS) { ada_item(F, it, scr); continue; }
        pa_conv<false>(F, it, scr, lane);
    }
}
template <bool NT>
__device__ __forceinline__ void pa_conv(const Frame& F, int it, LAS float* scr, int lane) {
    {
        int r = it - ADA_ITEMS; const int l = r / CI_LAYER; r -= l * CI_LAYER;
        if (r < CI_IN) { const int kb = r / 368, nb = r % 368; conv_item<NT>(F.in(I_WIN) + (size_t)l * DM * PW, DM, PW, ((bf16_t*)(F.ws + WS_WIN)) + (size_t)l * PW * DM, 64 * kb, 32 * nb, 32 * nb, scr, lane); return; } r -= CI_IN;
        if (r < CI_AO) { const int kb = r / 64, nb = r % 64; conv_item<NT>(F.in(I_WAO) + (size_t)l * AW * DM, AW, DM, ((bf16_t*)(F.ws + WS_WAO)) + (size_t)l * DM * AW, 64 * kb, 32 * nb, 32 * nb, scr, lane); return; } r -= CI_AO;
        if (r < CI_CO) { const int kb = r / 64, nb = r % 64; conv_item<NT>(F.in(I_WCO) + (size_t)l * CWD * DM, CWD, DM, ((bf16_t*)(F.ws + WS_WCO)) + (size_t)l * DM * CWD, 64 * kb, 32 * nb, 32 * nb, scr, lane); return; } r -= CI_CO;
        if (r < CI_SO) { const int kb = r / 64, nb = r % 64; conv_item<NT>(F.in(I_WSO) + (size_t)l * SWD * DM, SWD, DM, ((bf16_t*)(F.ws + WS_WSO)) + (size_t)l * DM * SWD, 64 * kb, 32 * nb, 32 * nb, scr, lane); return; } r -= CI_SO;
        if (r < CI_O) { const int kb = r / 64, nb = r % 64; conv_item<NT>(F.in(I_WO) + (size_t)l * DM * DM, DM, DM, ((bf16_t*)(F.ws + WS_WO)) + (size_t)l * DM * DM, 64 * kb, 32 * nb, 32 * nb, scr, lane); return; } r -= CI_O;
        if (r < CI_E1 + CI_E3) { const int w3 = r >= CI_E1; if (w3) r -= CI_E1; const int e = r / 1024, q = r % 1024, kb = q / 32, nb = q % 32, n0 = 32 * nb;
            conv_item8<NT>(F.in(w3 ? I_WE3 : I_WE1) + (size_t)(l * NE + e) * DM * FF, DM, FF, ((unsigned char*)(F.ws + WS_W13)) + (size_t)(l * NE + e) * 2048 * DM, 64 * kb, n0, (n0 >> 7) * 256 + (n0 & 127) + (w3 ? 128 : 0), W13_SCALE, scr, lane); return; } r -= CI_E1 + CI_E3;
        { const int e = r / 1024, q = r % 1024, kb = q / 64, nb = q % 64;
            conv_item8<NT>(F.in(I_WE2) + (size_t)(l * NE + e) * FF * DM, FF, DM, ((unsigned char*)(F.ws + WS_W2)) + (size_t)(l * NE + e) * DM * FF, 64 * kb, 32 * nb, 32 * nb, W2_SCALE, scr, lane); }
    }
}
constexpr int NSTREAM = 32;
__device__ __forceinline__ void pa_stream(const Frame& F0, int widx, int nw, int win) {
    const Frame F = fresh(F0);
    LAS float* scr = (LAS float*)(F.lds + RING_OFF + F.wave * 16384);
    const int lane = F.lane;
    constexpr int cO = CI_IN + CI_AO + CI_CO + CI_SO, cE1 = cO + CI_O, cE3 = cE1 + CI_E1, cE2 = cE3 + CI_E3, cB2 = cE2 + 3072;
    const int n = (win == 0) ? CI_E1 + CI_LAYER : (win == 1) ? CI_O + CI_E3 + 3072 : CI_LAYER - cB2;
    for (int j = widx; j < n; j += nw) {
        int ci;
        if (win == 0) ci = (j < CI_E1) ? cE1 + j : CI_LAYER + (j - CI_E1);
        else if (win == 1) ci = (j < CI_O) ? cO + j : cE3 + (j - CI_O);
        else ci = cB2 + j;
        pa_conv<true>(F, ADA_ITEMS + ci, scr, lane);
    }
}
__device__ __forceinline__ void phase_pa2(const Frame& F0) {
    const Frame F = fresh(F0);
    const int gt = F.bx * 512 + F.tid, nt = F.G * 512;
    for (int i = gt; i < 2 * 5 * 12288; i += nt) { const int l = i / 61440, r = i % 61440, v = r / 12288, n = r % 12288;
        float s = F.in(I_BADA)[l * 12288 + n];
#pragma unroll
        for (int kc = 0; kc < 16; ++kc) s += ((float*)(F.ws + WS_ADAP))[(size_t)((l * 16 + kc) * 5 + v) * 12288 + n];
        ((float*)(F.ws + WS_MOD))[i] = s; }
    for (int i = gt; i < 2 * 5 * DM; i += nt) { const int l = i / (5 * DM), r = i % (5 * DM), v = r / DM, c = r % DM, n = 4 * DM + c;
        float s = F.in(I_BADA)[l * 12288 + n];
#pragma unroll
        for (int kc = 0; kc < 16; ++kc) s += ((float*)(F.ws + WS_ADAP))[(size_t)((l * 16 + kc) * 5 + v) * 12288 + n];
        ((float*)(F.ws + WS_MA2))[i] = F.in(I_GN2)[l * DM + c] * (s + 1.0f); }
    for (int idx = gt; idx < NL * NH * 15 * 64; idx += nt) {
        const int dd = (idx & 63) - 16, ro = (idx >> 6) % 15, lh = (idx >> 6) / 15;
        ((float*)(F.ws + WS_TAB))[idx] = (dd >= 0 && dd < 31) ? (F.in(I_RPB)[(lh * 15 + ro) * 31 + dd] - ((const float*)(F.ws + WS_MSH))[lh >> 4]) * LOG2E : 0.f; }
    for (int i = gt; i < 1024; i += nt) { const int pos = i >> 4, f = i & 15; const float freq = 1.0f / powf(10000.0f, (float)f * (1.0f / 16.0f)); const float ang = (float)pos * freq;
        ((float*)(F.ws + WS_ROPE))[2 * i] = cosf(ang); ((float*)(F.ws + WS_ROPE))[2 * i + 1] = sinf(ang); }
}

__device__ __forceinline__ const float* xrow_ptr(const Frame& F, int lx, int row) {
    if (lx == 0) return (row < ML) ? F.in(I_X) + (size_t)row * DM : F.in(I_CTX) + (size_t)(row - ML) * DM;
    return F.out + (size_t)row * DM;
}
__device__ __forceinline__ void load_row_f32(const float* p, int lane, f32x4 (&v)[8]) {
#pragma unroll
    for (int j = 0; j < 4; ++j) { v[2 * j] = *(const f32x4*)(p + 8 * lane + 512 * j); v[2 * j + 1] = *(const f32x4*)(p + 8 * lane + 512 * j + 4); }
}
__device__ __forceinline__ void combine_rows2(const Frame& F, int lprev, const int (&row)[2], const bool (&ok)[2], f32x4 (&v)[2][8]) {
    const int lane = F.lane;
    f32x4 a[2][8]; int sl[2]; bool lat[2]; int bb[2];
#pragma unroll
    for (int u = 0; u < 2; ++u) { lat[u] = row[u] < ML; bb[u] = lat[u] ? (row[u] >> 12) : ((row[u] - ML) >> 8);
        if (ok[u]) { if (lprev == 0) load_row_f32(xrow_ptr(F, 0, row[u]), lane, v[u]);
            else { const bf16_t* xb = ((const bf16_t*)(F.ws + WS_X1)) + (size_t)row[u] * DM + 8 * lane;
#pragma unroll
                for (int j = 0; j < 4; ++j) { const u32x4 w = *(const u32x4*)(xb + 512 * j); v[u][2 * j] = (f32x4){bflo(w.x), bfhi(w.x), bflo(w.y), bfhi(w.y)}; v[u][2 * j + 1] = (f32x4){bflo(w.z), bfhi(w.z), bflo(w.w), bfhi(w.w)}; } }
            const bf16_t* dl = ((const bf16_t*)(F.ws + WS_XM)) + (size_t)row[u] * DM + 8 * lane;
#pragma unroll
            for (int j = 0; j < 4; ++j) { const u32x4 w = *(const u32x4*)(dl + 512 * j);
                v[u][2 * j] += (f32x4){bflo(w.x), bfhi(w.x), bflo(w.y), bfhi(w.y)}; v[u][2 * j + 1] += (f32x4){bflo(w.z), bfhi(w.z), bflo(w.w), bfhi(w.w)}; } }
        sl[u] = (ok[u] && lane < 16) ? ((const int*)(F.ws + WS_SLOT))[(size_t)row[u] * 16 + lane] : 0x7fffffff;
#pragma unroll
        for (int j = 0; j < 8; ++j) a[u][j] = (f32x4){0.f, 0.f, 0.f, 0.f}; }
    for (int e = 0; e < 16; ++e) {
#pragma unroll
        for (int u = 0; u < 2; ++u) {
            const int sv = __builtin_amdgcn_readlane(sl[u], e);
            if (sv < (lat[u] ? CAP_L : CAP_C)) {
                const int yr = lat[u] ? ((e * 4 + bb[u]) * 512 + sv) : (32768 + e * 256 + bb[u] * 32 + sv);
                const bf16_t* yp = ((bf16_t*)(F.ws + WS_Y)) + (size_t)yr * DM + 8 * lane;
#pragma unroll
                for (int j = 0; j < 4; ++j) { const u32x4 w = *(const u32x4*)(yp + 512 * j);
                    a[u][2 * j] += (f32x4){bflo(w.x), bfhi(w.x), bflo(w.y), bfhi(w.y)}; a[u][2 * j + 1] += (f32x4){bflo(w.z), bfhi(w.z), bflo(w.w), bfhi(w.w)}; }
            }
        }
    }
#pragma unroll
    for (int u = 0; u < 2; ++u) {
        const float* g2 = ((float*)(F.ws + WS_MOD)) + (size_t)(lprev * 5 + (lat[u] ? bb[u] : 4)) * 12288 + 5 * DM + 8 * lane;
#pragma unroll
        for (int j = 0; j < 4; ++j) { const f32x4 m0 = *(const f32x4*)(g2 + 512 * j), m1 = *(const f32x4*)(g2 + 512 * j + 4); v[u][2 * j] += m0 * a[u][2 * j]; v[u][2 * j + 1] += m1 * a[u][2 * j + 1]; } }
}
__device__ __forceinline__ void phase_norm1(const Frame& F0, int l) {
    const Frame F = fresh(F0);
    const int lane = F.lane;
    for (int r0 = F.gw; r0 < MT; r0 += 2 * F.ngw) {
        const int row[2] = {r0, r0 + F.ngw}; const bool ok[2] = {true, r0 + F.ngw < MT};
        f32x4 v[2][8];
        if (l == 0) {
#pragma unroll
            for (int u = 0; u < 2; ++u) if (ok[u]) { if (row[u] < ML) load_row_f32(F.in(I_X) + (size_t)row[u] * DM, lane, v[u]); else load_row_f32(F.in(I_CTX) + (size_t)(row[u] - ML) * DM, lane, v[u]); }
        } else {
            combine_rows2(F, l - 1, row, ok, v);
#pragma unroll
            for (int u = 0; u < 2; ++u) if (ok[u] && row[u] < ML) {
#pragma unroll
                for (int j = 0; j < 4; ++j) { u32x4 o; o.x = pk2(v[u][2 * j].x, v[u][2 * j].y); o.y = pk2(v[u][2 * j].z, v[u][2 * j].w); o.z = pk2(v[u][2 * j + 1].x, v[u][2 * j + 1].y); o.w = pk2(v[u][2 * j + 1].z, v[u][2 * j + 1].w);
                    *(u32x4*)(((bf16_t*)(F.ws + WS_X1)) + (size_t)row[u] * DM + 8 * lane + 512 * j) = o; } }
        }
#pragma unroll
        for (int u = 0; u < 2; ++u) if (ok[u]) {
            const int bs = row[u] < ML ? (row[u] >> 12) : 4;
            float ss = 0.f;
#pragma unroll
            for (int j = 0; j < 8; ++j) ss += (v[u][j].x * v[u][j].x + v[u][j].y * v[u][j].y) + (v[u][j].z * v[u][j].z + v[u][j].w * v[u][j].w);
            const float rinv = 1.0f / sqrtf(wave_sum(ss) * (1.0f / DM) + EPS);
            const float* g1 = F.in(I_GN1) + l * DM + 8 * lane; const float* md = ((float*)(F.ws + WS_MOD)) + (size_t)(l * 5 + bs) * 12288 + 8 * lane;
#pragma unroll
            for (int j = 0; j < 4; ++j) {
                const f32x4 ga = *(const f32x4*)(g1 + 512 * j), gb = *(const f32x4*)(g1 + 512 * j + 4);
                const f32x4 sha = *(const f32x4*)(md + 512 * j), shb = *(const f32x4*)(md + 512 * j + 4);
                const f32x4 sca = *(const f32x4*)(md + DM + 512 * j), scb = *(const f32x4*)(md + DM + 512 * j + 4);
                const f32x4 ha = (v[u][2 * j] * rinv * ga) * (sca + 1.0f) + sha, hb = (v[u][2 * j + 1] * rinv * gb) * (scb + 1.0f) + shb;
                u32x4 o; o.x = pk2(ha.x, ha.y); o.y = pk2(ha.z, ha.w); o.z = pk2(hb.x, hb.y); o.w = pk2(hb.z, hb.w);
                *(u32x4*)(((bf16_t*)(F.ws + WS_H)) + (size_t)row[u] * DM + 8 * lane + 512 * j) = o; }
        }
    }
}
__device__ __forceinline__ void phase_final(const Frame& F0) {
    const Frame F = fresh(F0);
    const int lane = F.lane;
    for (int r0 = F.gw; r0 < ML; r0 += 2 * F.ngw) {
        const int row[2] = {r0, r0 + F.ngw}; const bool ok[2] = {true, r0 + F.ngw < ML};
        f32x4 v[2][8]; combine_rows2(F, NL - 1, row, ok, v);
#pragma unroll
        for (int u = 0; u < 2; ++u) if (ok[u]) {
#pragma unroll
            for (int j = 0; j < 4; ++j) { *(f32x4*)(F.out + (size_t)row[u] * DM + 8 * lane + 512 * j) = v[u][2 * j]; *(f32x4*)(F.out + (size_t)row[u] * DM + 8 * lane + 512 * j + 4) = v[u][2 * j + 1]; } }
    }
}

__device__ __forceinline__ unsigned char* gate_chunk(unsigned char* Pbytes, int br, int pm, int pn, int frag) {
    const unsigned c = (unsigned)(((br * 68 + pm) * 8 + pn) * 16 + frag), row = c / 3u, slot = c - row * 3u;
    return Pbytes + (size_t)row * (PW * 2) + GATE_COL * 2 + slot * 4096u;
}
struct EpiProj {
    static constexpr bool PERM = true;
    bf16_t* O; const float* bias;
    __device__ __forceinline__ void operator()(const f32x4 (&acc)[2][2][4][2], const pg8::Unit& u, int wr, int wc, int fr, int fq) const {
        const int row0 = u.pm * 256 + wr * 64 + fr, col0 = u.pn * 256 + wc * 32 + 8 * fq; const bool sg = u.pn >= (GATE_COL / 256);
        f32x4 bv[2][2];
#pragma unroll
        for (int bj = 0; bj < 2; ++bj)
#pragma unroll
            for (int n = 0; n < 2; ++n) { bv[bj][n] = *(const f32x4*)(bias + col0 + bj * 128 + 4 * n); if (sg) bv[bj][n] *= -1.4426950408889634f; }
#pragma unroll
        for (int ai = 0; ai < 2; ++ai)
#pragma unroll
            for (int m = 0; m < 4; ++m) { bf16_t* rowp = O + (size_t)(row0 + ai * 128 + m * 16) * PW + col0;
#pragma unroll
                for (int bj = 0; bj < 2; ++bj) { f32x4 v0 = acc[ai][bj][m][0] + bv[bj][0], v1 = acc[ai][bj][m][1] + bv[bj][1];
                    if (sg) {
                        u32x2 q; q.x = pk4_gate(sig2_(v0.x), sig2_(v0.y), sig2_(v0.z), sig2_(v0.w)); q.y = pk4_gate(sig2_(v1.x), sig2_(v1.y), sig2_(v1.z), sig2_(v1.w));
                        *(u32x2*)(gate_chunk((unsigned char*)O, (u.pn - GATE_COL / 256) >> 3, u.pm, (u.pn - GATE_COL / 256) & 7, (ai * 4 + m) * 2 + bj) + ((wr * 4 + wc) * 64 + fq * 16 + fr) * 8) = q; continue; }
                    u32x4 w; w.x = cvt_pk_bf16(v0[0], v0[1]); w.y = cvt_pk_bf16(v0[2], v0[3]); w.z = cvt_pk_bf16(v1[0], v1[1]); w.w = cvt_pk_bf16(v1[2], v1[3]);
                    *(u32x4*)(rowp + bj * 128) = w; } }
    }
};
template <int MODE> struct EpiGate {
    static constexpr bool PERM = true;
    bf16_t* O; unsigned char* Pbytes; int br;
    u32x4* Pp;
    __device__ __forceinline__ void operator()(const f32x4 (&acc)[2][2][4][2], const pg8::Unit& u, int wr, int wc, int fr, int fq) const {
        const int row0 = u.pm * 256 + wr * 64 + fr, col0 = u.pn * 256 + wc * 32 + 8 * fq;
        const int tidx = (wr * 4 + wc) * 64 + fq * 16 + fr;
        u32x4* pp = Pp + (size_t)(u.pm * 8 + u.pn) * (16 * 512) + tidx;
        u32x2 gw[2][4][2];
#pragma unroll
        for (int ai = 0; ai < 2; ++ai)
#pragma unroll
            for (int m = 0; m < 4; ++m)
#pragma unroll
                for (int bj = 0; bj < 2; ++bj) gw[ai][m][bj] = *(const u32x2*)(gate_chunk(Pbytes, br, u.pm, u.pn, (ai * 4 + m) * 2 + bj) + tidx * 8);
#pragma unroll
        for (int ai = 0; ai < 2; ++ai) {
            u32x4 pw[4][2];
            if (MODE > 0) {
#pragma unroll
                for (int m = 0; m < 4; ++m)
#pragma unroll
                    for (int bj = 0; bj < 2; ++bj) pw[m][bj] = pp[((ai * 4 + m) * 2 + bj) * 512];
            }
#pragma unroll
            for (int m = 0; m < 4; ++m) { const size_t row = (size_t)(row0 + ai * 128 + m * 16);
#pragma unroll
                for (int bj = 0; bj < 2; ++bj) {
                    f32x4 v0 = acc[ai][bj][m][0] * gate4(gw[ai][m][bj].x), v1 = acc[ai][bj][m][1] * gate4(gw[ai][m][bj].y);
                    if (MODE > 0) { const u32x4 p = pw[m][bj]; v0 = v0 * (1.0f / 255.0f) + (f32x4){bflo(p.x), bfhi(p.x), bflo(p.y), bfhi(p.y)}; v1 = v1 * (1.0f / 255.0f) + (f32x4){bflo(p.z), bfhi(p.z), bflo(p.w), bfhi(p.w)}; }
                    else { v0 *= (1.0f / 255.0f); v1 *= (1.0f / 255.0f); }
                    u32x4 w; w.x = cvt_pk_bf16(v0[0], v0[1]); w.y = cvt_pk_bf16(v0[2], v0[3]); w.z = cvt_pk_bf16(v1[0], v1[1]); w.w = cvt_pk_bf16(v1[2], v1[3]);
                    if (MODE < 2) pp[((ai * 4 + m) * 2 + bj) * 512] = w; else *(u32x4*)(O + row * DM + col0 + bj * 128) = w; } }
        }
    }
};
struct EpiDelta {
    static constexpr bool PERM = true;
    bf16_t* O; const float* mod;
    __device__ __forceinline__ void operator()(const f32x4 (&acc)[2][2][4][2], const pg8::Unit& u, int wr, int wc, int fr, int fq) const {
        const int row0 = u.pm * 256 + wr * 64 + fr, col0 = u.pn * 256 + wc * 32 + 8 * fq;
        const int bs = (u.pm < 64) ? (u.pm >> 4) : 4;
        f32x4 mv[2][2];
#pragma unroll
        for (int bj = 0; bj < 2; ++bj)
#pragma unroll
            for (int n = 0; n < 2; ++n) mv[bj][n] = *(const f32x4*)(mod + (size_t)bs * 12288 + col0 + bj * 128 + 4 * n);
#pragma unroll
        for (int ai = 0; ai < 2; ++ai)
#pragma unroll
            for (int m = 0; m < 4; ++m) { bf16_t* rowp = O + (size_t)(row0 + ai * 128 + m * 16) * DM + col0;
#pragma unroll
                for (int bj = 0; bj < 2; ++bj) { const f32x4 v0 = acc[ai][bj][m][0] * mv[bj][0], v1 = acc[ai][bj][m][1] * mv[bj][1];
                    u32x4 w; w.x = cvt_pk_bf16(v0[0], v0[1]); w.y = cvt_pk_bf16(v0[2], v0[3]); w.z = cvt_pk_bf16(v1[0], v1[1]); w.w = cvt_pk_bf16(v1[2], v1[3]);
                    *(u32x4*)(rowp + bj * 128) = w; } }
    }
};
struct EpiSwiglu {
    static constexpr bool PERM = true;
    unsigned char* O;
    __device__ __forceinline__ void operator()(const f32x4 (&acc)[2][2][4][2], const pg8::Unit& u, int wr, int wc, int fr, int fq) const {
        const int row0 = u.pm * 256 + wr * 64 + fr, col0 = u.pn * 128 + wc * 32 + 8 * fq; constexpr float SC = 1.0f / W13_SCALE;
#pragma unroll
        for (int ai = 0; ai < 2; ++ai)
#pragma unroll
            for (int mp = 0; mp < 2; ++mp) { u32x2 w[2];
#pragma unroll
                for (int mm = 0; mm < 2; ++mm) { const int m = 2 * mp + mm; float h[8];
#pragma unroll
                    for (int n = 0; n < 2; ++n)
#pragma unroll
                        for (int q = 0; q < 4; ++q) { const float a = acc[ai][0][m][n][q] * SC, b3 = acc[ai][1][m][n][q] * SC; h[4 * n + q] = a * sigmoidf_(a) * b3; }
                    w[mm].x = pk4_fp8(h[0], h[1], h[2], h[3]); w[mm].y = pk4_fp8(h[4], h[5], h[6], h[7]); }
                { auto r = __builtin_amdgcn_permlane16_swap(w[0].x, w[1].x, false, false); w[0].x = r[0]; w[1].x = r[1]; }
                { auto r = __builtin_amdgcn_permlane16_swap(w[0].y, w[1].y, false, false); w[0].y = r[0]; w[1].y = r[1]; }
                *(u32x4*)(O + (size_t)(row0 + ai * 128 + (2 * mp + (fq & 1)) * 16) * FF + col0 - 8 * (fq & 1)) = (u32x4){w[0].x, w[0].y, w[1].x, w[1].y}; }
    }
};
struct EpiY {
    static constexpr bool PERM = true;
    bf16_t* O; const float* gate;
    __device__ __forceinline__ void operator()(const f32x4 (&acc)[2][2][4][2], const pg8::Unit& u, int wr, int wc, int fr, int fq) const {
        const int row0 = u.pm * 256 + wr * 64 + fr, col0 = u.pn * 256 + wc * 32 + 8 * fq;
        float gts[2][4];
#pragma unroll
        for (int ai = 0; ai < 2; ++ai)
#pragma unroll
            for (int m = 0; m < 4; ++m) gts[ai][m] = gate[row0 + ai * 128 + m * 16];
#pragma unroll
        for (int ai = 0; ai < 2; ++ai)
#pragma unroll
            for (int m = 0; m < 4; ++m) { const int row = row0 + ai * 128 + m * 16; const float gt = gts[ai][m] * (1.0f / W2_SCALE);
#pragma unroll
                for (int bj = 0; bj < 2; ++bj) { const f32x4 v0 = acc[ai][bj][m][0] * gt, v1 = acc[ai][bj][m][1] * gt;
                    u32x4 w; w.x = cvt_pk_bf16(v0[0], v0[1]); w.y = cvt_pk_bf16(v0[2], v0[3]); w.z = cvt_pk_bf16(v1[0], v1[1]); w.w = cvt_pk_bf16(v1[2], v1[3]);
                    *(u32x4*)(O + (size_t)row * DM + col0 + bj * 128) = w; } }
    }
};

__device__ __forceinline__ void load64bf(const bf16_t* p, float (&x)[64]) {
#pragma unroll
    for (int i = 0; i < 8; ++i) { const u32x4 w = *(const u32x4*)(p + 8 * i);
        x[8 * i + 0] = bflo(w.x); x[8 * i + 1] = bfhi(w.x); x[8 * i + 2] = bflo(w.y); x[8 * i + 3] = bfhi(w.y); x[8 * i + 4] = bflo(w.z); x[8 * i + 5] = bfhi(w.z); x[8 * i + 6] = bflo(w.w); x[8 * i + 7] = bfhi(w.w); }
}
__device__ __forceinline__ void store64bf(bf16_t* p, const float (&x)[64]) {
#pragma unroll
    for (int i = 0; i < 8; ++i) { u32x4 w; w.x = pk2(x[8 * i], x[8 * i + 1]); w.y = pk2(x[8 * i + 2], x[8 * i + 3]); w.z = pk2(x[8 * i + 4], x[8 * i + 5]); w.w = pk2(x[8 * i + 6], x[8 * i + 7]); *(u32x4*)(p + 8 * i) = w; }
}
__device__ __forceinline__ void headnorm(float (&x)[64], const float* g) {
    float ss = 0.f;
#pragma unroll
    for (int i = 0; i < 64; ++i) ss += x[i] * x[i];
    const float rinv = 1.0f / sqrtf(ss * (1.0f / 64.0f) + EPS);
#pragma unroll
    for (int i = 0; i < 64; ++i) x[i] = x[i] * rinv * g[i];
}
__device__ __forceinline__ void rope64(float (&x)[64], const float* rrow, const float* rcol) {
#pragma unroll
    for (int i = 0; i < 16; ++i) { const float c = rrow[2 * i], s = rrow[2 * i + 1]; const float a = x[i], b = x[i + 16]; x[i] = a * c - b * s; x[i + 16] = b * c + a * s; }
#pragma unroll
    for (int i = 0; i < 16; ++i) { const float c = rcol[2 * i], s = rcol[2 * i + 1]; const float a = x[32 + i], b = x[48 + i]; x[32 + i] = a * c - b * s; x[48 + i] = b * c + a * s; }
}
template <bool PLAIN, bool ROT>
__device__ __forceinline__ void prep_head(const u32x4 (&w)[8], const f32x4 g0, const f32x4 g1, bf16_t* plain_dst, bf16_t* rot_dst, const float* rope, int rowpos, int rsub, int c) {
#pragma unroll
    for (int j = 0; j < 8; ++j) {
        float x[8] = {bflo(w[j].x), bfhi(w[j].x), bflo(w[j].y), bfhi(w[j].y), bflo(w[j].z), bfhi(w[j].z), bflo(w[j].w), bfhi(w[j].w)};
        float ss = 0.f;
#pragma unroll
        for (int e = 0; e < 8; ++e) ss += x[e] * x[e];
        ss += __shfl_xor(ss, 1); ss += __shfl_xor(ss, 2); ss += __shfl_xor(ss, 4);
        const float rinv = 1.0f / sqrtf(ss * (1.0f / 64.0f) + EPS);
        x[0] *= rinv * g0.x; x[1] *= rinv * g0.y; x[2] *= rinv * g0.z; x[3] *= rinv * g0.w; x[4] *= rinv * g1.x; x[5] *= rinv * g1.y; x[6] *= rinv * g1.z; x[7] *= rinv * g1.w;
        const size_t o = (size_t)(8 * j) * 64;
        if constexpr (PLAIN) { u32x4 p; p.x = pk2(x[0], x[1]); p.y = pk2(x[2], x[3]); p.z = pk2(x[4], x[5]); p.w = pk2(x[6], x[7]); *(GAS u32x4*)(plain_dst + o) = p; }
        if constexpr (ROT) {
            const int pos = (c < 4) ? rowpos : (8 * j + rsub);
            const float* rp = rope + pos * 32 + 16 * (c & 1);
            const f32x4 t0 = *(const GAS f32x4*)rp, t1 = *(const GAS f32x4*)(rp + 4), t2 = *(const GAS f32x4*)(rp + 8), t3 = *(const GAS f32x4*)(rp + 12);
            const float cs[8] = {t0.x, t0.z, t1.x, t1.z, t2.x, t2.z, t3.x, t3.z}, sn[8] = {t0.y, t0.w, t1.y, t1.w, t2.y, t2.w, t3.y, t3.w};
            const float sg = (c & 2) ? 1.0f : -1.0f;
            float y[8];
#pragma unroll
            for (int e = 0; e < 8; ++e) { const float xp = __shfl_xor(x[e], 2); y[e] = x[e] * cs[e] + sg * xp * sn[e]; }
            u32x4 p; p.x = pk2(y[0], y[1]); p.y = pk2(y[2], y[3]); p.z = pk2(y[4], y[5]); p.w = pk2(y[6], y[7]); *(GAS u32x4*)(rot_dst + o) = p; }
    }
}
__device__ __forceinline__ void phase_prep(const Frame& F0, int l) {
    const Frame Fp = fresh(F0); const Frame& F = Fp;
    const int lane = F.lane, rsub = lane >> 3, c = lane & 7;
    const float* gqp = F.in(I_GQ) + l * 64 + 8 * c; const float* gkp = F.in(I_GK) + l * 64 + 8 * c;
    const f32x4 gq0 = *(const f32x4*)gqp, gq1 = *(const f32x4*)(gqp + 4), gk0 = *(const f32x4*)gkp, gk1 = *(const f32x4*)(gkp + 4);
    const float* rope = (const float*)(F.ws + WS_ROPE);
    for (int it = F.gw; it < (MT / 64) * NH; it += F.ngw) {
        Frame F = Fp; { unsigned long long w_ = (unsigned long long)Fp.ws; asm volatile("" : "+s"(w_)); F.ws = (unsigned char*)w_; }
        const int ch = it >> 4, h = it & 15, r0 = ch * 64; const bool lat = r0 < ML;
        const int b = lat ? (r0 >> 12) : ((r0 - ML) >> 8), t0 = lat ? (r0 & 4095) : ((r0 - ML) & 255);
        const size_t hb = (size_t)(b * NH + h);
        const bool doq = !lat && l == 0;
        const bf16_t* pbase = ((const bf16_t*)(F.ws + WS_P)) + (size_t)(r0 + rsub) * PW + h * 64 + 8 * c;
        u32x4 qw[8], kw[8];
#pragma unroll
        for (int j = 0; j < 8; ++j) { const bf16_t* p = pbase + (size_t)(8 * j) * PW; qw[j] = doq ? *(const GAS u32x4*)p : (u32x4){0u, 0u, 0u, 0u}; kw[j] = *(const GAS u32x4*)(p + AW); }
        if (lat) {
            const size_t tb = (hb * SEQ + t0 + rsub) * 64 + 8 * c;
            prep_head<false, true>(kw, gk0, gk1, nullptr, ((bf16_t*)(F.ws + WS_KR)) + tb, rope, t0 >> 6, rsub, c);
        } else {
            const size_t tb = (hb * CTXL + t0 + rsub) * 64 + 8 * c;
            if (doq) prep_head<true, false>(qw, gq0, gq1, ((bf16_t*)(F.ws + WS_QC)) + tb, nullptr, rope, 0, rsub, c);
            prep_head<true, false>(kw, gk0, gk1, ((bf16_t*)(F.ws + WS_KC)) + tb, nullptr, rope, 0, rsub, c);
        }
    }
}

__device__ __forceinline__ void phase_glu(const Frame& F0, int l, int nrows) {
    const Frame F = fresh(F0);
    const int gt = F.bx * 512 + F.tid, nt = F.G * 512;
    for (int it = gt; it < nrows * 64; it += 2 * nt) {
        u32x4 aw[2], gw[2]; bool ok[2]; int row[2], c0[2];
#pragma unroll
        for (int u = 0; u < 2; ++u) { const int i2 = it + u * nt; ok[u] = i2 < nrows * 64; row[u] = i2 >> 6; c0[u] = (i2 & 63) * 8;
            if (ok[u]) { aw[u] = *(const GAS u32x4*)(((const bf16_t*)(F.ws + WS_P)) + (size_t)row[u] * PW + 3072 + c0[u]); gw[u] = *(const GAS u32x4*)(((const bf16_t*)(F.ws + WS_P)) + (size_t)row[u] * PW + 3584 + c0[u]); } }
#pragma unroll
        for (int u = 0; u < 2; ++u) if (ok[u]) {
            u32x4 o; o.x = pk2(bflo(aw[u].x) * sigmoidf_(bflo(gw[u].x)), bfhi(aw[u].x) * sigmoidf_(bfhi(gw[u].x))); o.y = pk2(bflo(aw[u].y) * sigmoidf_(bflo(gw[u].y)), bfhi(aw[u].y) * sigmoidf_(bfhi(gw[u].y)));
            o.z = pk2(bflo(aw[u].z) * sigmoidf_(bflo(gw[u].z)), bfhi(aw[u].z) * sigmoidf_(bfhi(gw[u].z))); o.w = pk2(bflo(aw[u].w) * sigmoidf_(bflo(gw[u].w)), bfhi(aw[u].w) * sigmoidf_(bfhi(gw[u].w)));
            *(GAS u32x4*)(((bf16_t*)(F.ws + WS_U)) + (size_t)row[u] * CWD + c0[u]) = o; }
    }
}
__device__ __forceinline__ void phase_conv(const Frame& F0, int l, int nrows) {
    const Frame F = fresh(F0);
    const int lane = F.lane, c0 = 8 * lane;
    LAS float* wl = (LAS float*)(F.lds + RING_OFF);
    { const float* dw = F.in(I_CDW) + (size_t)l * 31 * CWD; float tv[31];
#pragma unroll
      for (int i = 0; i < 31; ++i) tv[i] = ((const GAS float*)dw)[F.tid + 512 * i];
#pragma unroll
      for (int i = 0; i < 31; ++i) wl[512 * i + ((F.tid >> 2) & 1) * 256 + (F.tid >> 3) * 4 + (F.tid & 3)] = tv[i]; }
    __syncthreads();
    const float* dbp = F.in(I_CDB) + l * CWD + c0; const float* lgp = F.in(I_CLG) + l * CWD + c0; const float* lbp = F.in(I_CLB) + l * CWD + c0;
    const f32x4 db0 = *(const f32x4*)dbp, db1 = *(const f32x4*)(dbp + 4), lg0 = *(const f32x4*)lgp, lg1 = *(const f32x4*)(lgp + 4), lb0 = *(const f32x4*)lbp, lb1 = *(const f32x4*)(lbp + 4);
    for (int un = F.gw; un < nrows / 4; un += F.ngw) {
        const int r0 = 4 * un; const bool lat = r0 < ML; const int sbeg = lat ? (r0 & ~4095) : (ML + ((r0 - ML) & ~255)), send = sbeg + (lat ? SEQ : CTXL);
        const bf16_t* ub = ((const bf16_t*)(F.ws + WS_U)) + c0;
        f32x4 acc[4][2];
#pragma unroll
        for (int t = 0; t < 4; ++t) { acc[t][0] = db0; acc[t][1] = db1; }
        f32x4 w[4][2];
#pragma unroll
        for (int i = 0; i < 34; ++i) {
#pragma unroll
            for (int j = 3; j > 0; --j) { w[j][0] = w[j - 1][0]; w[j][1] = w[j - 1][1]; }
            if (i < 31) { w[0][0] = *(const LAS f32x4*)(wl + i * CWD + 4 * lane); w[0][1] = *(const LAS f32x4*)(wl + i * CWD + 256 + 4 * lane); }
            const int r = r0 - 15 + i;
            if (r >= sbeg && r < send) {
                const u32x4 xw = *(const GAS u32x4*)(ub + (size_t)r * CWD);
                const f32x4 x0 = (f32x4){bflo(xw.x), bfhi(xw.x), bflo(xw.y), bfhi(xw.y)}, x1 = (f32x4){bflo(xw.z), bfhi(xw.z), bflo(xw.w), bfhi(xw.w)};
#pragma unroll
                for (int t = 0; t < 4; ++t) { const int k = i - t; if (k >= 0 && k < 31) { acc[t][0] += w[t][0] * x0; acc[t][1] += w[t][1] * x1; } }
            }
            if ((i & 7) == 7) asm volatile("" ::: "memory");
        }
#pragma unroll
        for (int t = 0; t < 4; ++t) {
            float s = (acc[t][0].x + acc[t][0].y) + (acc[t][0].z + acc[t][0].w) + (acc[t][1].x + acc[t][1].y) + (acc[t][1].z + acc[t][1].w);
            const float mean = wave_sum(s) * (1.0f / 512.0f);
            const f32x4 d0 = acc[t][0] - mean, d1 = acc[t][1] - mean;
            float s2 = (d0.x * d0.x + d0.y * d0.y) + (d0.z * d0.z + d0.w * d0.w) + (d1.x * d1.x + d1.y * d1.y) + (d1.z * d1.z + d1.w * d1.w);
            const float rstd = 1.0f / sqrtf(wave_sum(s2) * (1.0f / 512.0f) + EPS);
            const f32x4 y0 = d0 * rstd * lg0 + lb0, y1 = d1 * rstd * lg1 + lb1;
            u32x4 o; o.x = pk2(y0.x * sigmoidf_(y0.x), y0.y * sigmoidf_(y0.y)); o.y = pk2(y0.z * sigmoidf_(y0.z), y0.w * sigmoidf_(y0.w)); o.z = pk2(y1.x * sigmoidf_(y1.x), y1.y * sigmoidf_(y1.y)); o.w = pk2(y1.z * sigmoidf_(y1.z), y1.w * sigmoidf_(y1.w));
            *(GAS u32x4*)(((bf16_t*)(F.ws + WS_CONV)) + (size_t)(r0 + t) * CWD + c0) = o;
        }
    }
    __syncthreads();
}
__device__ __forceinline__ void phase_shortconv(const Frame& F0, int l, int nrows) {
    const Frame F = fresh(F0);
    const int gt = F.bx * 512 + F.tid, nt = F.G * 512;
    const float* sw = F.in(I_SCW) + (size_t)l * 3 * SWD;
    for (int it = gt; it < nrows * 64; it += nt) {
        const int row = it >> 6, c0 = (it & 63) * 8; const bool lat = row < ML; const int sbeg = lat ? (row & ~4095) : (ML + ((row - ML) & ~255)), send = sbeg + (lat ? SEQ : CTXL);
        float acc[8];
#pragma unroll
        for (int q = 0; q < 8; ++q) acc[q] = 0.f;
#pragma unroll
        for (int k = 0; k < 3; ++k) { const int r = row + k - 1;
            if (r >= sbeg && r < send) { const u32x4 cw = *(const u32x4*)(((bf16_t*)(F.ws + WS_P)) + (size_t)r * PW + 4608 + c0), xw = *(const u32x4*)(((bf16_t*)(F.ws + WS_P)) + (size_t)r * PW + 5120 + c0);
                const f32x4 w0 = *(const f32x4*)(sw + k * SWD + c0), w1 = *(const f32x4*)(sw + k * SWD + c0 + 4);
                acc[0] += w0.x * bflo(cw.x) * bflo(xw.x); acc[1] += w0.y * bfhi(cw.x) * bfhi(xw.x); acc[2] += w0.z * bflo(cw.y) * bflo(xw.y); acc[3] += w0.w * bfhi(cw.y) * bfhi(xw.y);
                acc[4] += w1.x * bflo(cw.z) * bflo(xw.z); acc[5] += w1.y * bfhi(cw.z) * bfhi(xw.z); acc[6] += w1.z * bflo(cw.w) * bflo(xw.w); acc[7] += w1.w * bfhi(cw.w) * bfhi(xw.w); } }
        const u32x4 bw = *(const u32x4*)(((bf16_t*)(F.ws + WS_P)) + (size_t)row * PW + 4096 + c0);
        u32x4 o; o.x = pk2(acc[0] * bflo(bw.x), acc[1] * bfhi(bw.x)); o.y = pk2(acc[2] * bflo(bw.y), acc[3] * bfhi(bw.y)); o.z = pk2(acc[4] * bflo(bw.z), acc[5] * bfhi(bw.z)); o.w = pk2(acc[6] * bflo(bw.w), acc[7] * bfhi(bw.w));
        *(u32x4*)(((bf16_t*)(F.ws + WS_SC)) + (size_t)row * SWD + c0) = o;
    }
}

__device__ __forceinline__ void phase_glu_sc(const Frame& F0, int l, int nrows) {
    const Frame F = fresh(F0);
    const int gt = F.bx * 512 + F.tid, nt = F.G * 512;
    const int c0 = (gt & 63) * 8;
    const float* sw = F.in(I_SCW) + (size_t)l * 3 * SWD + c0;
    f32x4 w0[3], w1[3];
#pragma unroll
    for (int k = 0; k < 3; ++k) { w0[k] = *(const f32x4*)(sw + k * SWD); w1[k] = *(const f32x4*)(sw + k * SWD + 4); }
    for (int it = gt; it < nrows * 64; it += nt) {
        const int row = it >> 6; const bool lat = row < ML; const int sbeg = lat ? (row & ~4095) : (ML + ((row - ML) & ~255)), send = sbeg + (lat ? SEQ : CTXL);
        const bf16_t* pr = ((const bf16_t*)(F.ws + WS_P)) + (size_t)row * PW + c0;
        const u32x4 aw = *(const GAS u32x4*)(pr + 3072), gw = *(const GAS u32x4*)(pr + 3584), bw = *(const GAS u32x4*)(pr + 4096);
        u32x4 cw[3], xw[3];
#pragma unroll
        for (int k = 0; k < 3; ++k) { const int r = row + k - 1; const bool ok = r >= sbeg && r < send; const bf16_t* p = pr + (ptrdiff_t)(k - 1) * PW;
            cw[k] = ok ? *(const GAS u32x4*)(p + 4608) : (u32x4){0u, 0u, 0u, 0u}; xw[k] = ok ? *(const GAS u32x4*)(p + 5120) : (u32x4){0u, 0u, 0u, 0u}; }
        { u32x4 o; o.x = pk2(bflo(aw.x) * sigmoidf_(bflo(gw.x)), bfhi(aw.x) * sigmoidf_(bfhi(gw.x))); o.y = pk2(bflo(aw.y) * sigmoidf_(bflo(gw.y)), bfhi(aw.y) * sigmoidf_(bfhi(gw.y)));
          o.z = pk2(bflo(aw.z) * sigmoidf_(bflo(gw.z)), bfhi(aw.z) * sigmoidf_(bfhi(gw.z))); o.w = pk2(bflo(aw.w) * sigmoidf_(bflo(gw.w)), bfhi(aw.w) * sigmoidf_(bfhi(gw.w)));
          *(GAS u32x4*)(((bf16_t*)(F.ws + WS_U)) + (size_t)row * CWD + c0) = o; }
        float acc[8];
#pragma unroll
        for (int q = 0; q < 8; ++q) acc[q] = 0.f;
#pragma unroll
        for (int k = 0; k < 3; ++k) {
            acc[0] += w0[k].x * bflo(cw[k].x) * bflo(xw[k].x); acc[1] += w0[k].y * bfhi(cw[k].x) * bfhi(xw[k].x); acc[2] += w0[k].z * bflo(cw[k].y) * bflo(xw[k].y); acc[3] += w0[k].w * bfhi(cw[k].y) * bfhi(xw[k].y);
            acc[4] += w1[k].x * bflo(cw[k].z) * bflo(xw[k].z); acc[5] += w1[k].y * bfhi(cw[k].z) * bfhi(xw[k].z); acc[6] += w1[k].z * bflo(cw[k].w) * bflo(xw[k].w); acc[7] += w1[k].w * bfhi(cw[k].w) * bfhi(xw[k].w); }
        u32x4 o; o.x = pk2(acc[0] * bflo(bw.x), acc[1] * bfhi(bw.x)); o.y = pk2(acc[2] * bflo(bw.y), acc[3] * bfhi(bw.y)); o.z = pk2(acc[4] * bflo(bw.z), acc[5] * bfhi(bw.z)); o.w = pk2(acc[6] * bflo(bw.w), acc[7] * bfhi(bw.w));
        *(GAS u32x4*)(((bf16_t*)(F.ws + WS_SC)) + (size_t)row * SWD + c0) = o;
    }
}

using pg8::bf16x8;
typedef __bf16 bf16x2_t __attribute__((ext_vector_type(2)));
__device__ __forceinline__ unsigned cvtpk_s(float lo, float hi) { f32x2 v = {lo, hi}; bf16x2_t b = __builtin_convertvector(v, bf16x2_t); return __builtin_bit_cast(unsigned, b); }
struct KF { bf16x8 k[2][2]; };
struct VF { bf16x8 v[4]; };
__device__ __forceinline__ void attn_step(const KF& fk, const VF& fv, const bf16x8 (&q)[2], f32x4 (&o)[4], float& ls, const f32x4 t0, const f32x4 t1) {
    constexpr float C = 0.125f * LOG2E;
    f32x4 s0 = (f32x4){0.f, 0.f, 0.f, 0.f}, s1 = (f32x4){0.f, 0.f, 0.f, 0.f};
    s0 = __builtin_amdgcn_mfma_f32_16x16x32_bf16(fk.k[0][0], q[0], s0, 0, 0, 0); s0 = __builtin_amdgcn_mfma_f32_16x16x32_bf16(fk.k[0][1], q[1], s0, 0, 0, 0);
    s1 = __builtin_amdgcn_mfma_f32_16x16x32_bf16(fk.k[1][0], q[0], s1, 0, 0, 0); s1 = __builtin_amdgcn_mfma_f32_16x16x32_bf16(fk.k[1][1], q[1], s1, 0, 0, 0);
    float p[8];
#pragma unroll
    for (int e = 0; e < 4; ++e) { p[e] = __builtin_amdgcn_exp2f(s0[e] * C + t0[e]); p[4 + e] = __builtin_amdgcn_exp2f(s1[e] * C + t1[e]); }
    ls += ((p[0] + p[1]) + (p[2] + p[3])) + ((p[4] + p[5]) + (p[6] + p[7]));
    const bf16x8 pb = __builtin_bit_cast(bf16x8, (u32x4){cvtpk_s(p[0], p[1]), cvtpk_s(p[2], p[3]), cvtpk_s(p[4], p[5]), cvtpk_s(p[6], p[7])});
#pragma unroll
    for (int dt = 0; dt < 4; ++dt) o[dt] = __builtin_amdgcn_mfma_f32_16x16x32_bf16(fv.v[dt], pb, o[dt], 0, 0, 0);
}
__device__ __forceinline__ float lane_xor(float v, int lane, int m) { return __builtin_bit_cast(float, __builtin_amdgcn_ds_bpermute((lane ^ m) << 2, __builtin_bit_cast(int, v))); }
template <bool ROT>
__device__ __forceinline__ void q_tile_from_w(const u32x4 w0, const u32x4 w1, const f32x4 (&gv)[4], const LAS float* rr, const LAS float* rc, int lane, bf16x8 (&qo)[2]);
template <bool ROT>
__device__ __forceinline__ void q_tile_from_p(const bf16_t* prow, const f32x4 (&gv)[4], const LAS float* rr, const LAS float* rc, int lane, bf16x8 (&qo)[2]) {
    const u32x4 w0 = *(const GAS u32x4*)prow, w1 = *(const GAS u32x4*)(prow + 32);
    q_tile_from_w<ROT>(w0, w1, gv, rr, rc, lane, qo);
}
template <bool ROT>
__device__ __forceinline__ void q_tile_from_w(const u32x4 w0, const u32x4 w1, const f32x4 (&gv)[4], const LAS float* rr, const LAS float* rc, int lane, bf16x8 (&qo)[2]) {
    const int g = lane >> 4;
    float x[16] = {bflo(w0.x), bfhi(w0.x), bflo(w0.y), bfhi(w0.y), bflo(w0.z), bfhi(w0.z), bflo(w0.w), bfhi(w0.w), bflo(w1.x), bfhi(w1.x), bflo(w1.y), bfhi(w1.y), bflo(w1.z), bfhi(w1.z), bflo(w1.w), bfhi(w1.w)};
    float ss = 0.f;
#pragma unroll
    for (int e = 0; e < 16; ++e) ss += x[e] * x[e];
    ss += lane_xor(ss, lane, 16); ss += lane_xor(ss, lane, 32);
    const float rinv = 1.0f / sqrtf(ss * (1.0f / 64.0f) + EPS);
#pragma unroll
    for (int e = 0; e < 16; ++e) x[e] = x[e] * rinv * gv[e >> 2][e & 3];
    if constexpr (ROT) {
        const float sg = (g & 2) ? 1.0f : -1.0f;
#pragma unroll
        for (int hf = 0; hf < 2; ++hf) { const LAS float* tp = hf ? rc : rr;
            const f32x4 t0 = *(const LAS f32x4*)tp, t1 = *(const LAS f32x4*)(tp + 4), t2 = *(const LAS f32x4*)(tp + 8), t3 = *(const LAS f32x4*)(tp + 12);
            const float cs[8] = {t0.x, t0.z, t1.x, t1.z, t2.x, t2.z, t3.x, t3.z}, sn[8] = {t0.y, t0.w, t1.y, t1.w, t2.y, t2.w, t3.y, t3.w};
#pragma unroll
            for (int e = 0; e < 8; ++e) { const float xv = x[8 * hf + e], xp = lane_xor(xv, lane, 32); x[8 * hf + e] = xv * cs[e] + sg * xp * sn[e]; } }
    }
    qo[0] = __builtin_bit_cast(bf16x8, (u32x4){pk2(x[0], x[1]), pk2(x[2], x[3]), pk2(x[4], x[5]), pk2(x[6], x[7])});
    qo[1] = __builtin_bit_cast(bf16x8, (u32x4){pk2(x[8], x[9]), pk2(x[10], x[11]), pk2(x[12], x[13]), pk2(x[14], x[15])});
}
constexpr int ATT_NS = 6, ATT_SLOT = 16384, ATT_TABC = ATT_NS * ATT_SLOT, ATT_ROPE = ATT_TABC + 4096;
__device__ __forceinline__ void glds16(const void* sbase, unsigned voff, unsigned lds_dst) { unsigned keep;
    asm volatile("s_mov_b32 %0, m0\n\ts_mov_b32 m0, %3\n\ts_nop 0\n\tglobal_load_lds_dwordx4 %1, %2\n\ts_mov_b32 m0, %0" : "=&s"(keep) : "v"(voff), "s"(sbase), "s"(lds_dst) : "memory"); }
constexpr int CV_ROWS = 65536;
__device__ __forceinline__ void conv_taps_fill(const Frame& F0, int l) {
    const Frame F = fresh(F0);
    LAS float* wl = (LAS float*)(F.lds + RING_OFF);
    const float* dw = F.in(I_CDW) + (size_t)l * 31 * CWD; float tv[31];
#pragma unroll
    for (int i = 0; i < 31; ++i) tv[i] = ((const GAS float*)dw)[F.tid + 512 * i];
#pragma unroll
    for (int i = 0; i < 31; ++i) wl[512 * i + ((F.tid >> 2) & 1) * 256 + (F.tid >> 3) * 4 + (F.tid & 3)] = tv[i];
}
__device__ __forceinline__ void phase_conv2(const Frame& F0, int l, int nrows, bool prefilled) {
    if (!prefilled) conv_taps_fill(F0, l);
    const Frame F = fresh(F0);
    const int lane = F.lane, wave = F.wave, c0 = 8 * lane;
    LAS float* wl = (LAS float*)(F.lds + RING_OFF);
    const float* dbp = F.in(I_CDB) + l * CWD + c0; const float* lgp = F.in(I_CLG) + l * CWD + c0; const float* lbp = F.in(I_CLB) + l * CWD + c0;
    const f32x4 db0 = *(const f32x4*)dbp, db1 = *(const f32x4*)(dbp + 4), lg0 = *(const f32x4*)lgp, lg1 = *(const f32x4*)(lgp + 4), lb0 = *(const f32x4*)lbp, lb1 = *(const f32x4*)(lbp + 4);
    const unsigned ldsb = (unsigned)(unsigned long long)(F.lds + RING_OFF) + (unsigned)CV_ROWS;
    const LAS unsigned char* rowsL = F.lds + RING_OFF + CV_ROWS;
    __syncthreads();
#define CV_STAGE(ti_) do { const int r0_ = 32 * (ti_); const bool lat_ = r0_ < ML; const int sbeg_ = lat_ ? (r0_ & ~4095) : (ML + ((r0_ - ML) & ~255)), send_ = sbeg_ + (lat_ ? SEQ : CTXL); \
        const bf16_t* ub_ = (const bf16_t*)(F.ws + WS_U); \
        _Pragma("nounroll") for (int j = wave; j < 62; j += 8) { const int r = r0_ - 15 + j; \
            if (r >= sbeg_ && r < send_) glds16(ub_ + (size_t)r * CWD, (unsigned)lane * 16u, ldsb + (unsigned)j * 1024u); \
            else *(LAS u32x4*)(rowsL + j * 1024 + lane * 16) = (u32x4){0u, 0u, 0u, 0u}; } } while (0)
    f32x4 acc[4][2];
    int tcur = -1, tnext = F.bx; const int ntile = nrows / 32;
#pragma nounroll
    for (;;) {
        if (tnext < ntile) CV_STAGE(tnext);
        if (tcur >= 0) {
            const int r0 = 32 * tcur;
#pragma unroll
            for (int t = 0; t < 4; ++t) {
                float s = (acc[t][0].x + acc[t][0].y) + (acc[t][0].z + acc[t][0].w) + (acc[t][1].x + acc[t][1].y) + (acc[t][1].z + acc[t][1].w);
                const float mean = wave_sum(s) * (1.0f / 512.0f);
                const f32x4 d0 = acc[t][0] - mean, d1 = acc[t][1] - mean;
                float s2 = (d0.x * d0.x + d0.y * d0.y) + (d0.z * d0.z + d0.w * d0.w) + (d1.x * d1.x + d1.y * d1.y) + (d1.z * d1.z + d1.w * d1.w);
                const float rstd = 1.0f / sqrtf(wave_sum(s2) * (1.0f / 512.0f) + EPS);
                const f32x4 y0 = d0 * rstd * lg0 + lb0, y1 = d1 * rstd * lg1 + lb1;
                u32x4 o; o.x = pk2(y0.x * sigmoidf_(y0.x), y0.y * sigmoidf_(y0.y)); o.y = pk2(y0.z * sigmoidf_(y0.z), y0.w * sigmoidf_(y0.w)); o.z = pk2(y1.x * sigmoidf_(y1.x), y1.y * sigmoidf_(y1.y)); o.w = pk2(y1.z * sigmoidf_(y1.z), y1.w * sigmoidf_(y1.w));
                *(GAS u32x4*)(((bf16_t*)(F.ws + WS_CONV)) + (size_t)(r0 + 4 * wave + t) * CWD + c0) = o;
            }
        }
        if (tnext >= ntile) break;
        asm volatile("s_waitcnt vmcnt(0)" ::: "memory");
        __syncthreads();
#pragma unroll
        for (int t = 0; t < 4; ++t) { acc[t][0] = db0; acc[t][1] = db1; }
        f32x4 w[4][2];
        const LAS unsigned char* myrows = rowsL + (4 * wave) * 1024 + lane * 16;
#pragma unroll
        for (int i = 0; i < 34; ++i) {
#pragma unroll
            for (int j = 3; j > 0; --j) { w[j][0] = w[j - 1][0]; w[j][1] = w[j - 1][1]; }
            if (i < 31) { w[0][0] = *(const LAS f32x4*)(wl + i * CWD + 4 * lane); w[0][1] = *(const LAS f32x4*)(wl + i * CWD + 256 + 4 * lane); }
            const u32x4 xw = *(const LAS u32x4*)(myrows + i * 1024);
            const f32x4 x0 = (f32x4){bflo(xw.x), bfhi(xw.x), bflo(xw.y), bfhi(xw.y)}, x1 = (f32x4){bflo(xw.z), bfhi(xw.z), bflo(xw.w), bfhi(xw.w)};
#pragma unroll
            for (int t = 0; t < 4; ++t) { const int k = i - t; if (k >= 0 && k < 31) { acc[t][0] += w[t][0] * x0; acc[t][1] += w[t][1] * x1; } }
        }
        __syncthreads();
        tcur = tnext; tnext += F.G;
    }
#undef CV_STAGE
    asm volatile("s_waitcnt vmcnt(0)" ::: "memory");
    __syncthreads();
}
typedef short v4i16_t __attribute__((ext_vector_type(4)));
__device__ __forceinline__ u32x2 lds_tr16(const LAS unsigned char* p) { return __builtin_bit_cast(u32x2, __builtin_amdgcn_ds_read_tr16_b64_v4i16((LAS v4i16_t*)p)); }
template <bool CTXQ>
__device__ __forceinline__ void attn_block(const Frame& Fu, int l, int b, int h, int rgp, float msh) {
    Frame F = Fu; { unsigned long long w = (unsigned long long)Fu.ws; asm volatile("" : "+s"(w)); F.ws = (unsigned char*)w; }
    int lane_ = F.lane; asm volatile("" : "+v"(lane_));
    const int lane = lane_, fr = lane & 15, g = lane >> 4, wave = F.wave, bh = b * NH + h;
    const int rg = rgp * 2 + (wave >> 2), j = wave & 3, r0 = 4 * rg, c0 = 16 * j, bs = min(max(16 * j - 8, 0), 32);
    const unsigned ldsb = (unsigned)(unsigned long long)(F.lds + RING_OFF);
    const LAS unsigned char* ring = F.lds + RING_OFF;
    const int kmin = CTXQ ? 0 : min(max(8 * rgp - 4, 0), 56), kmax = CTXQ ? -1 : min(max(8 * rgp + 7 - 4, 0), 56) + 7, nloc = kmax - kmin + 1, nrow = nloc + 4;
    constexpr bool active = true; constexpr int NT = CTXQ ? 1 : 4;
    const int tid = wave * 64 + lane, dk = tid >> 3, dc = (tid & 7) ^ ((dk >> 1) & 7);
    const unsigned kdo = (unsigned)(dk * 64 + 8 * dc) * 2u, vdv = (unsigned)((8 * wave + ((lane >> 1) & 7)) * PW + 8 * (2 * (lane >> 4) + (lane & 1))) * 2u;
    const bf16_t* kloc = ((const bf16_t*)(F.ws + WS_KR)) + (size_t)bh * SEQ * 64; const bf16_t* vloc = ((const bf16_t*)(F.ws + WS_P)) + (size_t)(b * SEQ) * PW + 2 * AW + h * 64;
    const bf16_t* kctx = ((const bf16_t*)(F.ws + WS_KC)) + (size_t)bh * CTXL * 64; const bf16_t* vctx = ((const bf16_t*)(F.ws + WS_P)) + (size_t)(ML + b * CTXL) * PW + 2 * AW + h * 64;
#define ATT_ISSUE(s_) do { const int s2_ = min((s_), nrow - 1); const unsigned dst_ = ldsb + (unsigned)(((s_) % ATT_NS) * ATT_SLOT + wave * 1024); \
        if (s2_ < nloc) { glds16(kloc + (size_t)(kmin + s2_) * 4096, kdo, dst_); glds16(vloc + (size_t)(kmin + s2_) * 64 * PW, vdv, dst_ + 8192u); } \
        else { glds16(kctx + (size_t)(s2_ - nloc) * 4096, kdo, dst_); glds16(vctx + (size_t)(s2_ - nloc) * 64 * PW, vdv, dst_ + 8192u); } } while (0)
#define ATT_FRAGS(slot_, koffA, koffB, vb_) do { const LAS unsigned char* sl_ = ring + (slot_) * ATT_SLOT; \
        kf.k[0][0] = *(const LAS bf16x8*)(sl_ + (koffA)); kf.k[0][1] = *(const LAS bf16x8*)(sl_ + (koffB)); kf.k[1][0] = *(const LAS bf16x8*)(sl_ + (koffA) + 2048); kf.k[1][1] = *(const LAS bf16x8*)(sl_ + (koffB) + 2048); \
        _Pragma("unroll") for (int dt = 0; dt < 4; ++dt) { const u32x2 lo_ = lds_tr16(sl_ + (vb_) + dt * 256), hi_ = lds_tr16(sl_ + (vb_) + 2048 + dt * 256);        \
            vf.v[dt] = __builtin_bit_cast(bf16x8, (u32x4){lo_.x, lo_.y, hi_.x, hi_.y}); } } while (0)
#define ATT_ROWSYNC(s_) do { asm volatile("s_waitcnt vmcnt(%0)" :: "n"(2 * (ATT_NS - 2)) : "memory");     \
        asm volatile("s_barrier" ::: "memory");                                                                  \
        ATT_ISSUE((s_) + ATT_NS - 1); } while (0)
    bf16x8 q[4][2];
    const bf16_t* qraw = ((const bf16_t*)(F.ws + WS_P)) + (size_t)(b * SEQ + r0 * 64 + c0) * PW + h * 64;
    const unsigned qlo = (unsigned)(fr * PW + 8 * g);
    if constexpr (CTXQ) {
        const bf16_t* qc = ((const bf16_t*)(F.ws + WS_QC)) + ((size_t)bh * CTXL + 128 * rgp + 16 * wave + fr) * 64 + 8 * g;
#pragma unroll
        for (int ks = 0; ks < 2; ++ks) q[0][ks] = *(const GAS bf16x8*)(qc + 32 * ks);
    } else {
        f32x4 gv[4]; { const float* gq = F.in(I_GQ) + l * 64 + 8 * g; gv[0] = *(const f32x4*)gq; gv[1] = *(const f32x4*)(gq + 4); gv[2] = *(const f32x4*)(gq + 32); gv[3] = *(const f32x4*)(gq + 36); }
        const LAS float* ropet = (const LAS float*)(F.lds + RING_OFF + ATT_ROPE) + 16 * (g & 1);
        u32x4 qw[4][2];
#pragma unroll
        for (int i = 0; i < 4; ++i) { qw[i][0] = *(const GAS u32x4*)(qraw + (size_t)i * 64 * PW + qlo); qw[i][1] = *(const GAS u32x4*)(qraw + (size_t)i * 64 * PW + qlo + 32); }
#pragma unroll
        for (int i = 0; i < 4; ++i) { q_tile_from_w<true>(qw[i][0], qw[i][1], gv, ropet + (r0 + i) * 32, ropet + (c0 + fr) * 32, lane, q[i]); asm volatile("" : "+v"(q[i][0]), "+v"(q[i][1]) :: "memory"); }
    }
    f32x4 o[4][4]; float ls[4];
#pragma unroll
    for (int i = 0; i < 4; ++i) { ls[i] = 0.f;
#pragma unroll
        for (int dt = 0; dt < 4; ++dt) o[i][dt] = (f32x4){0.f, 0.f, 0.f, 0.f}; }
    int rsv[4];
#pragma unroll
    for (int i = 0; i < 4; ++i) rsv[i] = min(max(r0 + i - 4, 0), 56);
    asm volatile("s_waitcnt vmcnt(0)" ::: "memory");
#pragma unroll
    for (int s = 0; s < ATT_NS - 1; ++s) ATT_ISSUE(s);
    KF kf; VF vf;
    if constexpr (!CTXQ) {
        const int swz = ((fr >> 1) + ((bs >> 1) & 7)) & 7;
        const int kA = bs * 128 + fr * 128 + ((g ^ (swz & 3)) + 4 * (swz >> 2)) * 16, kB = bs * 128 + fr * 128 + ((g ^ (swz & 3)) + 4 * (1 ^ (swz >> 2))) * 16;
        const int vb = 8192 + ((bs >> 3) + (g >> 1)) * 1024 + (4 * (g & 1) + (fr >> 2)) * 32 + (fr & 3) * 8;
        const int cq = c0 + fr, csq = min(max(cq - 8, 0), 48);
        f32x4 mb0, mb1;
#pragma unroll
        for (int e = 0; e < 4; ++e) { const int ka_ = bs + 4 * g + e, kb_ = ka_ + 16; mb0[e] = (ka_ >= csq && ka_ < csq + 16) ? 0.f : -__builtin_inff(); mb1[e] = (kb_ >= csq && kb_ < csq + 16) ? 0.f : -__builtin_inff(); }
        const LAS float* tl = (const LAS float*)(F.lds + RING_OFF + ATT_TABC) + 16 + (bs + 4 * g - cq + 15);
#pragma nounroll
        for (int s = 0; s < nloc; ++s) {
            ATT_ROWSYNC(s);
            const int kr = kmin + s;
            if (kr >= rsv[0] && kr <= rsv[3] + 7) {
                ATT_FRAGS(s % ATT_NS, kA, kB, vb);
#pragma unroll
                for (int i = 0; i < 4; ++i) if (kr >= rsv[i] && kr <= rsv[i] + 7) {
                    const LAS float* tr = tl + (kr - (r0 + i) + 7) * 64;
                    const f32x4 t0 = (f32x4){tr[0], tr[1], tr[2], tr[3]} + mb0, t1 = (f32x4){tr[16], tr[17], tr[18], tr[19]} + mb1;
                    attn_step(kf, vf, q[i], o[i], ls[i], t0, t1); __builtin_amdgcn_sched_barrier(0); }
            }
        }
    }
    {
        if constexpr (!CTXQ) { f32x4 gv[4]; const float* gq = F.in(I_GQ) + l * 64 + 8 * g; gv[0] = *(const f32x4*)gq; gv[1] = *(const f32x4*)(gq + 4); gv[2] = *(const f32x4*)(gq + 32); gv[3] = *(const f32x4*)(gq + 36);
          const LAS float* ropet = (const LAS float*)(F.lds + RING_OFF + ATT_ROPE);
          u32x4 qw[4][2];
#pragma unroll
          for (int i = 0; i < 4; ++i) { qw[i][0] = *(const GAS u32x4*)(qraw + (size_t)i * 64 * PW + qlo); qw[i][1] = *(const GAS u32x4*)(qraw + (size_t)i * 64 * PW + qlo + 32); }
#pragma unroll
          for (int i = 0; i < 4; ++i) { q_tile_from_w<false>(qw[i][0], qw[i][1], gv, ropet, ropet, lane, q[i]); asm volatile("" : "+v"(q[i][0]), "+v"(q[i][1]) :: "memory"); } }
        asm volatile("s_waitcnt vmcnt(0)" ::: "memory");
        const int swz = (fr >> 1) & 7;
        const int kA = fr * 128 + ((g ^ (swz & 3)) + 4 * (swz >> 2)) * 16, kB = fr * 128 + ((g ^ (swz & 3)) + 4 * (1 ^ (swz >> 2))) * 16;
        const int vb = 8192 + (g >> 1) * 1024 + (4 * (g & 1) + (fr >> 2)) * 32 + (fr & 3) * 8;
        const f32x4 tm = (f32x4){msh, msh, msh, msh};
#pragma nounroll
        for (int s = nloc; s < nrow; ++s) {
            ATT_ROWSYNC(s);
            if (active)
#pragma unroll
            for (int hf = 0; hf < 2; ++hf) {
                ATT_FRAGS(s % ATT_NS, kA + hf * 4096, kB + hf * 4096, vb + hf * 4096);
#pragma unroll
                for (int i = 0; i < NT; ++i) { attn_step(kf, vf, q[i], o[i], ls[i], tm, tm); __builtin_amdgcn_sched_barrier(0); }
            }
        }
    }
    asm volatile("s_waitcnt vmcnt(0)" ::: "memory");
    asm volatile("s_barrier" ::: "memory");
#undef ATT_ISSUE
#undef ATT_FRAGS
#undef ATT_ROWSYNC
#pragma unroll
    for (int i = 0; i < NT; ++i) {
        float lt = ls[i]; lt += lane_xor(lt, lane, 16); lt += lane_xor(lt, lane, 32);
        const float inv = 1.0f / lt;
        const int orow = CTXQ ? (ML + b * CTXL + 128 * rgp + 16 * wave + fr) : (b * SEQ + (r0 + i) * 64 + c0 + fr);
        bf16_t* op = ((bf16_t*)(F.ws + WS_ATT)) + (size_t)orow * AW + h * 64 + 4 * g;
        if (active) {
#pragma unroll
            for (int dp = 0; dp < 2; ++dp) {
                const f32x4 va = o[i][2 * dp] * inv, vb = o[i][2 * dp + 1] * inv;
                unsigned ax = cvtpk_s(va.x, va.y), ay = cvtpk_s(va.z, va.w), bx = cvtpk_s(vb.x, vb.y), by = cvtpk_s(vb.z, vb.w);
                { auto r = __builtin_amdgcn_permlane16_swap(ax, bx, false, false); ax = r[0]; bx = r[1]; }
                { auto r = __builtin_amdgcn_permlane16_swap(ay, by, false, false); ay = r[0]; by = r[1]; }
                *(GAS u32x4*)(op - 4 * g + 32 * dp + ((g & 1) ? 16 + 4 * (g - 1) : 4 * g)) = (u32x4){ax, ay, bx, by}; } }
    }
}
__device__ __forceinline__ void phase_attn(const Frame& F0, int l) {
    const Frame F = fresh(F0);
    LAS float* tabc = (LAS float*)(F.lds + RING_OFF + ATT_TABC);
    const float msh = -((const float*)(F.ws + WS_MSH))[l] * LOG2E;
    int curh = -1;
    { int t_ = F.tid; for (int i = t_; i < 2048; i += 512) ((LAS float*)(F.lds + RING_OFF + ATT_ROPE))[i] = ((const GAS float*)(F.ws + WS_ROPE))[i]; }
    for (int u = F.bx; u < 512; u += F.G) {
        const int h = u & 15, rest = u >> 4, b = rest >> 3, rgp = rest & 7;
        if (h != curh) { __syncthreads(); int t_ = F.tid; unsigned long long w_ = (unsigned long long)F.ws; asm volatile("" : "+v"(t_), "+s"(w_));
            for (int i = t_; i < 960; i += 512) ((LAS float*)(F.lds + RING_OFF + ATT_TABC))[i] = ((const GAS float*)((unsigned char*)w_ + WS_TAB))[(size_t)(l * NH + h) * 960 + i]; __syncthreads(); curh = h; }
        attn_block<false>(F, l, b, h, rgp, msh);
    }
    __syncthreads();
    if (l == 0) for (int u = F.bx; u < NB * NH * 2; u += F.G) attn_block<true>(F, l, u >> 5, (u >> 1) & 15, u & 1, msh);
    __syncthreads();
}

__device__ __forceinline__ void router_fill(const Frame& F0, int l) {
    const Frame F = fresh(F0);
    const int tid = F.tid;
    LAS float* wt = (LAS float*)(F.lds + RING_OFF);
    const float* wr = F.in(I_WR) + (size_t)l * DM * NE;
#pragma unroll 1
    for (int i0 = 0; i0 < DM * NE; i0 += 512 * 16) { float tv[16];
#pragma unroll
        for (int j = 0; j < 16; ++j) tv[j] = ((const GAS float*)wr)[i0 + 512 * j + tid];
#pragma unroll
        for (int j = 0; j < 16; ++j) { const int i = i0 + 512 * j + tid; wt[(i & 15) * DM + ((i >> 4) ^ ((i & 15) << 2))] = tv[j]; } }
}
__device__ __forceinline__ void phase_norm2(const Frame& F0, int l, int nrows, bool prefilled) {
    if (!prefilled) router_fill(F0, l);
    const Frame F = fresh(F0);
    const int tid = F.tid, lane = F.lane;
    LAS float* wt = (LAS float*)(F.lds + RING_OFF);
    __syncthreads();
    const int myexp = ((lane >> 5) & 1) * 8 + ((lane >> 4) & 1) * 4 + ((lane >> 3) & 1) * 2 + ((lane >> 2) & 1);
    for (int r0 = F.gw; r0 < nrows; r0 += 2 * F.ngw) {
        const int row[2] = {r0, min(r0 + F.ngw, nrows - 1)}; const bool ok1 = r0 + F.ngw < nrows;
        f32x4 v[2][8]; float rinv[2];
#pragma unroll
        for (int u = 0; u < 2; ++u) { const float* xp = xrow_ptr(F, 0, row[u]) + 4 * lane; const bf16_t* xb = ((const bf16_t*)(F.ws + WS_X1)) + (size_t)row[u] * DM + 4 * lane; const bf16_t* dl = ((const bf16_t*)(F.ws + WS_XM)) + (size_t)row[u] * DM + 4 * lane; float ss = 0.f;
#pragma unroll
            for (int k = 0; k < 8; ++k) { const u32x2 dw = *(const u32x2*)(dl + 256 * k); f32x4 xv; if (l == 0) xv = *(const f32x4*)(xp + 256 * k); else { const u32x2 xw = *(const u32x2*)(xb + 256 * k); xv = (f32x4){bflo(xw.x), bfhi(xw.x), bflo(xw.y), bfhi(xw.y)}; }
                v[u][k] = xv + (f32x4){bflo(dw.x), bfhi(dw.x), bflo(dw.y), bfhi(dw.y)}; ss += (v[u][k].x * v[u][k].x + v[u][k].y * v[u][k].y) + (v[u][k].z * v[u][k].z + v[u][k].w * v[u][k].w); }
            rinv[u] = ss; }
        rinv[0] = 1.0f / sqrtf(wave_sum(rinv[0]) * (1.0f / DM) + EPS); rinv[1] = 1.0f / sqrtf(wave_sum(rinv[1]) * (1.0f / DM) + EPS);
        const float* g2 = F.in(I_GN2) + l * DM + 4 * lane;
#pragma unroll
        for (int u = 0; u < 2; ++u) { const int bs = row[u] < ML ? (row[u] >> 12) : 4; const float* md = ((float*)(F.ws + WS_MOD)) + (size_t)(l * 5 + bs) * 12288 + 4 * lane;
#pragma unroll
            for (int k = 0; k < 8; ++k) { const f32x4 g = *(const f32x4*)(g2 + 256 * k), sh = *(const f32x4*)(md + 3 * DM + 256 * k), scl = *(const f32x4*)(md + 4 * DM + 256 * k);
                v[u][k] = (v[u][k] * rinv[u] * g) * (scl + 1.0f) + sh;
                if (u == 0 || ok1) *(unsigned*)(((unsigned char*)(F.ws + WS_H8)) + (size_t)row[u] * DM + 4 * lane + 256 * k) = pk4_fp8(v[u][k].x, v[u][k].y, v[u][k].z, v[u][k].w); } }
        float s[2][16];
#pragma unroll
        for (int e = 0; e < 16; ++e) { f32x4 a0 = {0.f, 0.f, 0.f, 0.f}, a1 = {0.f, 0.f, 0.f, 0.f};
#pragma unroll
            for (int k = 0; k < 8; ++k) { const f32x4 w = *(const LAS f32x4*)(wt + e * DM + 4 * (lane ^ e) + 256 * k); a0 += v[0][k] * w; a1 += v[1][k] * w; }
            float s0 = (a0.x + a0.y) + (a0.z + a0.w), s1 = (a1.x + a1.y) + (a1.z + a1.w);
            asm volatile("" : "+v"(s0), "+v"(s1) :: "memory");
            s[0][e] = s0; s[1][e] = s1; }
#pragma unroll
        for (int u = 0; u < 2; ++u) {
#pragma unroll
            for (int st = 0; st < 4; ++st) { const int d = 32 >> st, n = 8 >> st; const bool hi = (lane & d) != 0;
#pragma unroll
                for (int i = 0; i < 8; ++i) if (i < n) { const float a = s[u][i], b = s[u][i + n]; const float send = hi ? a : b, keep = hi ? b : a; s[u][i] = keep + __shfl_xor(send, d); } }
            float lg = s[u][0]; lg += __shfl_xor(lg, 2); lg += __shfl_xor(lg, 1);
            float mx = lg;
#pragma unroll
            for (int d = 4; d < 64; d <<= 1) mx = fmaxf(mx, __shfl_xor(mx, d));
            const float p = expf(lg - mx); float sum = p;
#pragma unroll
            for (int d = 4; d < 64; d <<= 1) sum += __shfl_xor(sum, d);
            const float aff = p / sum;
            if ((lane & 3) == 0 && (u == 0 || ok1)) { const int r = row[u];
                if (r < ML) ((float*)(F.ws + WS_AFFT))[((size_t)(r >> 12) * NE + myexp) * SEQ + (r & 4095)] = aff;
                else ((float*)(F.ws + WS_AFFT))[(size_t)NB * NE * SEQ + ((size_t)((r - ML) >> 8) * NE + myexp) * CTXL + ((r - ML) & 255)] = aff; }
        }
    }
    __syncthreads();
}

__device__ __forceinline__ void phase_norm2p(const Frame& F0, int l, int nrows, bool prefilled) {
    if (!prefilled) router_fill(F0, l);
    const Frame F = fresh(F0);
    const int lane = F.lane;
    LAS float* wt = (LAS float*)(F.lds + RING_OFF);
    __syncthreads();
    const int myexp = ((lane >> 5) & 1) * 8 + ((lane >> 4) & 1) * 4 + ((lane >> 3) & 1) * 2 + ((lane >> 2) & 1);
    f32x4 xr[8]; u32x2 xbw[8], dr[8];
#define N2_LOAD(row_) do { const int rr_ = (row_); const bf16_t* dl_ = ((const bf16_t*)(F.ws + WS_XM)) + (size_t)rr_ * DM + 4 * lane; \
        if (l == 0) { const float* xp_ = xrow_ptr(F, 0, rr_) + 4 * lane; _Pragma("unroll") for (int k = 0; k < 8; ++k) xr[k] = *(const f32x4*)(xp_ + 256 * k); } \
        else { const bf16_t* xb_ = ((const bf16_t*)(F.ws + WS_X1)) + (size_t)rr_ * DM + 4 * lane; _Pragma("unroll") for (int k = 0; k < 8; ++k) xbw[k] = *(const u32x2*)(xb_ + 256 * k); } \
        _Pragma("unroll") for (int k = 0; k < 8; ++k) dr[k] = *(const u32x2*)(dl_ + 256 * k); } while (0)
    if (F.gw < nrows) N2_LOAD(F.gw);
#pragma nounroll
    for (int r = F.gw; r < nrows; r += F.ngw) {
        f32x4 v[8]; float ss = 0.f;
#pragma unroll
        for (int k = 0; k < 8; ++k) { const f32x4 xv = (l == 0) ? xr[k] : (f32x4){bflo(xbw[k].x), bfhi(xbw[k].x), bflo(xbw[k].y), bfhi(xbw[k].y)};
            v[k] = xv + (f32x4){bflo(dr[k].x), bfhi(dr[k].x), bflo(dr[k].y), bfhi(dr[k].y)}; ss += (v[k].x * v[k].x + v[k].y * v[k].y) + (v[k].z * v[k].z + v[k].w * v[k].w); }
        const int bs = r < ML ? (r >> 12) : 4;
        const float* ma = ((const float*)(F.ws + WS_MA2)) + (size_t)(l * 5 + bs) * DM + 4 * lane; const float* mb = ((const float*)(F.ws + WS_MOD)) + (size_t)(l * 5 + bs) * 12288 + 3 * DM + 4 * lane;
        f32x4 A[8], B[8];
#pragma unroll
        for (int k = 0; k < 8; ++k) { A[k] = *(const f32x4*)(ma + 256 * k); B[k] = *(const f32x4*)(mb + 256 * k); }
        asm volatile("" ::: "memory");
        if (r + F.ngw < nrows) N2_LOAD(r + F.ngw);
        asm volatile("" ::: "memory");
        const float rinv = 1.0f / sqrtf(wave_sum(ss) * (1.0f / DM) + EPS);
#pragma unroll
        for (int k = 0; k < 8; ++k) { v[k] = (v[k] * rinv) * A[k] + B[k];
            *(unsigned*)(((unsigned char*)(F.ws + WS_H8)) + (size_t)r * DM + 4 * lane + 256 * k) = pk4_fp8(v[k].x, v[k].y, v[k].z, v[k].w); }
        float s[16];
#pragma unroll
        for (int e = 0; e < 16; ++e) { f32x4 a0 = {0.f, 0.f, 0.f, 0.f};
#pragma unroll
            for (int k = 0; k < 8; ++k) { const f32x4 w = *(const LAS f32x4*)(wt + e * DM + 4 * (lane ^ e) + 256 * k); a0 += v[k] * w; }
            float s0 = (a0.x + a0.y) + (a0.z + a0.w);
            asm volatile("" : "+v"(s0));
            s[e] = s0; }
#pragma unroll
        for (int st = 0; st < 4; ++st) { const int d = 32 >> st, n = 8 >> st; const bool hi = (lane & d) != 0;
#pragma unroll
            for (int i = 0; i < 8; ++i) if (i < n) { const float a = s[i], b = s[i + n]; const float send = hi ? a : b, keep = hi ? b : a; s[i] = keep + __shfl_xor(send, d); } }
        float lg = s[0]; lg += __shfl_xor(lg, 2); lg += __shfl_xor(lg, 1);
        float mx = lg;
#pragma unroll
        for (int d = 4; d < 64; d <<= 1) mx = fmaxf(mx, __shfl_xor(mx, d));
        const float p = expf(lg - mx); float sum = p;
#pragma unroll
        for (int d = 4; d < 64; d <<= 1) sum += __shfl_xor(sum, d);
        const float aff = p / sum;
        if ((lane & 3) == 0) {
            if (r < ML) ((float*)(F.ws + WS_AFFT))[((size_t)(r >> 12) * NE + myexp) * SEQ + (r & 4095)] = aff;
            else ((float*)(F.ws + WS_AFFT))[(size_t)NB * NE * SEQ + ((size_t)((r - ML) >> 8) * NE + myexp) * CTXL + ((r - ML) & 255)] = aff; }
    }
#undef N2_LOAD
    __syncthreads();
}
__device__ __forceinline__ int block_count8(LAS int* slots, int par, int wave, int lane, int wc) {
    if (lane == 0) slots[par * 8 + wave] = wc;
    __syncthreads();
    typedef int i32x4 __attribute__((ext_vector_type(4)));
    const i32x4 a = *(const LAS i32x4*)(slots + par * 8), b = *(const LAS i32x4*)(slots + par * 8 + 4);
    return (a.x + a.y) + (a.z + a.w) + (b.x + b.y) + (b.z + b.w);
}
__device__ __forceinline__ void block_count8x3(LAS int* slots, int par, int wave, int lane, int w1, int w2, int w3, int& t1, int& t2, int& t3) {
    if (lane == 0) { slots[par * 24 + wave] = w1; slots[par * 24 + 8 + wave] = w2; slots[par * 24 + 16 + wave] = w3; }
    __syncthreads();
    typedef int i32x4 __attribute__((ext_vector_type(4)));
    const LAS i32x4* p = (const LAS i32x4*)(slots + par * 24);
    const i32x4 a = p[0], b = p[1], c = p[2], d = p[3], e = p[4], f = p[5];
    t1 = (a.x + a.y) + (a.z + a.w) + (b.x + b.y) + (b.z + b.w); t2 = (c.x + c.y) + (c.z + c.w) + (d.x + d.y) + (d.z + d.w); t3 = (e.x + e.y) + (e.z + e.w) + (f.x + f.y) + (f.z + f.w);
}
__device__ __forceinline__ int block_excl_scan(LAS int* slots, int wave, int lane, int c, int& total) {
    int incl = c;
#pragma unroll
    for (int o = 1; o < 64; o <<= 1) { const int t = __shfl_up(incl, o); if (lane >= o) incl += t; }
    __syncthreads();
    if (lane == 63) slots[wave] = incl;
    __syncthreads();
    int base = 0, tot = 0;
#pragma unroll
    for (int w = 0; w < 8; ++w) { const int x = slots[w]; tot += x; if (w < wave) base += x; }
    total = tot; return base + incl - c;
}
template <int NV>
__device__ __forceinline__ void rank_group(const Frame& F, const float* src, int ntok, int cap, int* slot_out  , int rho0) {
    const int tid = F.tid, lane = F.lane, wave = F.wave;
    LAS int* cs = (LAS int*)(F.lds + RING_OFF);
    LAS int* cs3 = cs + 32;
    const bool act = NV * tid < ntok;
    float val[NV]; unsigned key[NV];
    if constexpr (NV == 8) { const f32x4 a = *(const f32x4*)(src + 8 * tid), b = *(const f32x4*)(src + 8 * tid + 4); val[0] = a.x; val[1] = a.y; val[2] = a.z; val[3] = a.w; val[4] = b.x; val[5] = b.y; val[6] = b.z; val[7] = b.w; }
    else { val[0] = act ? src[tid] : 0.f; }
#pragma unroll
    for (int i = 0; i < NV; ++i) key[i] = act ? __builtin_bit_cast(unsigned, val[i]) : 0u;
    unsigned prefix = 0u; int par = 0;
    { const unsigned cand = 1u << 30; int wc = 0;
#pragma unroll
      for (int i = 0; i < NV; ++i) wc += (int)__builtin_popcountll(__ballot(key[i] >= cand));
      if (block_count8(cs, par, wave, lane, wc) >= cap) prefix = cand;
      par ^= 1; }
    for (int bit = 28; bit >= 0; bit -= 2) {
        const unsigned c1 = prefix | (1u << bit), c2 = prefix | (2u << bit), c3 = prefix | (3u << bit); int w1 = 0, w2 = 0, w3 = 0;
#pragma unroll
        for (int i = 0; i < NV; ++i) { w1 += (int)__builtin_popcountll(__ballot(key[i] >= c1)); w2 += (int)__builtin_popcountll(__ballot(key[i] >= c2)); w3 += (int)__builtin_popcountll(__ballot(key[i] >= c3)); }
        int t1, t2, t3; block_count8x3(cs3, par, wave, lane, w1, w2, w3, t1, t2, t3);
        prefix = (t3 >= cap) ? c3 : (t2 >= cap) ? c2 : (t1 >= cap) ? c1 : prefix;
        par ^= 1;
    }
    const unsigned T = prefix;
    int wc = 0;
#pragma unroll
    for (int i = 0; i < NV; ++i) wc += (int)__builtin_popcountll(__ballot(key[i] > T));
    const int ngt = block_count8(cs, par, wave, lane, wc); par ^= 1;
    const int R = cap - ngt;
    int ceq = 0;
#pragma unroll
    for (int i = 0; i < NV; ++i) ceq += (key[i] == T) ? 1 : 0;
    int tot; int eqr = block_excl_scan(cs + 16, wave, lane, ceq, tot);
    bool sel[NV]; int csel = 0;
#pragma unroll
    for (int i = 0; i < NV; ++i) { const bool eq = key[i] == T; sel[i] = (key[i] > T) || (eq && eqr < R); eqr += eq ? 1 : 0; csel += sel[i] ? 1 : 0; }
    int sl = block_excl_scan(cs + 16, wave, lane, csel, tot);
    if (act) {
#pragma unroll
        for (int i = 0; i < NV; ++i) { const int t = NV * tid + i; slot_out[(size_t)t * 16] = sel[i] ? sl : 0x7fffffff;
            if (sel[i]) { ((int*)(F.ws + WS_IDX))[rho0 + sl] = t; ((float*)(F.ws + WS_GATE))[rho0 + sl] = val[i]; ++sl; } }
    }
    __syncthreads();
}
__device__ __forceinline__ void phase_rank(const Frame& F0, int l) {
    const Frame F = fresh(F0);
    const int nunits = 64 + ((l == 0) ? 64 : 0);
    for (int un = F.bx; un < nunits; un += F.G) {
        if (un < 64) { const int b = un >> 4, e = un & 15;
            rank_group<8>(F, ((float*)(F.ws + WS_AFFT)) + (size_t)un * SEQ, SEQ, CAP_L, ((int*)(F.ws + WS_SLOT)) + (size_t)(b * SEQ) * 16 + e, (e * 4 + b) * 512); }
        else { const int g = un - 64, b = g >> 4, e = g & 15;
            rank_group<1>(F, ((float*)(F.ws + WS_AFFT)) + (size_t)NB * NE * SEQ + (size_t)g * CTXL, CTXL, CAP_C, ((int*)(F.ws + WS_SLOT)) + (size_t)(ML + b * CTXL) * 16 + e, 32768 + e * 256 + b * 32); }
    }
}
__device__ __forceinline__ void phase_gather(const Frame& F0, int l) {
    const Frame F = fresh(F0);
    const int lane = F.lane; const int nrows = (l == 0) ? XS_ROWS : 32768;
    for (int rho = F.gw; rho < nrows; rho += F.ngw) {
        const bf16_t* src = nullptr;
        if (rho < 32768) { const int ge = rho >> 9, b = ge & 3; src = ((bf16_t*)(F.ws + WS_H)) + (size_t)(b * SEQ + ((int*)(F.ws + WS_IDX))[rho]) * DM; }
        else { const int i = (rho - 32768) & 255; if (i < 128) { const int b = i >> 5; src = ((bf16_t*)(F.ws + WS_H)) + (size_t)(ML + b * CTXL + ((int*)(F.ws + WS_IDX))[rho]) * DM; } else if (lane == 0) ((float*)(F.ws + WS_GATE))[rho] = 0.f; }
        bf16_t* dst = ((bf16_t*)(F.ws + WS_XS)) + (size_t)rho * DM + 8 * lane;
#pragma unroll
        for (int j = 0; j < 4; ++j) { const u32x4 w = src ? *(const u32x4*)(src + 8 * lane + 512 * j) : (u32x4){0u, 0u, 0u, 0u}; *(u32x4*)(dst + 512 * j) = w; }
    }
}

#ifndef PH_MASK
#define PH_MASK 0xFFFFFFFFu
#endif
#ifndef DUP_MASK
#define DUP_MASK 0x0u
#endif
#define SLOT_OF(k) (((k) < 2) ? (k) : (((k) - 2) % 11 + 2))
#define REPS(k) for (int rep_ = 0; rep_ < 1 + (int)((DUP_MASK >> SLOT_OF(k)) & 1u); ++rep_)
#define IN(k) (lo <= (k) && (k) < hi && ((PH_MASK >> (((k) < 2) ? (k) : (((k) - 2) % 11 + 2))) & 1u))
#define SEAM(k) do { if (IN(k) && IN((k) + 1)) xcd_barrier(bar); } while (0)
#define SEAMP(k, HOOK) do { if (IN(k) && IN((k) + 1)) { xcd_arrive(bar); HOOK; xcd_wait(bar); } } while (0)
template <int L> __device__ __forceinline__ void layer_program(const Frame& F0, const int lo, const int hi, const XcdBarrier& bar, LAS unsigned char* ring) {
    {
        constexpr int l = L; constexpr int pb = 2 + 11 * l;
        const int mrows = (l == 0) ? MT : ML;
        const int xrows = (l == 0) ? XS_ROWS : 32768;
        if (IN(pb + 0)) REPS(pb + 0) { phase_norm1(F0, l); } SEAM(pb + 0);
        if (IN(pb + 1)) REPS(pb + 1) {
            const Frame F = fresh(F0);
            if (l == 0 && F.bx >= F.G - NSTREAM) pa_stream(F0, (F.bx - (F.G - NSTREAM)) * NWAVES + F.wave, NSTREAM * NWAVES, 0);
            else {
            pg8::Gemm g{((bf16_t*)(F.ws + WS_H)), ((bf16_t*)(F.ws + WS_WIN)) + (size_t)l * PW * DM, DM}; pg8::StaticOrder S; if (l == NL - 1) { S.init(ML, PW, F.G, F.bx, 0); S.ex_n = 32; S.ex_pm0 = ML / 256; S.ex_pn0 = AW / 256; } else S.init(MT, PW, F.G - NSTREAM, F.bx, 0);
            EpiProj E{((bf16_t*)(F.ws + WS_P)), F.in(I_BIN) + l * PW};
            pg8::gemm_phase<EpiProj, pg8::StaticOrder, true, true>(ring, g, S, E, F.wave);
            }
        } SEAM(pb + 1);
        if (IN(pb + 2)) REPS(pb + 2) { phase_prep(F0, l); phase_glu_sc(F0, l, mrows); } SEAMP(pb + 2, conv_taps_fill(F0, l));
        if (IN(pb + 3)) REPS(pb + 3) { phase_conv2(F0, l, mrows, IN(pb + 2) && DUP_MASK == 0u); phase_attn(F0, l); } SEAM(pb + 3);
        if (IN(pb + 4)) REPS(pb + 4) {
            const int GG = (l == 0) ? F0.G - NSTREAM : F0.G;
            if (l == 0 && F0.bx >= GG) { pa_stream(F0, (F0.bx - GG) * NWAVES + F0.wave, NSTREAM * NWAVES, 1); } else {
            { const Frame F = fresh(F0); pg8::StaticOrder S; S.init(mrows, DM, GG, F.bx, 0);
              pg8::Gemm g{((bf16_t*)(F.ws + WS_ATT)), ((bf16_t*)(F.ws + WS_WAO)) + (size_t)l * DM * AW, AW}; EpiGate<0> E{((bf16_t*)(F.ws + WS_MX)), (unsigned char*)(F.ws + WS_P), 0, (u32x4*)(F.ws + WS_QR)}; pg8::gemm_phase<EpiGate<0>, pg8::StaticOrder, true, true>(ring, g, S, E, F.wave); }
            { const Frame F = fresh(F0); pg8::StaticOrder S; S.init(mrows, DM, GG, F.bx, 0);
              pg8::Gemm g{((bf16_t*)(F.ws + WS_CONV)), ((bf16_t*)(F.ws + WS_WCO)) + (size_t)l * DM * CWD, CWD}; EpiGate<1> E{((bf16_t*)(F.ws + WS_MX)), (unsigned char*)(F.ws + WS_P), 1, (u32x4*)(F.ws + WS_QR)}; pg8::gemm_phase<EpiGate<1>, pg8::StaticOrder, true, true>(ring, g, S, E, F.wave); }
            { const Frame F = fresh(F0); pg8::StaticOrder S; S.init(mrows, DM, GG, F.bx, 0);
              pg8::Gemm g{((bf16_t*)(F.ws + WS_SC)), ((bf16_t*)(F.ws + WS_WSO)) + (size_t)l * DM * SWD, SWD}; EpiGate<2> E{((bf16_t*)(F.ws + WS_MX)), (unsigned char*)(F.ws + WS_P), 2, (u32x4*)(F.ws + WS_QR)}; pg8::gemm_phase<EpiGate<2>, pg8::StaticOrder, true, true>(ring, g, S, E, F.wave); }
            }
        } SEAM(pb + 4);
        if (IN(pb + 5)) REPS(pb + 5) {
            const Frame F = fresh(F0);
            const int GG = (l == 0) ? F.G - NSTREAM : F.G;
            if (l == 0 && F.bx >= GG) { pa_stream(F0, (F.bx - GG) * NWAVES + F.wave, NSTREAM * NWAVES, 2); } else {
            pg8::Gemm g{((bf16_t*)(F.ws + WS_MX)), ((bf16_t*)(F.ws + WS_WO)) + (size_t)l * DM * DM, DM}; pg8::StaticOrder S; S.init(mrows, DM, GG, F.bx, 0);
            EpiDelta E{((bf16_t*)(F.ws + WS_XM)), ((float*)(F.ws + WS_MOD)) + (size_t)l * 5 * 12288 + 2 * DM};
            pg8::gemm_phase<EpiDelta, pg8::StaticOrder, true, true>(ring, g, S, E, F.wave);
            }
        } SEAMP(pb + 5, router_fill(F0, l));
        if (IN(pb + 6)) REPS(pb + 6) { phase_norm2p(F0, l, mrows, IN(pb + 5) && DUP_MASK == 0u); } SEAM(pb + 6);
        if (IN(pb + 7)) REPS(pb + 7) { phase_rank(F0, l); } SEAM(pb + 7);
        if (IN(pb + 9)) REPS(pb + 9) {
            const Frame F = fresh(F0);
            pg8::StaticOrder S; S.init(xrows, 2048, F.G, F.bx, 1);
            LAS int* gidx = (LAS int*)(F.lds + RING_BYTES + 1024);
            { pg8::Unit u;
              for (int si = 0; S.next(si, u); ++si) if (F.tid < 256) { const int rho = u.pm * 256 + F.tid; int src;
                  if (rho < 32768) src = ((rho >> 9) & 3) * SEQ + ((const int*)(F.ws + WS_IDX))[rho];
                  else { const int i = (rho - 32768) & 255; if (i < 128) src = ML + (i >> 5) * CTXL + ((const int*)(F.ws + WS_IDX))[rho]; else { src = 0; ((float*)(F.ws + WS_GATE))[rho] = 0.f; } }
                  gidx[si * 256 + F.tid] = src; } }
            __syncthreads();
            pg8::Gemm g{(const bf16_t*)(F.ws + WS_H8), (const bf16_t*)(F.ws + WS_W13 + (size_t)l * NE * 2048 * DM), DM / 2};
            EpiSwiglu E{(unsigned char*)(F.ws + WS_HID)};
            pg8::gemm_phase<EpiSwiglu, pg8::StaticOrder, true, true, true, true>(ring, g, S, E, F.wave, gidx);
        } SEAM(pb + 9);
        if (IN(pb + 10)) REPS(pb + 10) {
            const Frame F = fresh(F0);
            pg8::Gemm g{(const bf16_t*)(F.ws + WS_HID), (const bf16_t*)(F.ws + WS_W2 + (size_t)l * NE * DM * FF), FF / 2}; pg8::StaticOrder S; S.init(xrows, DM, F.G, F.bx, 1);
            EpiY E{((bf16_t*)(F.ws + WS_Y)), ((float*)(F.ws + WS_GATE))};
            pg8::gemm_phase<EpiY, pg8::StaticOrder, true, true, false, true>(ring, g, S, E, F.wave);
        } SEAM(pb + 10);
    }
}
struct Args { const float* in[26]; float* out; unsigned char* ws; int ph_lo, ph_hi; };
__global__ void __launch_bounds__(NWAVES * 64, 2) mk_fwd(Args args) {
    extern __shared__ __attribute__((aligned(16))) unsigned char lds[];
    Frame F;
    F.lds = (LAS unsigned char*)lds;
    volatile LAS unsigned* MISC = (volatile LAS unsigned*)(F.lds + MISC_OFF);
    F.wave = __builtin_amdgcn_readfirstlane((int)threadIdx.x >> 6); F.tid = F.wave * 64 + mk_lane_id(); F.lane = F.tid & 63;
    F.G = gridDim.x; F.bx = blockIdx.x; F.gw = blockIdx.x * NWAVES + F.wave; F.ngw = F.G * NWAVES;
    F.karg = (const CAS unsigned char*)__builtin_amdgcn_kernarg_segment_ptr(); F.out = nullptr; F.ws = nullptr;
    unsigned char* ws = args.ws;
    for (int u = F.tid; u < (LDS_BYTES - RING_BYTES) / 4; u += NWAVES * 64) ((LAS unsigned*)(F.lds + RING_BYTES))[u] = 0u;
    __syncthreads();
    const int lo = args.ph_lo, hi = args.ph_hi;
    XcdBarrier bar; bar.bar = (unsigned*)(ws + WS_CTL) + CW_BAR; bar.x = 0; bar.st = nullptr; bar.w0 = (F.wave == 0);
    if (hi - lo > 1) bar = xcd_barrier_post((unsigned*)(ws + WS_CTL) + CW_BAR, MISC + 8, F.wave == 0);
    LAS unsigned char* ring = F.lds + RING_OFF;
    const Frame& F0 = F;

    if (IN(0)) REPS(0) { phase_pa(F0); } SEAM(0);
    if (IN(1)) REPS(1) { phase_pa2(F0); } SEAM(1);
    layer_program<0>(F0, lo, hi, bar, ring);
    layer_program<1>(F0, lo, hi, bar, ring);
    if (IN(24)) REPS(24) { phase_final(F0); }
#undef IN
#undef SEAM
}

extern "C" void kernel_launch(void* const* d_in, const int* in_sizes, int n_in, void* d_out, int out_size, void* d_ws, size_t ws_size, hipStream_t stream) {
    static int grid = 0;
    if (grid == 0) {
        if (n_in != 26 || out_size != ML * DM || ws_size < WS_END) { fprintf(stderr, "kernel_launch: unexpected shapes (n_in %d, out %d, ws %zu < %zu)\n", n_in, out_size, ws_size, (size_t)WS_END); grid = -1; return; }
        int dev = 0, cus = 0, per_cu = 0;
        if (hipGetDevice(&dev) != hipSuccess || hipDeviceGetAttribute(&cus, hipDeviceAttributeMultiprocessorCount, dev) != hipSuccess) { grid = -1; return; }
        if (hipFuncSetAttribute((const void*)mk_fwd, hipFuncAttributeMaxDynamicSharedMemorySize, LDS_BYTES) != hipSuccess) { fprintf(stderr, "kernel_launch: hipFuncSetAttribute failed\n"); grid = -1; return; }
        if (hipOccupancyMaxActiveBlocksPerMultiprocessor(&per_cu, (const void*)mk_fwd, NWAVES * 64, LDS_BYTES) != hipSuccess || per_cu < 1) fprintf(stderr, "kernel_launch: occupancy query says %d\n", per_cu);
        (void)hipGetLastError();
        grid = cus;
    }
    if (grid < 0) return;
    (void)hipMemsetAsync((char*)d_ws + WS_CTL, 0, CTL_ZERO_BYTES, stream);
    Args a{};
    for (int i = 0; i < 26; ++i) a.in[i] = (const float*)d_in[i];
    a.out = (float*)d_out; a.ws = (unsigned char*)d_ws;
#if MK_PER_PHASE
    for (int p = 0; p < NPHASE; ++p) { a.ph_lo = p; a.ph_hi = p + 1; hipLaunchKernelGGL(mk_fwd, dim3(grid), dim3(NWAVES * 64), LDS_BYTES, stream, a); }
#else
    a.ph_lo = 0; a.ph_hi = NPHASE; hipLaunchKernelGGL(mk_fwd, dim3(grid), dim3(NWAVES * 64), LDS_BYTES, stream, a);
#endif
}
```
